# Optimizing an MI355X kernel written in HIP

```python
import math
import jax
import jax.numpy as jnp
from jax import lax
import numpy as np

D_MODEL = 1024
BATCH = 8
SEQ = 4096
DEPTH = 4

N_EVEN = (DEPTH + 1) // 2
N_ODD = DEPTH // 2
SB_HEADS = 8
SB_HEAD_DIM = D_MODEL // 16
SB_WIDTH = SB_HEADS * SB_HEAD_DIM
Q_BLOCK = 128
ML_HEADS = 4
ML_HEAD_DIM = D_MODEL // 8
ML_WIDTH = ML_HEADS * ML_HEAD_DIM
ML_CHUNK = 64
CONV_WIDTH = 4
MIX_WIDTH = SB_WIDTH + ML_WIDTH
SPLITS = (SB_WIDTH, 2 * SB_WIDTH, 3 * SB_WIDTH, 3 * SB_WIDTH + 2 * ML_WIDTH,
          3 * SB_WIDTH + 3 * ML_WIDTH, 3 * SB_WIDTH + 4 * ML_WIDTH)
IN_COLS = 3 * SB_WIDTH + 4 * ML_WIDTH + 2 * ML_HEADS
RW_HEAD_DIM = 64
RW_HEADS = D_MODEL // RW_HEAD_DIM
DECAY_LORA = 64
AAA_LORA = 64
GATE_LORA = 128
D_FF = 4 * D_MODEL
NORM_EPS = 1e-6
GN_EPS = 64e-5

kernel_name = 'hybrid_stickbreak_mlstm_rwkv7'


def rmsnorm(x, g):
    xf = x.astype(jnp.float32)
    y = xf * lax.rsqrt(jnp.mean(xf * xf, axis=-1, keepdims=True) + NORM_EPS) * g
    return y.astype(x.dtype)


def causal_depthwise_conv(x, w):
    K, C = w.shape
    return lax.conv_general_dilated(
        x, w.astype(x.dtype)[:, None, :], window_strides=(1,), padding=[(K - 1, 0)],
        dimension_numbers=('NWC', 'WIO', 'NWC'), feature_group_count=C)


def stick_breaking_attention(q, k, v):
    S, d = q.shape[2], q.shape[3]
    scale = 1.0 / math.sqrt(d)
    outs = []
    for blk in range(S // Q_BLOCK):
        q0 = blk * Q_BLOCK
        q1 = q0 + Q_BLOCK
        qb = q[:, :, q0:q1]
        kb = k[:, :, :q1]
        vb = v[:, :, :q1]
        z = jnp.einsum('bhtd,bhsd->bhts', qb, kb) * scale
        t_idx = q0 + jnp.arange(Q_BLOCK)[:, None]
        s_idx = jnp.arange(q1)[None, :]
        causal = s_idx < t_idx
        log_keep = jnp.where(causal, jax.nn.log_sigmoid(-z), 0.0)
        suffix = lax.cumsum(log_keep, axis=3, reverse=True) - log_keep
        weights = jnp.where(causal, jnp.exp(jax.nn.log_sigmoid(z) + suffix), 0.0)
        outs.append(jnp.einsum('bhts,bhsd->bhtd', weights, vb))
    return jnp.concatenate(outs, axis=2)


def mlstm_chunkwise(q, k, v, log_i, log_f):
    B, H, S, d = q.shape
    nc = S // ML_CHUNK
    k = k * (d ** -0.5)
    tril = jnp.tril(jnp.ones((ML_CHUNK, ML_CHUNK), dtype=bool))

    def to_chunks(t):
        t = t.reshape(t.shape[:2] + (nc, ML_CHUNK) + t.shape[3:])
        return jnp.moveaxis(t, 2, 0)

    def step(carry, inp):
        C, n, m = carry
        qc, kc, vc, li, lf = inp
        b = jnp.cumsum(lf, axis=-1)
        dmat = jnp.where(tril, b[..., :, None] - b[..., None, :] + li[..., None, :], -jnp.inf)
        inter = b + m[..., None]
        m_t = jnp.maximum(jnp.max(dmat, axis=-1), inter)
        scores = jnp.einsum('bhtd,bhsd->bhts', qc, kc) * jnp.exp(dmat - m_t[..., None])
        w_inter = jnp.exp(inter - m_t)
        num = jnp.einsum('bhts,bhsd->bhtd', scores, vc) + \
            w_inter[..., None] * jnp.einsum('bhtd,bhde->bhte', qc, C)
        den = jnp.sum(scores, axis=-1) + w_inter * jnp.einsum('bhtd,bhd->bht', qc, n)
        h = num / jnp.maximum(jnp.abs(den), jnp.exp(-m_t))[..., None]
        b_last = b[..., -1]
        g = b_last[..., None] - b + li
        m_new = jnp.maximum(b_last + m, jnp.max(g, axis=-1))
        w_state = jnp.exp(b_last + m - m_new)
        w_tok = jnp.exp(g - m_new[..., None])
        C_new = w_state[..., None, None] * C + jnp.einsum('bhs,bhsd,bhse->bhde', w_tok, kc, vc)
        n_new = w_state[..., None] * n + jnp.einsum('bhs,bhsd->bhd', w_tok, kc)
        return (C_new, n_new, m_new), h

    init = (jnp.zeros((B, H, d, d), jnp.float32), jnp.zeros((B, H, d), jnp.float32),
            jnp.zeros((B, H), jnp.float32))
    _, h = lax.scan(step, init, (to_chunks(q), to_chunks(k), to_chunks(v),
                                 to_chunks(log_i), to_chunks(log_f)))
    return jnp.moveaxis(h, 0, 2).reshape(B, H, S, d)


def stickbreak_mlstm_mix(u, w_in, b_if, conv_w, head_g, w_out):
    B, S, _ = u.shape
    proj = u.astype(jnp.float32) @ w_in
    sb_q, sb_k, sb_v, ml_qk, ml_v, ml_o, ml_if = jnp.split(proj, SPLITS, axis=-1)

    def heads(t, n_heads):
        return t.reshape(B, S, n_heads, -1).transpose(0, 2, 1, 3)

    a_out = stick_breaking_attention(heads(sb_q, SB_HEADS), heads(sb_k, SB_HEADS),
                                     heads(sb_v, SB_HEADS))
    a_out = a_out.transpose(0, 2, 1, 3).reshape(B, S, SB_WIDTH)
    ml_qk = jax.nn.silu(causal_depthwise_conv(ml_qk, conv_w))
    ml_q, ml_k = jnp.split(ml_qk, 2, axis=-1)
    ml_if = ml_if + b_if
    log_i = ml_if[..., :ML_HEADS].transpose(0, 2, 1)
    log_f = jax.nn.log_sigmoid(ml_if[..., ML_HEADS:]).transpose(0, 2, 1)
    h = mlstm_chunkwise(heads(ml_q, ML_HEADS), heads(ml_k, ML_HEADS), heads(ml_v, ML_HEADS),
                        log_i, log_f)
    h = h.transpose(0, 2, 1, 3)
    h = h * lax.rsqrt(jnp.mean(h * h, axis=-1, keepdims=True) + NORM_EPS) * head_g
    h = h.reshape(B, S, ML_WIDTH) * jax.nn.sigmoid(ml_o)
    return jnp.concatenate([a_out, h], axis=-1) @ w_out


def rwkv7_time_mix(u, mu, w_rkv, w0, w1, w2, a0, a1, a2, g1, g2, k_k, k_a, r_k,
                   ln_g, ln_b, w_out):
    B, S, D = u.shape
    xf = u.astype(jnp.float32)
    x_prev = jnp.pad(xf, ((0, 0), (1, 0), (0, 0)))[:, :S]
    xx = x_prev - xf
    xr, xw, xk, xv, xa, xg = (xf + xx * mu[i] for i in range(6))
    r = xr @ w_rkv[0]
    k = xk @ w_rkv[1]
    v = xv @ w_rkv[2]
    log_w = -jax.nn.softplus(-(w0 + jnp.tanh(xw @ w1) @ w2)) - 0.5
    decay = jnp.exp(-jnp.exp(log_w))
    a = jax.nn.sigmoid(a0 + (xa @ a1) @ a2)
    gate = jax.nn.sigmoid(xg @ g1) @ g2

    def heads(t):
        return t.reshape(B, S, RW_HEADS, RW_HEAD_DIM)

    kk = heads(k * k_k)
    kk = kk * lax.rsqrt(jnp.maximum(jnp.sum(kk * kk, axis=-1, keepdims=True), 1e-24))
    k = k * (1.0 + (a - 1.0) * k_a)
    r, k, v, decay, a = heads(r), heads(k), heads(v), heads(decay), heads(a)

    def step(state, inp):
        r_t, w_t, k_t, v_t, kk_t, a_t = inp
        sa = jnp.einsum('bhvk,bhk->bhv', state, kk_t)
        state = state * w_t[:, :, None, :] - sa[..., None] * (kk_t * a_t)[:, :, None, :] \
            + v_t[..., None] * k_t[:, :, None, :]
        return state, jnp.einsum('bhvk,bhk->bhv', state, r_t)

    def time_major(t):
        return jnp.moveaxis(t, 1, 0)

    init = jnp.zeros((B, RW_HEADS, RW_HEAD_DIM, RW_HEAD_DIM), jnp.float32)
    _, y = lax.scan(step, init, (time_major(r), time_major(decay), time_major(k),
                                 time_major(v), time_major(kk), time_major(a)))
    y = jnp.moveaxis(y, 0, 1)
    mean = jnp.mean(y, axis=-1, keepdims=True)
    var = jnp.mean(jnp.square(y - mean), axis=-1, keepdims=True)
    y = (y - mean) * lax.rsqrt(var + GN_EPS) * ln_g + ln_b
    y = y + jnp.sum(r * k * r_k, axis=-1, keepdims=True) * v
    return (y.reshape(B, S, D) * gate) @ w_out


def squared_relu_mlp(u, w_up, w_down):
    return jnp.square(jax.nn.relu(u.astype(jnp.float32) @ w_up)) @ w_down


def setup_inputs(seed: int = 0) -> dict:
    key = jax.random.key(seed)
    ks = iter(jax.random.split(key, 32))
    D = D_MODEL

    def nrm(shape, scale):
        return jax.random.normal(next(ks), shape, jnp.float32) * scale

    def uni(shape, lo, hi):
        return jax.random.uniform(next(ks), shape, jnp.float32, lo, hi)

    x = nrm((BATCH, SEQ, D), 1.0)
    norm_g = 1.0 + nrm((DEPTH, 4, D), 0.02)
    e_w_in = nrm((N_EVEN, D, IN_COLS), D ** -0.5)
    e_b_if = jnp.concatenate([nrm((N_EVEN, ML_HEADS), 0.1),
                              uni((N_EVEN, ML_HEADS), 3.0, 6.0)], axis=-1)
    e_conv_w = nrm((N_EVEN, CONV_WIDTH, 2 * ML_WIDTH), CONV_WIDTH ** -0.5)
    e_head_g = 1.0 + nrm((N_EVEN, ML_HEADS, ML_HEAD_DIM), 0.02)
    e_w_out = nrm((N_EVEN, MIX_WIDTH, D), MIX_WIDTH ** -0.5)
    r_mu = uni((N_ODD, 6, D), 0.0, 1.0)
    r_w_rkv = nrm((N_ODD, 3, D, D), D ** -0.5)
    r_w0 = uni((N_ODD, D), -6.0, 1.0)
    r_w1 = nrm((N_ODD, D, DECAY_LORA), D ** -0.5)
    r_w2 = nrm((N_ODD, DECAY_LORA, D), 0.5 * DECAY_LORA ** -0.5)
    r_a0 = nrm((N_ODD, D), 0.1)
    r_a1 = nrm((N_ODD, D, AAA_LORA), D ** -0.5)
    r_a2 = nrm((N_ODD, AAA_LORA, D), 0.5 * AAA_LORA ** -0.5)
    r_g1 = nrm((N_ODD, D, GATE_LORA), D ** -0.5)
    r_g2 = nrm((N_ODD, GATE_LORA, D), GATE_LORA ** -0.5)
    r_k_k = 0.85 + nrm((N_ODD, D), 0.02)
    r_k_a = 1.0 + nrm((N_ODD, D), 0.02)
    r_r_k = nrm((N_ODD, RW_HEADS, RW_HEAD_DIM), 0.1)
    r_ln_g = 1.0 + nrm((N_ODD, RW_HEADS, RW_HEAD_DIM), 0.02)
    r_ln_b = nrm((N_ODD, RW_HEADS, RW_HEAD_DIM), 0.02)
    r_w_out = nrm((N_ODD, D, D), D ** -0.5)
    mlp_w_up = nrm((DEPTH, D, D_FF), D ** -0.5)
    mlp_w_down = nrm((DEPTH, D_FF, D), D_FF ** -0.5)
    return {'x': x, 'norm_g': norm_g, 'e_w_in': e_w_in, 'e_b_if': e_b_if,
            'e_conv_w': e_conv_w, 'e_head_g': e_head_g, 'e_w_out': e_w_out,
            'r_mu': r_mu, 'r_w_rkv': r_w_rkv, 'r_w0': r_w0, 'r_w1': r_w1, 'r_w2': r_w2,
            'r_a0': r_a0, 'r_a1': r_a1, 'r_a2': r_a2, 'r_g1': r_g1, 'r_g2': r_g2,
            'r_k_k': r_k_k, 'r_k_a': r_k_a, 'r_r_k': r_r_k, 'r_ln_g': r_ln_g,
            'r_ln_b': r_ln_b, 'r_w_out': r_w_out, 'mlp_w_up': mlp_w_up,
            'mlp_w_down': mlp_w_down}


def reference(x, norm_g, e_w_in, e_b_if, e_conv_w, e_head_g, e_w_out, r_mu, r_w_rkv,
              r_w0, r_w1, r_w2, r_a0, r_a1, r_a2, r_g1, r_g2, r_k_k, r_k_a, r_r_k,
              r_ln_g, r_ln_b, r_w_out, mlp_w_up, mlp_w_down):
    h = x
    for layer in range(DEPTH):
        g = norm_g[layer]
        u = rmsnorm(h, g[0])
        if layer % 2 == 0:
            e = layer // 2
            mix = stickbreak_mlstm_mix(u, e_w_in[e], e_b_if[e], e_conv_w[e], e_head_g[e],
                                       e_w_out[e])
        else:
            o = layer // 2
            mix = rwkv7_time_mix(u, r_mu[o], r_w_rkv[o], r_w0[o], r_w1[o], r_w2[o], r_a0[o],
                                 r_a1[o], r_a2[o], r_g1[o], r_g2[o], r_k_k[o], r_k_a[o],
                                 r_r_k[o], r_ln_g[o], r_ln_b[o], r_w_out[o])
        h = h + rmsnorm(mix, g[1]).astype(h.dtype)
        u = rmsnorm(h, g[2])
        ff = squared_relu_mlp(u, mlp_w_up[layer], mlp_w_down[layer])
        h = h + rmsnorm(ff, g[3]).astype(h.dtype)
    return h
```

```cpp
#include <hip/hip_runtime.h>
#include <cstdio>
#include <cstdint>
typedef short bf16x8 __attribute__((ext_vector_type(8)));
typedef short s16x4 __attribute__((ext_vector_type(4)));
typedef float f32x4 __attribute__((ext_vector_type(4)));
typedef float f32x16 __attribute__((ext_vector_type(16)));
typedef unsigned u32x4 __attribute__((ext_vector_type(4)));
typedef unsigned u32x2 __attribute__((ext_vector_type(2)));
#ifdef HOST_EMU
#define LDSQ
#define DI inline
DI int lane_id() { return emu_lane(); }
DI s16x4 TR16(const LDSQ void* p) { return emu_tr16(p); }
DI unsigned short f2bf(float f) { return (unsigned short)emu_f2bf(f); }
#define MEMFENCE() do {} while (0)
#else
#define LDSQ __attribute__((address_space(3)))
#define DI __device__ __forceinline__
typedef short v4i16_t __attribute__((ext_vector_type(4)));
typedef __bf16 bf16x2_t __attribute__((ext_vector_type(2)));
typedef float f32x2_t __attribute__((ext_vector_type(2)));
DI int lane_id() { int l = (int)(threadIdx.x & 63u); asm volatile("" : "+v"(l)); return l; }
DI s16x4 TR16(const LDSQ void* p) { return __builtin_bit_cast(s16x4, __builtin_amdgcn_ds_read_tr16_b64_v4i16((LDSQ v4i16_t*)p)); }
DI unsigned short f2bf(float f) { f32x2_t v = {f, 0.f}; bf16x2_t b = __builtin_convertvector(v, bf16x2_t); return (unsigned short)(__builtin_bit_cast(unsigned, b) & 0xffffu); }
#define MEMFENCE() asm volatile("" ::: "memory")
#endif
typedef unsigned short bf16_t;
DI float bf2f(unsigned short s) { unsigned u = ((unsigned)s) << 16; return __builtin_bit_cast(float, u); }
DI unsigned pk2(float lo, float hi) {
#ifdef HOST_EMU
    return (unsigned)f2bf(lo) | ((unsigned)f2bf(hi) << 16);
#else
    f32x2_t v = {lo, hi}; bf16x2_t b = __builtin_convertvector(v, bf16x2_t); return __builtin_bit_cast(unsigned, b);
#endif
}
DI f32x4 mfma16(bf16x8 a, bf16x8 b, f32x4 c) { return __builtin_amdgcn_mfma_f32_16x16x32_bf16(a, b, c, 0, 0, 0); }
DI f32x16 mfma32(bf16x8 a, bf16x8 b, f32x16 c) { return __builtin_amdgcn_mfma_f32_32x32x16_bf16(a, b, c, 0, 0, 0); }
DI bf16x8 mk8(u32x2 lo, u32x2 hi) { u32x4 v = {lo.x, lo.y, hi.x, hi.y}; return __builtin_bit_cast(bf16x8, v); }
DI u32x2 pack4(f32x4 v) { u32x2 r = {pk2(v[0], v[1]), pk2(v[2], v[3])}; return r; }
DI u32x2 ld8(const bf16_t* p) { return *(const u32x2*)p; }
DI u32x4 ld16(const bf16_t* p) { return *(const u32x4*)p; }
DI u32x2 tr2(s16x4 v) { return __builtin_bit_cast(u32x2, v); }
DI float fexp(float x) { return __builtin_amdgcn_exp2f(x * 1.4426950408889634f); }
DI float flog(float x) { return __builtin_amdgcn_logf(x) * 0.6931471805599453f; }
DI float softplusf(float x) { return fmaxf(x, 0.f) + flog(1.0f + fexp(-fabsf(x))); }
DI float sigmoidf_(float x) { return __builtin_amdgcn_rcpf(1.0f + fexp(-x)); }
DI float tanhf_(float x) { const float xc = fminf(fmaxf(x, -15.f), 15.f); const float e = fexp(2.f * xc); return (e - 1.f) * __builtin_amdgcn_rcpf(e + 1.f); }

#define SB_STOP 36.0f
DI int crow32(int i, int h) { return (i & 3) + 8 * (i >> 2) + 4 * h; }
DI void sb_attn_unit(const bf16_t* __restrict__ Q, const bf16_t* __restrict__ K, int ldqk, const bf16_t* __restrict__ VT, int S, bf16_t* __restrict__ O, int ldo, int t0  ) {
    const int lane = lane_id(), r = lane & 31, hi = lane >> 5;
    bf16x8 qf[4];
#pragma unroll
    for (int s = 0; s < 4; ++s) qf[s] = __builtin_bit_cast(bf16x8, ld16(Q + (size_t)(t0 + r) * ldqk + 16 * s + 8 * hi));
    f32x16 o0, o1;
#pragma unroll
    for (int i = 0; i < 16; ++i) { o0[i] = 0.f; o1[i] = 0.f; }
    float carry = 0.f;
    const int tq = t0 + r;
    u32x4 kn[4]; u32x2 vn[8];
    int s0 = t0;
#define SB_LOAD(kd, vd, s0_) do { \
    _Pragma("unroll") for (int s = 0; s < 4; ++s) kd[s] = ld16(K + (size_t)((s0_) + r) * ldqk + 16 * s + 8 * hi); \
    _Pragma("unroll") for (int db = 0; db < 2; ++db) _Pragma("unroll") for (int s = 0; s < 2; ++s) { \
        const bf16_t* vp = VT + (size_t)(32 * db + r) * S + (s0_) + 16 * s + 4 * hi; vd[(db * 2 + s) * 2] = ld8(vp); vd[(db * 2 + s) * 2 + 1] = ld8(vp + 8); } } while (0)
    SB_LOAD(kn, vn, s0);
    for (;;) {
        u32x4 kc[4]; u32x2 vc[8];
#pragma unroll
        for (int s = 0; s < 4; ++s) kc[s] = kn[s];
#pragma unroll
        for (int s = 0; s < 8; ++s) vc[s] = vn[s];
        const int sn = s0 - 32;
        if (sn >= 0) SB_LOAD(kn, vn, sn);
        f32x16 z;
#pragma unroll
        for (int i = 0; i < 16; ++i) z[i] = 0.f;
#pragma unroll
        for (int s = 0; s < 4; ++s) z = mfma32(__builtin_bit_cast(bf16x8, kc[s]), qf[s], z);
        float sp[16];
        const bool diag = (s0 == t0);
#pragma unroll
        for (int i = 0; i < 16; ++i) { z[i] *= 0.125f; const bool valid = !diag || (s0 + crow32(i, hi) < tq); sp[i] = valid ? softplusf(z[i]) : 0.f; if (!valid) z[i] = -1e30f; }
        float gs[4], pg[4];
#pragma unroll
        for (int g = 0; g < 4; ++g) gs[g] = (sp[4 * g] + sp[4 * g + 1]) + (sp[4 * g + 2] + sp[4 * g + 3]);
#pragma unroll
        for (int g = 0; g < 4; ++g) pg[g] = __shfl_xor(gs[g], 32);
        float after[4];
        {
            const float o3 = 0.f, o2 = gs[3], o1_ = gs[3] + gs[2], o0_ = o1_ + gs[1];
            const float p3i = pg[3], p2i = pg[3] + pg[2], p1i = p2i + pg[1], p0i = p1i + pg[0];
            const float pe3 = 0.f, pe2 = p3i, pe1 = p2i, pe0 = p1i;
            after[0] = o0_ + (hi ? pe0 : p0i); after[1] = o1_ + (hi ? pe1 : p1i); after[2] = o2 + (hi ? pe2 : p2i); after[3] = o3 + (hi ? pe3 : p3i);
        }
        const float tot = (gs[0] + gs[1]) + (gs[2] + gs[3]) + (pg[0] + pg[1]) + (pg[2] + pg[3]);
        f32x16 p;
#pragma unroll
        for (int g = 0; g < 4; ++g) {
            float c = carry + after[g];
#pragma unroll
            for (int j = 3; j >= 0; --j) { c += sp[4 * g + j]; p[4 * g + j] = fexp(z[4 * g + j] - c); }
        }
        carry += tot;
#pragma unroll
        for (int s = 0; s < 2; ++s) {
            u32x4 pb = {pk2(p[8 * s], p[8 * s + 1]), pk2(p[8 * s + 2], p[8 * s + 3]), pk2(p[8 * s + 4], p[8 * s + 5]), pk2(p[8 * s + 6], p[8 * s + 7])};
            const bf16x8 pbv = __builtin_bit_cast(bf16x8, pb);
            o0 = mfma32(mk8(vc[(0 * 2 + s) * 2], vc[(0 * 2 + s) * 2 + 1]), pbv, o0);
            o1 = mfma32(mk8(vc[(1 * 2 + s) * 2], vc[(1 * 2 + s) * 2 + 1]), pbv, o1);
        }
        if (sn < 0) break;
        if (__all(carry > SB_STOP)) break;
        s0 = sn;
    }
#undef SB_LOAD
#pragma unroll
    for (int g = 0; g < 4; ++g) {
        u32x2 w0 = {pk2(o0[4 * g], o0[4 * g + 1]), pk2(o0[4 * g + 2], o0[4 * g + 3])};
        u32x2 w1 = {pk2(o1[4 * g], o1[4 * g + 1]), pk2(o1[4 * g + 2], o1[4 * g + 3])};
        bf16_t* op = O + (size_t)(t0 + r) * ldo + 8 * g + 4 * hi;
        *(u32x2*)op = w0; *(u32x2*)(op + 32) = w1;
    }
}

DI void mlstm_stream(const bf16_t* __restrict__ Qp, const bf16_t* __restrict__ Kp, int ldqk, const bf16_t* __restrict__ Vp, int ldv, const float* __restrict__ G, int gi, int gf,
                     int S, int den, bf16_t* __restrict__ NUM, int ldn, float* __restrict__ DEN, float* __restrict__ EMT, int ldd, LDSQ unsigned char* lds) {
    const int lane = lane_id(), fr = lane & 15, fq = lane >> 4;
    LDSQ unsigned char* Kimg = lds;
    LDSQ unsigned char* Vimg = lds + 4096;
    f32x4 C[8];
#pragma unroll
    for (int ci = 0; ci < 8; ++ci) C[ci] = (f32x4){0.f, 0.f, 0.f, 0.f};
    float Fcarry = 0.f, Mcarry = 0.f;
    const int NC = S / 16;
    u32x2 qn[8], kn[8]; u32x4 vn = {0u, 0u, 0u, 0u}; float lin, lfn;
#define ML_LOAD(c_) do { const size_t row = (size_t)(16 * (c_) + fr); \
    _Pragma("unroll") for (int ks = 0; ks < 4; ++ks) { qn[2 * ks] = ld8(Qp + row * ldqk + 32 * ks + 4 * fq); qn[2 * ks + 1] = ld8(Qp + row * ldqk + 32 * ks + 16 + 4 * fq); \
        kn[2 * ks] = ld8(Kp + row * ldqk + 32 * ks + 4 * fq); kn[2 * ks + 1] = ld8(Kp + row * ldqk + 32 * ks + 16 + 4 * fq); } \
    if (!den && lane < 32) vn = ld16(Vp + (size_t)(16 * (c_) + (lane >> 1)) * ldv + 8 * (lane & 1)); \
    lin = G[row * 8 + gi]; lfn = G[row * 8 + gf]; } while (0)
    ML_LOAD(0);
    for (int c = 0; c < NC; ++c) {
        u32x2 qc[8], kc[8]; u32x4 vcur = vn; const float li = lin, lf = lfn;
#pragma unroll
        for (int i = 0; i < 8; ++i) { qc[i] = qn[i]; kc[i] = kn[i]; }
        if (c + 1 < NC) ML_LOAD(c + 1);
        MEMFENCE();
#pragma unroll
        for (int ks = 0; ks < 4; ++ks) { *(LDSQ u32x2*)(Kimg + fr * 256 + (32 * ks + 4 * fq) * 2) = kc[2 * ks]; *(LDSQ u32x2*)(Kimg + fr * 256 + (32 * ks + 16 + 4 * fq) * 2) = kc[2 * ks + 1]; }
        if (den) { if (lane < 32) { u32x4 e0 = {(lane & 1) ? 0u : 0x3F80u, 0u, 0u, 0u}; *(LDSQ u32x4*)(Vimg + (lane >> 1) * 32 + (lane & 1) * 16) = e0; } }
        else { if (lane < 32) *(LDSQ u32x4*)(Vimg + (lane >> 1) * 32 + (lane & 1) * 16) = vcur; }
        MEMFENCE();
        float inc = lf;
#pragma unroll
        for (int d = 1; d < 16; d <<= 1) { const float t = __shfl_up(inc, d, 16); if (fr >= d) inc += t; }
        const float Fg = Fcarry + inc, a = li - Fg;
        float mx = a;
#pragma unroll
        for (int d = 1; d < 16; d <<= 1) { const float t = __shfl_up(mx, d, 16); if (fr >= d) mx = fmaxf(mx, t); }
        const float Mx = fmaxf(Mcarry, mx);
        const float Mend = __shfl(Mx, 15, 16), Ftot = __shfl(inc, 15, 16);
        float as_[4], Mxs[4], Fgs[4];
#pragma unroll
        for (int i = 0; i < 4; ++i) { as_[i] = __shfl(a, 4 * fq + i, 16); Mxs[i] = __shfl(Mx, 4 * fq + i, 16); Fgs[i] = __shfl(Fg, 4 * fq + i, 16); }
        f32x4 st = {0.f, 0.f, 0.f, 0.f};
#pragma unroll
        for (int ks = 0; ks < 4; ++ks) st = mfma16(mk8(kc[2 * ks], kc[2 * ks + 1]), mk8(qc[2 * ks], qc[2 * ks + 1]), st);
        f32x4 pt;
#pragma unroll
        for (int i = 0; i < 4; ++i) pt[i] = (4 * fq + i <= fr) ? st[i] * fexp(as_[i] - Mx) : 0.f;
        const s16x4 v4 = TR16(Vimg + (4 * fq + (fr >> 2)) * 32 + 8 * (fr & 3));
        const u32x2 z2 = {0u, 0u};
        f32x4 numI = mfma16(mk8(pack4(pt), z2), mk8(tr2(v4), z2), (f32x4){0.f, 0.f, 0.f, 0.f});
        f32x4 inter = {0.f, 0.f, 0.f, 0.f};
#pragma unroll
        for (int ks = 0; ks < 4; ++ks) inter = mfma16(mk8(qc[2 * ks], qc[2 * ks + 1]), mk8(pack4(C[2 * ks]), pack4(C[2 * ks + 1])), inter);
        f32x4 num;
#pragma unroll
        for (int i = 0; i < 4; ++i) num[i] = numI[i] + fexp(Mcarry - Mxs[i]) * inter[i];
        if (den) {
            if (fr == 0) {
#pragma unroll
                for (int i = 0; i < 4; ++i) { const size_t row = (size_t)(16 * c + 4 * fq + i); DEN[row * ldd] = num[i]; EMT[row * ldd] = fexp(-(Fgs[i] + Mxs[i])); }
            }
        } else {
#pragma unroll
            for (int i = 0; i < 4; ++i) NUM[(size_t)(16 * c + 4 * fq + i) * ldn + fr] = f2bf(num[i]);
        }
        const float wstate = fexp(Mcarry - Mend);
        f32x4 vw;
#pragma unroll
        for (int i = 0; i < 4; ++i) vw[i] = bf2f((unsigned short)v4[i]) * fexp(as_[i] - Mend);
        const bf16x8 vwb = mk8(pack4(vw), z2);
#pragma unroll
        for (int ci = 0; ci < 8; ++ci) {
            const s16x4 k4 = TR16(Kimg + (4 * fq + (fr >> 2)) * 256 + (16 * ci + 4 * (fr & 3)) * 2);
            C[ci] = mfma16(mk8(tr2(k4), z2), vwb, C[ci] * wstate);
        }
        Mcarry = Mend; Fcarry += Ftot;
        MEMFENCE();
    }
#undef ML_LOAD
}

struct RwkvPrepArgs {
    const bf16_t *R, *K; int ld;
    const bf16_t* LORA; int ldl;
    const bf16_t *W2T, *A2T;
    const float *w0, *a0, *k_k, *k_a, *r_k;
    bf16_t *KT, *BT, *KK, *RT;
    float* GL;
    float* BONUS;
};
DI void rwkv_prep_unit(const RwkvPrepArgs& P, int chunk, int h) {
    const int lane = lane_id(), fr = lane & 15, fq = lane >> 4;
    const size_t row = (size_t)chunk * 16 + fr;
    bf16x8 bw[2], ba[2];
#pragma unroll
    for (int s = 0; s < 2; ++s) {
        const u32x4 lw = ld16(P.LORA + row * P.ldl + 32 * s + 8 * fq);
        u32x4 t;
#pragma unroll
        for (int j = 0; j < 4; ++j) { const unsigned w = lw[j]; t[j] = pk2(tanhf_(bf2f((unsigned short)(w & 0xffffu))), tanhf_(bf2f((unsigned short)(w >> 16)))); }
        bw[s] = __builtin_bit_cast(bf16x8, t);
        ba[s] = __builtin_bit_cast(bf16x8, ld16(P.LORA + row * P.ldl + 64 + 32 * s + 8 * fq));
    }
    float ss = 0.f, bon = 0.f;
    float kap[16], av[16], kp[16], rv[16], ld_[16];
#pragma unroll
    for (int ti = 0; ti < 4; ++ti) {
        const int chl = 16 * ti + fr;
        f32x4 dw = {0.f, 0.f, 0.f, 0.f}, da = {0.f, 0.f, 0.f, 0.f};
#pragma unroll
        for (int s = 0; s < 2; ++s) {
            dw = mfma16(__builtin_bit_cast(bf16x8, ld16(P.W2T + (size_t)(64 * h + chl) * 64 + 32 * s + 8 * fq)), bw[s], dw);
            da = mfma16(__builtin_bit_cast(bf16x8, ld16(P.A2T + (size_t)(64 * h + chl) * 64 + 32 * s + 8 * fq)), ba[s], da);
        }
        const int ch0 = 64 * h + 16 * ti + 4 * fq;
        const u32x2 r2 = ld8(P.R + row * P.ld + ch0), k2 = ld8(P.K + row * P.ld + ch0);
        const f32x4 w0v = *(const f32x4*)(P.w0 + ch0), a0v = *(const f32x4*)(P.a0 + ch0), kkv = *(const f32x4*)(P.k_k + ch0), kav = *(const f32x4*)(P.k_a + ch0), rkv = *(const f32x4*)(P.r_k + ch0);
#pragma unroll
        for (int i = 0; i < 4; ++i) {
            const int e = 4 * ti + i;
            const float r = bf2f((unsigned short)((i & 1) ? (r2[i >> 1] >> 16) : (r2[i >> 1] & 0xffffu)));
            const float k = bf2f((unsigned short)((i & 1) ? (k2[i >> 1] >> 16) : (k2[i >> 1] & 0xffffu)));
            const float wl = w0v[i] + dw[i];
            const float logw = -softplusf(-wl) - 0.5f;
            ld_[e] = -fexp(logw);
            const float a = sigmoidf_(a0v[i] + da[i]);
            const float kkr = k * kkv[i];
            ss += kkr * kkr;
            const float k1 = k * (1.0f + (a - 1.0f) * kav[i]);
            bon += r * k1 * rkv[i];
            kap[e] = kkr; av[e] = a; kp[e] = k1; rv[e] = r;
        }
    }
    ss += __shfl_xor(ss, 16); ss += __shfl_xor(ss, 32);
    bon += __shfl_xor(bon, 16); bon += __shfl_xor(bon, 32);
    const float rn = __builtin_amdgcn_rsqf(fmaxf(ss, 1e-24f));
    if (fq == 0) P.BONUS[row * 16 + h] = bon;
#pragma unroll
    for (int ti = 0; ti < 4; ++ti) {
        const int ch0 = 64 * h + 16 * ti + 4 * fq;
        f32x4 okt, obt, okk, ort, ogl;
#pragma unroll
        for (int i = 0; i < 4; ++i) {
            const int e = 4 * ti + i;
            float cs = ld_[e];
#pragma unroll
            for (int d = 1; d < 16; d <<= 1) { const float t = __shfl_up(cs, d, 16); if (fr >= d) cs += t; }
            const float gi = fexp(cs), gx = fexp(cs - ld_[e]), ginv = fexp(-cs);
            const float kappa = kap[e] * rn;
            okt[i] = kappa * gx; obt[i] = kappa * av[e] * ginv; okk[i] = kp[e] * ginv; ort[i] = rv[e] * gi; ogl[i] = gi;
        }
        *(u32x2*)(P.KT + row * P.ld + ch0) = pack4(okt);
        *(u32x2*)(P.BT + row * P.ld + ch0) = pack4(obt);
        *(u32x2*)(P.KK + row * P.ld + ch0) = pack4(okk);
        *(u32x2*)(P.RT + row * P.ld + ch0) = pack4(ort);
        if (fr == 15) *(f32x4*)(P.GL + (size_t)chunk * 1024 + ch0) = ogl;
    }
}

DI bf16x8 pk_lo(f32x4 v) { const u32x2 z2 = {0u, 0u}; return mk8(pack4(v), z2); }
DI f32x4 mm16(f32x4 accPT, f32x4 accQ) { return mfma16(pk_lo(accPT), pk_lo(accQ), (f32x4){0.f, 0.f, 0.f, 0.f}); }
DI void rwkv_scan_stream(const bf16_t* __restrict__ KT, const bf16_t* __restrict__ BT, const bf16_t* __restrict__ KK, const bf16_t* __restrict__ RT, const bf16_t* __restrict__ V, int ld,
                         const float* __restrict__ GL, int S, bf16_t* __restrict__ Y, int ldy, LDSQ unsigned char* lds) {
    const int lane = lane_id(), fr = lane & 15, fq = lane >> 4;
    LDSQ unsigned char* BTimg = lds;
    LDSQ unsigned char* KKimg = lds + 2048;
    LDSQ unsigned char* Vimg = lds + 4096;
    f32x4 H[4];
#pragma unroll
    for (int ci = 0; ci < 4; ++ci) H[ci] = (f32x4){0.f, 0.f, 0.f, 0.f};
    const int NC = S / 16;
    u32x2 ktn[4], btn[4], kkn[4], rtn[4]; u32x4 vn = {0u, 0u, 0u, 0u}; f32x4 gln[4];
#define RW_LOAD(c_) do { const size_t row = (size_t)(16 * (c_) + fr); \
    _Pragma("unroll") for (int s = 0; s < 2; ++s) _Pragma("unroll") for (int q = 0; q < 2; ++q) { const size_t o = row * ld + 32 * s + 16 * q + 4 * fq; \
        ktn[2 * s + q] = ld8(KT + o); btn[2 * s + q] = ld8(BT + o); kkn[2 * s + q] = ld8(KK + o); rtn[2 * s + q] = ld8(RT + o); } \
    if (lane < 32) vn = ld16(V + (size_t)(16 * (c_) + (lane >> 1)) * ld + 8 * (lane & 1)); \
    _Pragma("unroll") for (int ci = 0; ci < 4; ++ci) gln[ci] = *(const f32x4*)(GL + (size_t)(c_) * 1024 + 16 * ci + 4 * fq); } while (0)
    RW_LOAD(0);
    const bool dg[4] = {4 * fq + 0 == fr, 4 * fq + 1 == fr, 4 * fq + 2 == fr, 4 * fq + 3 == fr};
    for (int c = 0; c < NC; ++c) {
        u32x2 kt[4], bt[4], kk[4], rt[4]; const u32x4 vcur = vn; f32x4 gl[4];
#pragma unroll
        for (int i = 0; i < 4; ++i) { kt[i] = ktn[i]; bt[i] = btn[i]; kk[i] = kkn[i]; rt[i] = rtn[i]; gl[i] = gln[i]; }
        if (c + 1 < NC) RW_LOAD(c + 1);
        MEMFENCE();
#pragma unroll
        for (int s = 0; s < 2; ++s)
#pragma unroll
            for (int q = 0; q < 2; ++q) { const int off = fr * 128 + (32 * s + 16 * q + 4 * fq) * 2; *(LDSQ u32x2*)(BTimg + off) = bt[2 * s + q]; *(LDSQ u32x2*)(KKimg + off) = kk[2 * s + q]; }
        if (lane < 32) *(LDSQ u32x4*)(Vimg + (lane >> 1) * 32 + (lane & 1) * 16) = vcur;
        MEMFENCE();
        const f32x4 z4 = {0.f, 0.f, 0.f, 0.f};
        f32x4 x1 = z4, x2 = z4, akt = z4, arbt = z4, arkt = z4;
#pragma unroll
        for (int s = 0; s < 2; ++s) {
            const bf16x8 fkt = mk8(kt[2 * s], kt[2 * s + 1]), fbt = mk8(bt[2 * s], bt[2 * s + 1]), fkk = mk8(kk[2 * s], kk[2 * s + 1]), frt = mk8(rt[2 * s], rt[2 * s + 1]);
            x1 = mfma16(fbt, fkt, x1);
            x2 = mfma16(fkt, fbt, x2);
            akt = mfma16(fkk, fkt, akt);
            arbt = mfma16(fbt, frt, arbt);
            arkt = mfma16(fkk, frt, arkt);
        }
        f32x4 yT, y_;
#pragma unroll
        for (int i = 0; i < 4; ++i) {
            const int rr = 4 * fq + i;
            yT[i] = (rr < fr) ? -x1[i] : 0.f;
            y_[i] = (fr < rr) ? -x2[i] : 0.f;
            akt[i] = (rr < fr) ? akt[i] : 0.f;
            arbt[i] = (rr <= fr) ? arbt[i] : 0.f;
            arkt[i] = (rr <= fr) ? arkt[i] : 0.f;
        }
#define IA(x) ((f32x4){(x)[0] + (dg[0] ? 1.f : 0.f), (x)[1] + (dg[1] ? 1.f : 0.f), (x)[2] + (dg[2] ? 1.f : 0.f), (x)[3] + (dg[3] ? 1.f : 0.f)})
        const f32x4 y2 = mm16(yT, y_), y2T = mm16(y_, yT);
        const f32x4 y4 = mm16(y2T, y2), y4T = mm16(y2, y2T);
        const f32x4 y8T = mm16(y4, y4T);
        const f32x4 w1 = mm16(IA(y_), IA(y2T)), w1T = mm16(IA(yT), IA(y2));
        const f32x4 w2 = mm16(w1T, IA(y4T)), w2T = mm16(w1, IA(y4));
        const f32x4 tT = mm16(w2T, IA(y8T));
#undef IA
        const bf16x8 hb0 = mk8(pack4(H[0]), pack4(H[1])), hb1 = mk8(pack4(H[2]), pack4(H[3]));
        const s16x4 v4 = TR16(Vimg + (4 * fq + (fr >> 2)) * 32 + 8 * (fr & 3));
        const u32x2 z2 = {0u, 0u};
        f32x4 g = mfma16(mk8(kt[0], kt[1]), hb0, z4);
        g = mfma16(mk8(kt[2], kt[3]), hb1, g);
        g = mfma16(pk_lo(akt), mk8(tr2(v4), z2), g);
        const f32x4 tg = mfma16(pk_lo(tT), pk_lo(g), z4);
        const f32x4 u = -tg;
        f32x4 yo = mfma16(mk8(rt[0], rt[1]), hb0, z4);
        yo = mfma16(mk8(rt[2], rt[3]), hb1, yo);
        const bf16x8 uv = mk8(pack4(u), tr2(v4));
        yo = mfma16(mk8(pack4(arbt), pack4(arkt)), uv, yo);
#pragma unroll
        for (int i = 0; i < 4; ++i) Y[(size_t)(16 * c + 4 * fq + i) * ldy + fr] = f2bf(yo[i]);
#pragma unroll
        for (int ci = 0; ci < 4; ++ci) {
            const int off = (4 * fq + (fr >> 2)) * 128 + (16 * ci + 4 * (fr & 3)) * 2;
            const s16x4 b4 = TR16(BTimg + off), k4 = TR16(KKimg + off);
            H[ci] = mfma16(mk8(tr2(b4), tr2(k4)), uv, H[ci]) * gl[ci];
        }
        MEMFENCE();
    }
#undef RW_LOAD
}
#define GAS __attribute__((address_space(1)))
#define LAS __attribute__((address_space(3)))
typedef GAS unsigned gu32;
#define RLX_AGENT __ATOMIC_RELAXED, __HIP_MEMORY_SCOPE_AGENT
#define LDS_WAIT() asm volatile("s_waitcnt lgkmcnt(0)" ::: "memory")
#define VM_WAIT() asm volatile("s_waitcnt vmcnt(0)" ::: "memory")

constexpr int CB = 8, CS = 4096, CD = 1024, CM = CB * CS;
constexpr int NPROJ = 3584, PITCH_WIN = 3592, FF = 4096;
constexpr float NORM_EPS = 1e-6f, GN_EPS = 64e-5f;
constexpr int NWAVES = 8;
constexpr size_t MiB = 1u << 20;
constexpr size_t WS_CTL = 0, CTL_ZERO_BYTES = 1 * MiB;
constexpr size_t WS_W = 1 * MiB;
constexpr size_t WS_GATES = 27 * MiB, WS_DEN = 28 * MiB, WS_EMT = 28 * MiB + 512 * 1024, WS_BONUS = 29 * MiB;
constexpr size_t WS_U = 32 * MiB;
constexpr size_t WS_BIG = 97 * MiB;
constexpr size_t WS_PROJ = WS_BIG, WS_QKC = 321 * MiB, WS_VT = 385 * MiB, WS_NUM = 417 * MiB;
constexpr size_t WS_MIX = WS_BIG;
constexpr size_t WS_HID = WS_BIG, WS_FFO = 353 * MiB;
constexpr size_t WS_XR = 97 * MiB, WS_XK = 161 * MiB, WS_XV = 225 * MiB, WS_RO = 289 * MiB, WS_KO = 353 * MiB, WS_VO = 417 * MiB, WS_LORA = 481 * MiB, WS_GL = 497 * MiB;
constexpr size_t WS_KT = WS_XR, WS_BT = WS_XK, WS_KK = WS_XV, WS_RT = WS_U, WS_YRAW = WS_RO, WS_YG = WS_KO;
constexpr size_t WS_END = 505 * MiB;
constexpr size_t W_IN = 0, W_OUTE = 3670016, W_UP = 5242880, W_DN = 9437184;
constexpr size_t W_RKV = 0, W_LB1 = 3145728, W_LB2 = 3407872, W_W2T = 3670016, W_A2T = 3735552, W_G2T = 3801088, W_OUTO = 3932160;
constexpr int CW_BAR = 4096;

constexpr int RING_BYTES = 131072, LDSCTL_OFF = RING_BYTES, MISC_OFF = LDSCTL_OFF + 320, LDS_BYTES = 147456;

#define XB_TMO      128
#define XB_XCNT(j)  (256  + 64 * (j))
#define XB_XSUB(j)  (1280 + 64 * (j))
#define XB_XGEN(j)  (2304 + 64 * (j))
#define XB_TOP      3328
#define XB_TOPGEN   3392
#define XCD_BAR_WORDS 3456
#define XB_SPIN_CAP (1u << 18)
__device__ __forceinline__ unsigned xb_ld(unsigned* p)              { return __hip_atomic_load(p, __ATOMIC_RELAXED, __HIP_MEMORY_SCOPE_AGENT); }
__device__ __forceinline__ unsigned xb_add(unsigned* p, unsigned v) { return __hip_atomic_fetch_add(p, v, __ATOMIC_RELAXED, __HIP_MEMORY_SCOPE_AGENT); }
__device__ __forceinline__ unsigned xb_xcc_id() { return (unsigned)__builtin_amdgcn_s_getreg((3 << 11) | 20) & 0xFu; }
#define XB_SPIN(cond, bar) do { unsigned _sp = 0; while (cond) { __builtin_amdgcn_s_sleep(1); \
    if ((++_sp & 255u) == 0u) { if (xb_ld(&(bar)[XB_TMO])) break; if (_sp > XB_SPIN_CAP) { atomicAdd(&(bar)[XB_TMO], 1u); break; } } } } while (0)
struct XcdBarrier { unsigned* bar; unsigned x; volatile LAS unsigned* st; };
__device__ __forceinline__ XcdBarrier xcd_barrier_post(unsigned* bar, volatile LAS unsigned* st) {
    XcdBarrier b; b.bar = bar; b.x = xb_xcc_id(); b.st = st;
    if (threadIdx.x == 0) (void)xb_add(&bar[XB_XCNT(b.x)], 1u);
    return b;
}
__device__ __forceinline__ void xcd_barrier_complete(unsigned* bar, unsigned x, unsigned& nloc, unsigned& nx) {
    const unsigned G = gridDim.x * gridDim.y * gridDim.z;
    unsigned sum, cnt, mine, sp = 0u;
    for (;;) {
        sum = 0u; cnt = 0u; mine = 0u;
#pragma unroll
        for (unsigned j = 0; j < 16; ++j) { const unsigned c = xb_ld(&bar[XB_XCNT(j)]); sum += c; cnt += (c > 0u) ? 1u : 0u; mine = (j == x) ? c : mine; }
        if (sum == G) break;
        __builtin_amdgcn_s_sleep(1);
        if ((++sp & 255u) == 0u) { if (xb_ld(&bar[XB_TMO])) break; if (sp > XB_SPIN_CAP) { atomicAdd(&bar[XB_TMO], 1u); break; } }
    }
    nloc = mine > 0u ? mine : 1u; nx = cnt > 0u ? cnt : 1u;
}
__device__ __forceinline__ void xcd_barrier(const XcdBarrier& b) {
    asm volatile("s_waitcnt vmcnt(0)" ::: "memory");
    __syncthreads();
    if (threadIdx.x == 0) {
        unsigned* bar = b.bar;
        __builtin_amdgcn_s_waitcnt(0);
        unsigned nloc = b.st[0], nx = b.st[1];
        if (nloc == 0u) { xcd_barrier_complete(bar, b.x, nloc, nx); b.st[0] = nloc; b.st[1] = nx; }
        const unsigned old = xb_add(&bar[XB_XSUB(b.x)], 1u);
        const unsigned gen = old / nloc;
        if (old + 1u == (gen + 1u) * nloc) {
            __builtin_amdgcn_fence(__ATOMIC_RELEASE, "agent");
            asm volatile("s_waitcnt vmcnt(0)" ::: "memory");
            const unsigned og = xb_add(&bar[XB_TOP], 1u);
            const unsigned tg = og / nx;
            if (og + 1u == (tg + 1u) * nx) xb_add(&bar[XB_TOPGEN], 1u);
            else XB_SPIN(xb_ld(&bar[XB_TOPGEN]) == tg, bar);
            __builtin_amdgcn_fence(__ATOMIC_ACQUIRE, "agent");
            xb_add(&bar[XB_XGEN(b.x)], 1u);
            asm volatile("s_waitcnt vmcnt(0)" ::: "memory");
        } else {
            XB_SPIN(xb_ld(&bar[XB_XGEN(b.x)]) == gen, bar);
            __builtin_amdgcn_fence(__ATOMIC_ACQUIRE, "agent");
            asm volatile("s_waitcnt vmcnt(0)" ::: "memory");
        }
    }
    __syncthreads();
}

namespace pg8 {
constexpr int BM = 256, BK = 64, HALF = 128, HTB = HALF * BK * 2, STAGE_BYTES = 8 * HTB, NXCD = 8, WGM = 8;
__host__ __device__ __forceinline__ int lds_byte(int r, int c) { const int st = (r >> 4) * 2 + (c >> 5), rr = r & 15, cc = c & 31, ob = rr * 64 + cc * 2; return st * 1024 + (ob ^ (((ob >> 9) & 1) << 5)); }
__host__ __device__ __forceinline__ void stage_rc(int b, int& R, int& C) { const int st = b / 1024, sb = b % 1024, swz = sb ^ (((sb >> 9) & 1) << 5); R = (st >> 1) * 16 + swz / 64; C = (st & 1) * 32 + (swz % 64) / 2; }
__host__ __device__ __forceinline__ int perm32(int rho) { const int n = rho >> 4, i = rho & 15; return 8 * (i >> 2) + 4 * n + (i & 3); }
struct Unit { int pm, pn; };
struct UnitPtrs { const char* A; const char* B; int two; };
struct StaticOrder {
    int nM, nN, nwg, G, c;
    __device__ void init(int M, int N, int G_, int c_) { nM = M / BM; nN = N / BM; nwg = nM * nN; G = G_; c = c_; }
    __device__ bool next(int i, Unit& u) const {
        const long L = (long)i * G + c; if (L >= nwg) return false;
        int wgid = (int)L; { const int q = nwg / NXCD, r = nwg % NXCD, xcd = wgid % NXCD, off = wgid / NXCD; wgid = (xcd < r ? xcd * (q + 1) : r * (q + 1) + (xcd - r) * q) + off; }
        const int nig = WGM * nN, gid = wgid / nig, fm = gid * WGM, gsz = (nM - fm) < WGM ? (nM - fm) : WGM;
        u.pm = fm + ((wgid % nig) % gsz); u.pn = (wgid % nig) / gsz; return true;
    }
};
__device__ __forceinline__ unsigned cvt_pk_bf16(float lo, float hi) { unsigned r; asm volatile("v_cvt_pk_bf16_f32 %0, %1, %2" : "=v"(r) : "v"(lo), "v"(hi)); return r; }

template <int LDA, int LDB, int NT> struct ProbPlain {
    const bf16_t* A; const bf16_t* Bt;
    static constexpr long lda = LDA, ldb = LDB; static constexpr bool TWO_SRC = false; static constexpr int NTC = NT;
    __device__ __forceinline__ void ptrs(const Unit& u, UnitPtrs& p) const {
        p.A = (const char*)(A + (size_t)u.pm * BM * lda); p.B = (const char*)(Bt + (size_t)u.pn * BM * ldb);
    }
};
struct ProbRkv {
    const bf16_t* X; size_t xstride; const bf16_t* Wt; const bf16_t* Upad; const bf16_t* LB1; long lb2d;
    static constexpr long lda = 1024, ldb = 1024; static constexpr bool TWO_SRC = true; static constexpr int NTC = 16;
    __device__ __forceinline__ void ptrs(const Unit& u, UnitPtrs& p) const {
        if (u.pn < 12) { p.A = (const char*)(X + (size_t)(u.pn >> 2) * xstride + (size_t)u.pm * BM * 1024); p.B = (const char*)(Wt + (size_t)u.pn * BM * 1024); p.two = 0; }
        else { const size_t arow = (size_t)u.pm * BM + (size_t)(u.pm >> 4) + 1; p.A = (const char*)(Upad + arow * 1024); p.B = (const char*)LB1; p.two = 1; }
    }
};
struct RkvOrder {
    int c;
    __device__ bool next(int i, Unit& u) const { const int half = c & 1; if (i >= (half ? 6 : 7)) return false; u.pm = c >> 1; u.pn = half ? 7 + i : i; return true; }
};
struct EpiStore {
    bf16_t* O; int ldc; int act; int rkv; size_t gstride; bf16_t* Ol;
    static constexpr bool PERM = true;
    __device__ __forceinline__ void operator()(const f32x4 (&acc)[2][2][4][2], const Unit& u, int wr, int wc, int fr, int fq) const {
        bf16_t* base = O; int ld = ldc, colt = u.pn * BM;
        if (rkv) { if (u.pn < 12) { base = O + (size_t)(u.pn >> 2) * gstride; colt = (u.pn & 3) * BM; } else { base = Ol; ld = 256; colt = 0; } }
        const int row0 = u.pm * BM + wr * 64 + fr, col0 = colt + wc * 32 + 8 * fq;
#pragma unroll
        for (int ai = 0; ai < 2; ++ai)
#pragma unroll
            for (int m = 0; m < 4; ++m) { bf16_t* rowp = base + (size_t)(row0 + ai * HALF + m * 16) * ld + col0;
#pragma unroll
                for (int bj = 0; bj < 2; ++bj) { f32x4 v0 = acc[ai][bj][m][0], v1 = acc[ai][bj][m][1];
                    if (act == 1) {
#pragma unroll
                        for (int q = 0; q < 4; ++q) { const float a = fmaxf(v0[q], 0.f), b = fmaxf(v1[q], 0.f); v0[q] = a * a; v1[q] = b * b; } }
                    u32x4 w; w.x = cvt_pk_bf16(v0[0], v0[1]); w.y = cvt_pk_bf16(v0[2], v0[3]); w.z = cvt_pk_bf16(v1[0], v1[1]); w.w = cvt_pk_bf16(v1[2], v1[3]);
                    *(u32x4*)(rowp + bj * HALF) = w; } }
    }
};

template <class Prob, class Epi, class Sched>
__device__ __forceinline__ void gemm_phase(LAS unsigned char* lds, const Prob& P, const Sched& S, const Epi& E) {
    int tid = threadIdx.x; asm volatile("" : "+v"(tid));
    const int wid = __builtin_amdgcn_readfirstlane(tid >> 6), lane = tid & 63, wr = wid >> 2, wc = wid & 3, fr = lane & 15, fq = lane >> 4;
    constexpr long lda = Prob::lda, ldb = Prob::ldb; long lb2d = 0; if constexpr (Prob::TWO_SRC) lb2d = P.lb2d;
    unsigned voffA[2], voffB[2];
#pragma unroll
    for (int i = 0; i < 2; ++i) { int R, C; stage_rc(tid * 16 + i * 8192, R, C); const int Rb = Epi::PERM ? ((R & ~31) + perm32(R & 31)) : R;
        voffA[i] = (unsigned)(R * lda + C) * 2u; voffB[i] = (unsigned)(Rb * ldb + C) * 2u; }
    const long kstep = (long)(BK * 2);
    const long hstepA = (long)HALF * lda * 2, hstepB = (long)HALF * ldb * 2;
    const unsigned ldsw = (unsigned)wid * 1024u;
    const int aoff = lds_byte(wr * 64 + fr, fq * 8), boff = lds_byte(wc * 32 + fr, fq * 8);
#define PG8_SA(b, h) (((b) * 2 + (h)) * HTB)
#define PG8_SB(b, h) ((4 + (b) * 2 + (h)) * HTB)
#define PG8_STAGE(bufoff, gbase, voff) do { _Pragma("unroll") for (int _i = 0; _i < 2; ++_i) \
        __builtin_amdgcn_global_load_lds((const unsigned*)((const char*)(gbase) + (voff)[_i]), (LAS unsigned*)(lds + (bufoff) + ldsw + _i * 8192), 16, 0, 0); } while (0)
#define PG8_LDA(dst, b, h) do { _Pragma("unroll") for (int m = 0; m < 4; ++m) _Pragma("unroll") for (int k = 0; k < 2; ++k) dst[m][k] = *(const LAS bf16x8*)(lds + PG8_SA(b, h) + aoff + m * 2048 + k * 1024); } while (0)
#define PG8_LDB(dst, b, h) do { _Pragma("unroll") for (int n = 0; n < 2; ++n) _Pragma("unroll") for (int k = 0; k < 2; ++k) dst[n][k] = *(const LAS bf16x8*)(lds + PG8_SB(b, h) + boff + n * 2048 + k * 1024); } while (0)
#define PG8_MMA(ai, bj, At, Bt) do { __builtin_amdgcn_s_setprio(1); _Pragma("unroll") for (int m = 0; m < 4; ++m) _Pragma("unroll") for (int n = 0; n < 2; ++n) _Pragma("unroll") for (int k = 0; k < 2; ++k) \
        acc[ai][bj][m][n] = __builtin_amdgcn_mfma_f32_16x16x32_bf16(Bt[n][k], At[m][k], acc[ai][bj][m][n], 0, 0, 0); __builtin_amdgcn_s_setprio(0); } while (0)
#define PG8_WAIT_V(n) asm volatile("s_waitcnt vmcnt(" #n ")" ::: "memory")
#define PG8_WAIT_L(n) asm volatile("s_waitcnt lgkmcnt(" #n ")" ::: "memory")
#define PG8_BAR __builtin_amdgcn_s_barrier()
#define PG8_SCHED __builtin_amdgcn_sched_barrier(0)
#define PG8_KTA(p, tau) ((p).A + ((!Prob::TWO_SRC || (tau) < 16) ? (long)(tau) * kstep : (long)((tau) - 16) * kstep - 2048))
#define PG8_KTB(p, tau) ((p).B + ((!Prob::TWO_SRC || (tau) < 16) ? (long)(tau) * kstep : (long)((tau) - 16) * kstep + lb2d))
    Unit cur, nxt; int ui = 0;
    if (!S.next(0, cur)) return;
    UnitPtrs cp, np; P.ptrs(cur, cp);
    f32x4 acc[2][2][4][2];
#pragma unroll
    for (int a = 0; a < 2; ++a)
#pragma unroll
        for (int b = 0; b < 2; ++b)
#pragma unroll
            for (int m = 0; m < 4; ++m)
#pragma unroll
                for (int n = 0; n < 2; ++n) acc[a][b][m][n] = (f32x4){0.f, 0.f, 0.f, 0.f};
    bf16x8 At[4][2], B0[2][2], B1[2][2];
    {
        const char* cA = cp.A; const char* cB = cp.B;
        PG8_STAGE(PG8_SB(0, 0), cB, voffB); PG8_STAGE(PG8_SB(0, 1), cB + hstepB, voffB); PG8_STAGE(PG8_SA(0, 0), cA, voffA); PG8_STAGE(PG8_SA(0, 1), cA + hstepA, voffA);
        if (wr == 1) PG8_BAR;
        PG8_WAIT_V(2); PG8_BAR;
        PG8_STAGE(PG8_SB(1, 0), cB + kstep, voffB); PG8_STAGE(PG8_SA(1, 0), cA + kstep, voffA); PG8_STAGE(PG8_SB(1, 1), cB + hstepB + kstep, voffB);
        PG8_WAIT_V(6); PG8_BAR;
    }
    for (;;) {
        const bool has_next = S.next(ui + 1, nxt);
        if (has_next) P.ptrs(nxt, np); else np = cp;
        int nt = Prob::NTC; if constexpr (Prob::TWO_SRC) { if (cp.two) nt = 32; }
        for (int t = 0; t < nt; t += 2) {
            const bool last = (t == nt - 2);
            const char* a1 = PG8_KTA(cp, t + 1);
            const char* a2 = last ? np.A : PG8_KTA(cp, t + 2); const char* b2 = last ? np.B : PG8_KTB(cp, t + 2);
            const char* a3 = a2 + kstep; const char* b3 = b2 + kstep;
            PG8_LDB(B0, 0, 0); PG8_LDB(B1, 0, 1); PG8_SCHED; PG8_LDA(At, 0, 0); PG8_STAGE(PG8_SA(1, 1), a1 + hstepA, voffA);
            PG8_WAIT_V(8); PG8_WAIT_L(0); PG8_BAR; PG8_MMA(0, 0, At, B0); PG8_MMA(0, 1, At, B1); PG8_BAR; PG8_SCHED;
            PG8_LDA(At, 0, 1); PG8_STAGE(PG8_SB(0, 0), b2, voffB); PG8_STAGE(PG8_SB(0, 1), b2 + hstepB, voffB); PG8_STAGE(PG8_SA(0, 0), a2, voffA);
            PG8_WAIT_V(8); PG8_WAIT_L(0); PG8_BAR; PG8_MMA(1, 0, At, B0); PG8_MMA(1, 1, At, B1); PG8_BAR; PG8_SCHED;
            PG8_LDB(B0, 1, 0); PG8_LDB(B1, 1, 1); PG8_SCHED; PG8_LDA(At, 1, 0); PG8_STAGE(PG8_SA(0, 1), a2 + hstepA, voffA);
            PG8_WAIT_V(8); PG8_WAIT_L(0); PG8_BAR; PG8_MMA(0, 0, At, B0); PG8_MMA(0, 1, At, B1); PG8_BAR; PG8_SCHED;
            PG8_LDA(At, 1, 1); PG8_STAGE(PG8_SB(1, 0), b3, voffB); PG8_STAGE(PG8_SB(1, 1), b3 + hstepB, voffB); PG8_STAGE(PG8_SA(1, 0), a3, voffA);
            PG8_WAIT_V(8); PG8_WAIT_L(0); PG8_BAR; PG8_MMA(1, 0, At, B0); PG8_MMA(1, 1, At, B1); PG8_BAR; PG8_SCHED;
        }
        if (wr == 0) PG8_BAR;
        E(acc, cur, wr, wc, fr, fq);
        if (!has_next) break;
#pragma unroll
        for (int a = 0; a < 2; ++a)
#pragma unroll
            for (int b = 0; b < 2; ++b)
#pragma unroll
                for (int m = 0; m < 4; ++m)
#pragma unroll
                    for (int n = 0; n < 2; ++n) acc[a][b][m][n] = (f32x4){0.f, 0.f, 0.f, 0.f};
        cur = nxt; cp = np; ++ui;
        if (wr == 1) PG8_BAR;
    }
    PG8_WAIT_V(0);
    PG8_BAR;
#undef PG8_SA
#undef PG8_SB
#undef PG8_STAGE
#undef PG8_LDA
#undef PG8_LDB
#undef PG8_MMA
#undef PG8_WAIT_V
#undef PG8_WAIT_L
#undef PG8_BAR
#undef PG8_SCHED
#undef PG8_KTA
#undef PG8_KTB
}
}

struct Frame {
    LAS unsigned char* lds;
    int tid, lane, wave, vcu, G, gw, NGW;
};
__device__ __forceinline__ float wave_sum(float v) {
#pragma unroll
    for (int o = 1; o < 64; o <<= 1) v += __shfl_xor(v, o);
    return v;
}
__device__ __forceinline__ void cvt_item(const float* W, int ldw, bf16_t* WT, int ldt, int k0, int n0, const float* sc, int mode, LAS float* scr, int lane) {
#pragma unroll 8
    for (int i = 0; i < 32; ++i) { const int kk = 2 * i + (lane >> 5); float v = W[(size_t)(k0 + kk) * ldw + n0 + (lane & 31)];
        if (mode) { const float s = sc[k0 + kk]; v *= (mode == 1) ? s : (1.0f - s); }
        scr[kk * 33 + (lane & 31)] = v; }
    LDS_WAIT(); asm volatile("" ::: "memory");
    const int c = lane & 7;
#pragma unroll
    for (int j = 0; j < 4; ++j) { const int n = (lane >> 3) + 8 * j; const LAS float* s = scr + (8 * c) * 33 + n;
        u32x4 o; o.x = pk2(s[0 * 33], s[1 * 33]); o.y = pk2(s[2 * 33], s[3 * 33]); o.z = pk2(s[4 * 33], s[5 * 33]); o.w = pk2(s[6 * 33], s[7 * 33]);
        *(GAS u32x4*)(WT + (size_t)(n0 + n) * ldt + k0 + 8 * c) = o; }
    LDS_WAIT(); asm volatile("" ::: "memory");
}
__device__ __forceinline__ void cvt_matrix(const Frame& F, const float* W, int ldw, int K, int N, bf16_t* WT, int ldt, const float* sc, int mode, int& cursor) {
    LAS float* scr = (LAS float*)(F.lds + F.wave * 16384);
    const int nnb = N / 32, nitems = (K / 64) * nnb;
    int first = (F.gw - cursor) % F.NGW; if (first < 0) first += F.NGW;
    for (int it = first; it < nitems; it += F.NGW) cvt_item(W, ldw, WT, ldt, 64 * (it / nnb), 32 * (it % nnb), sc, mode, scr, F.lane);
    cursor += nitems;
}
struct Inputs { const float* p[25]; };
__device__ __forceinline__ void convert_layer(const Frame& F, const Inputs& in, bf16_t* Wb, int L) {
    int cur = 0;
    if ((L & 1) == 0) {
        const int e = L >> 1;
        cvt_matrix(F, in.p[2] + (size_t)e * 1024 * PITCH_WIN, PITCH_WIN, 1024, NPROJ, Wb + W_IN, 1024, nullptr, 0, cur);
        cvt_matrix(F, in.p[6] + (size_t)e * 1024 * 1024, 1024, 1024, 1024, Wb + W_OUTE, 1024, nullptr, 0, cur);
    } else {
        const int o = L >> 1; const float* mu = in.p[7] + (size_t)o * 6 * 1024;
        for (int j = 0; j < 3; ++j) cvt_matrix(F, in.p[8] + ((size_t)o * 3 + j) * 1024 * 1024, 1024, 1024, 1024, Wb + W_RKV + (size_t)j * 1024 * 1024, 1024, nullptr, 0, cur);
        for (int s = 0; s < 2; ++s) { bf16_t* LB = Wb + (s ? W_LB2 : W_LB1); const int mode = s ? 1 : 2;
            cvt_matrix(F, in.p[10] + (size_t)o * 1024 * 64, 64, 1024, 64, LB, 1024, mu + 1 * 1024, mode, cur);
            cvt_matrix(F, in.p[13] + (size_t)o * 1024 * 64, 64, 1024, 64, LB + 64 * 1024, 1024, mu + 4 * 1024, mode, cur);
            cvt_matrix(F, in.p[15] + (size_t)o * 1024 * 128, 128, 1024, 128, LB + 128 * 1024, 1024, mu + 5 * 1024, mode, cur); }
        cvt_matrix(F, in.p[11] + (size_t)o * 64 * 1024, 1024, 64, 1024, Wb + W_W2T, 64, nullptr, 0, cur);
        cvt_matrix(F, in.p[14] + (size_t)o * 64 * 1024, 1024, 64, 1024, Wb + W_A2T, 64, nullptr, 0, cur);
        cvt_matrix(F, in.p[16] + (size_t)o * 128 * 1024, 1024, 128, 1024, Wb + W_G2T, 128, nullptr, 0, cur);
        cvt_matrix(F, in.p[22] + (size_t)o * 1024 * 1024, 1024, 1024, 1024, Wb + W_OUTO, 1024, nullptr, 0, cur);
    }
    cvt_matrix(F, in.p[23] + (size_t)L * 1024 * FF, FF, 1024, FF, Wb + W_UP, 1024, nullptr, 0, cur);
    cvt_matrix(F, in.p[24] + (size_t)L * FF * 1024, 1024, FF, 1024, Wb + W_DN, FF, nullptr, 0, cur);
}

struct RowPassArgs {
    const float* hsrc; const bf16_t* y; const float* gpost; float* hdst;
    bf16_t* udst; const float* gpre; int upad;
    const float* gate_w; const float* gate_b; float* gates;
};
__device__ __forceinline__ void row_pass(const Frame& F, const RowPassArgs& A) {
    LAS float* GWT = (LAS float*)(F.lds + 65536);
    if (A.gates) {
        for (int idx = F.tid; idx < 8192; idx += NWAVES * 64) { const int k = idx >> 3, j = idx & 7; GWT[j * 1024 + k] = A.gate_w[(size_t)k * PITCH_WIN + NPROJ + j]; }
        __syncthreads();
    }
    f32x4 gp[4], gq[4];
#pragma unroll
    for (int j = 0; j < 4; ++j) { gp[j] = A.gpost ? *(const f32x4*)(A.gpost + 4 * F.lane + 256 * j) : (f32x4){0.f, 0.f, 0.f, 0.f}; gq[j] = A.gpre ? *(const f32x4*)(A.gpre + 4 * F.lane + 256 * j) : (f32x4){0.f, 0.f, 0.f, 0.f}; }
    for (int row = F.gw; row < CM; row += F.NGW) {
        f32x4 hv[4];
#pragma unroll
        for (int j = 0; j < 4; ++j) hv[j] = *(const GAS f32x4*)(A.hsrc + (size_t)row * CD + 4 * F.lane + 256 * j);
        if (A.y) {
            f32x4 yf[4]; float ss = 0.f;
#pragma unroll
            for (int j = 0; j < 4; ++j) { const u32x2 w = ld8(A.y + (size_t)row * CD + 4 * F.lane + 256 * j);
                yf[j] = (f32x4){bf2f((unsigned short)(w.x & 0xffffu)), bf2f((unsigned short)(w.x >> 16)), bf2f((unsigned short)(w.y & 0xffffu)), bf2f((unsigned short)(w.y >> 16))};
                ss += (yf[j][0] * yf[j][0] + yf[j][1] * yf[j][1]) + (yf[j][2] * yf[j][2] + yf[j][3] * yf[j][3]); }
            const float rs = __builtin_amdgcn_rsqf(wave_sum(ss) * (1.0f / CD) + NORM_EPS);
#pragma unroll
            for (int j = 0; j < 4; ++j) { hv[j] += yf[j] * rs * gp[j]; *(GAS f32x4*)(A.hdst + (size_t)row * CD + 4 * F.lane + 256 * j) = hv[j]; }
        }
        if (A.udst) {
            float ss = 0.f;
#pragma unroll
            for (int j = 0; j < 4; ++j) ss += (hv[j][0] * hv[j][0] + hv[j][1] * hv[j][1]) + (hv[j][2] * hv[j][2] + hv[j][3] * hv[j][3]);
            const float rs = __builtin_amdgcn_rsqf(wave_sum(ss) * (1.0f / CD) + NORM_EPS);
            const size_t urow = A.upad ? (size_t)row + (size_t)(row / CS) + 1 : (size_t)row;
            f32x4 uf[4];
#pragma unroll
            for (int j = 0; j < 4; ++j) { uf[j] = hv[j] * rs * gq[j]; *(GAS u32x2*)(A.udst + urow * CD + 4 * F.lane + 256 * j) = pack4(uf[j]); }
            if (A.upad && (row % CS) == 0) {
#pragma unroll
                for (int j = 0; j < 4; ++j) *(GAS u32x2*)(A.udst + (urow - 1) * CD + 4 * F.lane + 256 * j) = (u32x2){0u, 0u};
            }
            if (A.gates) {
                float v[8];
#pragma unroll
                for (int g = 0; g < 8; ++g) { float s = 0.f;
#pragma unroll
                    for (int j = 0; j < 4; ++j) { const f32x4 w = *(const LAS f32x4*)(GWT + g * 1024 + 4 * F.lane + 256 * j); s += (uf[j][0] * w[0] + uf[j][1] * w[1]) + (uf[j][2] * w[2] + uf[j][3] * w[3]); }
                    v[g] = s; }
                const bool b5 = (F.lane & 32) != 0, b4 = (F.lane & 16) != 0, b3 = (F.lane & 8) != 0;
                float r4[4], r2[2];
#pragma unroll
                for (int i = 0; i < 4; ++i) { const float snd = b5 ? v[i] : v[i + 4], kp = b5 ? v[i + 4] : v[i]; r4[i] = kp + __shfl_xor(snd, 32); }
#pragma unroll
                for (int i = 0; i < 2; ++i) { const float snd = b4 ? r4[i] : r4[i + 2], kp = b4 ? r4[i + 2] : r4[i]; r2[i] = kp + __shfl_xor(snd, 16); }
                float r1; { const float snd = b3 ? r2[0] : r2[1], kp = b3 ? r2[1] : r2[0]; r1 = kp + __shfl_xor(snd, 8); }
                r1 += __shfl_xor(r1, 4); r1 += __shfl_xor(r1, 2); r1 += __shfl_xor(r1, 1);
                if ((F.lane & 7) == 0) { const int o = F.lane >> 3; float g = r1 + A.gate_b[o]; if (o >= 4) g = -softplusf(-g); A.gates[(size_t)row * 8 + o] = g; }
            }
        }
    }
}
__device__ __forceinline__ void mix_pass(const Frame& F, const bf16_t* Upad, const float* mu, bf16_t* XR, bf16_t* XK, bf16_t* XV) {
    f32x4 m0[4], m2[4], m3[4];
#pragma unroll
    for (int j = 0; j < 4; ++j) { m0[j] = *(const f32x4*)(mu + 0 * 1024 + 4 * F.lane + 256 * j); m2[j] = *(const f32x4*)(mu + 2 * 1024 + 4 * F.lane + 256 * j); m3[j] = *(const f32x4*)(mu + 3 * 1024 + 4 * F.lane + 256 * j); }
    for (int row = F.gw; row < CM; row += F.NGW) {
        const size_t urow = (size_t)row + (size_t)(row / CS) + 1;
#pragma unroll
        for (int j = 0; j < 4; ++j) {
            const size_t c = 4 * F.lane + 256 * j;
            const u32x2 a = ld8(Upad + urow * CD + c), b = ld8(Upad + (urow - 1) * CD + c);
            const f32x4 u = {bf2f((unsigned short)(a.x & 0xffffu)), bf2f((unsigned short)(a.x >> 16)), bf2f((unsigned short)(a.y & 0xffffu)), bf2f((unsigned short)(a.y >> 16))};
            const f32x4 p = {bf2f((unsigned short)(b.x & 0xffffu)), bf2f((unsigned short)(b.x >> 16)), bf2f((unsigned short)(b.y & 0xffffu)), bf2f((unsigned short)(b.y >> 16))};
            const f32x4 xx = p - u;
            *(GAS u32x2*)(XR + (size_t)row * CD + c) = pack4(u + xx * m0[j]);
            *(GAS u32x2*)(XK + (size_t)row * CD + c) = pack4(u + xx * m2[j]);
            *(GAS u32x2*)(XV + (size_t)row * CD + c) = pack4(u + xx * m3[j]);
        }
    }
}
__device__ __forceinline__ void conv_vt_pass(const Frame& F, const bf16_t* PROJ, const float* convw, bf16_t* QKC, bf16_t* VT) {
    {
        const int cg = F.tid & 127, rs = F.tid >> 7, c0 = 8 * cg;
        float w[4][8];
#pragma unroll
        for (int j = 0; j < 4; ++j) { const f32x4 a = *(const f32x4*)(convw + j * 1024 + c0), b = *(const f32x4*)(convw + j * 1024 + c0 + 4);
#pragma unroll
            for (int q = 0; q < 4; ++q) { w[j][q] = a[q]; w[j][4 + q] = b[q]; } }
        const float osc = (c0 >= 512) ? 0.08838834764831845f : 1.0f;
        for (int ub = blockIdx.x; ub < CM / 64; ub += F.G) {
            const int r0 = ub * 64 + rs * 16;
            u32x4 x0, x1, x2;
            const int tin = r0 % CS;
            const u32x4 zz = {0u, 0u, 0u, 0u};
            x0 = (tin >= 3) ? ld16(PROJ + (size_t)(r0 - 3) * NPROJ + 1536 + c0) : zz;
            x1 = (tin >= 2) ? ld16(PROJ + (size_t)(r0 - 2) * NPROJ + 1536 + c0) : zz;
            x2 = (tin >= 1) ? ld16(PROJ + (size_t)(r0 - 1) * NPROJ + 1536 + c0) : zz;
#pragma unroll 4
            for (int i = 0; i < 16; ++i) {
                const u32x4 x3 = ld16(PROJ + (size_t)(r0 + i) * NPROJ + 1536 + c0);
                u32x4 o;
#pragma unroll
                for (int q = 0; q < 4; ++q) {
                    float acc0 = w[0][2 * q] * bf2f((unsigned short)(x0[q] & 0xffffu)) + w[1][2 * q] * bf2f((unsigned short)(x1[q] & 0xffffu)) + w[2][2 * q] * bf2f((unsigned short)(x2[q] & 0xffffu)) + w[3][2 * q] * bf2f((unsigned short)(x3[q] & 0xffffu));
                    float acc1 = w[0][2 * q + 1] * bf2f((unsigned short)(x0[q] >> 16)) + w[1][2 * q + 1] * bf2f((unsigned short)(x1[q] >> 16)) + w[2][2 * q + 1] * bf2f((unsigned short)(x2[q] >> 16)) + w[3][2 * q + 1] * bf2f((unsigned short)(x3[q] >> 16));
                    acc0 = acc0 * sigmoidf_(acc0) * osc; acc1 = acc1 * sigmoidf_(acc1) * osc;
                    o[q] = pk2(acc0, acc1);
                }
                *(GAS u32x4*)(QKC + (size_t)(r0 + i) * CD + c0) = o;
                x0 = x1; x1 = x2; x2 = x3;
            }
        }
    }
    {
        LAS unsigned char* tile = F.lds + F.wave * 9216;
        for (int it = F.gw; it < CB * 8 * (CS / 64); it += F.NGW) {
            const int bh = it / (CS / 64), tb = it % (CS / 64), b = bh >> 3, h = bh & 7;
            const size_t tok0 = (size_t)b * CS + (size_t)tb * 64;
#pragma unroll
            for (int i = 0; i < 8; ++i) { const int r = 8 * i + (F.lane >> 3), ch = F.lane & 7;
                *(LAS u32x4*)(tile + r * 144 + ch * 16) = ld16(PROJ + (tok0 + r) * NPROJ + 1024 + 64 * h + 8 * ch); }
            LDS_WAIT(); asm volatile("" ::: "memory");
#pragma unroll
            for (int i = 0; i < 8; ++i) { const int pidx = i * 64 + F.lane, d = pidx >> 3, tg = pidx & 7;
                unsigned short e[8];
#pragma unroll
                for (int q = 0; q < 8; ++q) e[q] = *(const LAS unsigned short*)(tile + (8 * tg + q) * 144 + d * 2);
                u32x4 o = {(unsigned)e[0] | ((unsigned)e[1] << 16), (unsigned)e[2] | ((unsigned)e[3] << 16), (unsigned)e[4] | ((unsigned)e[5] << 16), (unsigned)e[6] | ((unsigned)e[7] << 16)};
                *(GAS u32x4*)(VT + ((size_t)bh * 64 + d) * CS + (size_t)tb * 64 + 8 * tg) = o; }
            LDS_WAIT(); asm volatile("" ::: "memory");
        }
    }
}
__device__ __forceinline__ void mixers_even_phase(const Frame& F, const bf16_t* PROJ, const bf16_t* QKC, const bf16_t* VT, const float* GATES, bf16_t* MIXCAT, bf16_t* NUM, float* DEN, float* EMT) {
    const int wg = blockIdx.x;
    if (F.wave == 7) {
        const int b = wg >> 5, mh = (wg >> 3) & 3, sl = wg & 7;
        const size_t r0 = (size_t)b * CS;
        mlstm_stream(QKC + r0 * CD + 128 * mh, QKC + r0 * CD + 512 + 128 * mh, CD, PROJ + r0 * NPROJ + 2560 + 128 * mh + 16 * sl, NPROJ, GATES + r0 * 8, mh, 4 + mh, CS, 0,
                     NUM + r0 * 512 + 128 * mh + 16 * sl, 512, nullptr, nullptr, 4, F.lds);
        return;
    }
    if (F.wave == 6 && wg < 32) {
        const int b = wg >> 2, mh = wg & 3;
        const size_t r0 = (size_t)b * CS;
        mlstm_stream(QKC + r0 * CD + 128 * mh, QKC + r0 * CD + 512 + 128 * mh, CD, nullptr, NPROJ, GATES + r0 * 8, mh, 4 + mh, CS, 1,
                     nullptr, 512, DEN + r0 * 4 + mh, EMT + r0 * 4 + mh, 4, F.lds + 8192);
        return;
    }
    const int worker = (wg < 32) ? wg * 6 + F.wave : 192 + (wg - 32) * 7 + F.wave;
    constexpr int NWORK = 32 * 6 + 224 * 7, NUNIT = CB * 8 * (CS / 32);
    for (int u = worker; u < NUNIT; u += NWORK) {
        const int bh = u / (CS / 32), qb = u % (CS / 32), b = bh >> 3, h = bh & 7;
        const size_t r0 = (size_t)b * CS;
        sb_attn_unit(PROJ + r0 * NPROJ + 64 * h, PROJ + r0 * NPROJ + 512 + 64 * h, NPROJ, VT + (size_t)bh * 64 * CS, CS, MIXCAT + r0 * CD + 64 * h, CD, 32 * qb);
    }
}
__device__ __forceinline__ void mlstm_post_pass(const Frame& F, const bf16_t* NUM, const float* DEN, const float* EMT, const bf16_t* PROJ, const float* head_g, bf16_t* MIXCAT) {
    const int hd = F.lane >> 4;
    f32x4 g0 = *(const f32x4*)(head_g + 8 * F.lane), g1 = *(const f32x4*)(head_g + 8 * F.lane + 4);
    for (int row = F.gw; row < CM; row += F.NGW) {
        const u32x4 nv = ld16(NUM + (size_t)row * 512 + 8 * F.lane), ov = ld16(PROJ + (size_t)row * NPROJ + 3072 + 8 * F.lane);
        const float den = DEN[(size_t)row * 4 + hd], emt = EMT[(size_t)row * 4 + hd];
        const float inv = __builtin_amdgcn_rcpf(fmaxf(fabsf(den), emt));
        float hvv[8]; float ss = 0.f;
#pragma unroll
        for (int q = 0; q < 4; ++q) { hvv[2 * q] = bf2f((unsigned short)(nv[q] & 0xffffu)) * inv; hvv[2 * q + 1] = bf2f((unsigned short)(nv[q] >> 16)) * inv; ss += hvv[2 * q] * hvv[2 * q] + hvv[2 * q + 1] * hvv[2 * q + 1]; }
        ss += __shfl_xor(ss, 1); ss += __shfl_xor(ss, 2); ss += __shfl_xor(ss, 4); ss += __shfl_xor(ss, 8);
        const float rs = __builtin_amdgcn_rsqf(ss * (1.0f / 128.0f) + NORM_EPS);
        u32x4 o;
#pragma unroll
        for (int q = 0; q < 4; ++q) {
            const float ga = (q < 2) ? g0[2 * q] : g1[2 * q - 4], gb = (q < 2) ? g0[2 * q + 1] : g1[2 * q - 3];
            const float a = hvv[2 * q] * rs * ga * sigmoidf_(bf2f((unsigned short)(ov[q] & 0xffffu)));
            const float b = hvv[2 * q + 1] * rs * gb * sigmoidf_(bf2f((unsigned short)(ov[q] >> 16)));
            o[q] = pk2(a, b);
        }
        *(GAS u32x4*)(MIXCAT + (size_t)row * CD + 512 + 8 * F.lane) = o;
    }
}
__device__ __forceinline__ void rwkv_post_unit(const bf16_t* YRAW, const bf16_t* V, const bf16_t* LORA, const bf16_t* G2T, const float* BONUS, const float* ln_g, const float* ln_b, bf16_t* YG, int chunk, int h) {
    const int lane = lane_id(), fr = lane & 15, fq = lane >> 4;
    const size_t row = (size_t)chunk * 16 + fr;
    bf16x8 bg[4];
#pragma unroll
    for (int s = 0; s < 4; ++s) { const u32x4 lg = ld16(LORA + row * 256 + 128 + 32 * s + 8 * fq); u32x4 t;
#pragma unroll
        for (int j = 0; j < 4; ++j) t[j] = pk2(sigmoidf_(bf2f((unsigned short)(lg[j] & 0xffffu))), sigmoidf_(bf2f((unsigned short)(lg[j] >> 16))));
        bg[s] = __builtin_bit_cast(bf16x8, t); }
    float yv[16], gt[16]; float sm = 0.f;
#pragma unroll
    for (int ti = 0; ti < 4; ++ti) {
        f32x4 g = {0.f, 0.f, 0.f, 0.f};
#pragma unroll
        for (int s = 0; s < 4; ++s) g = mfma16(__builtin_bit_cast(bf16x8, ld16(G2T + (size_t)(64 * h + 16 * ti + fr) * 128 + 32 * s + 8 * fq)), bg[s], g);
        const u32x2 y2 = ld8(YRAW + row * CD + 64 * h + 16 * ti + 4 * fq);
        yv[4 * ti] = bf2f((unsigned short)(y2.x & 0xffffu)); yv[4 * ti + 1] = bf2f((unsigned short)(y2.x >> 16)); yv[4 * ti + 2] = bf2f((unsigned short)(y2.y & 0xffffu)); yv[4 * ti + 3] = bf2f((unsigned short)(y2.y >> 16));
#pragma unroll
        for (int i = 0; i < 4; ++i) { gt[4 * ti + i] = g[i]; sm += yv[4 * ti + i]; }
    }
    sm += __shfl_xor(sm, 16); sm += __shfl_xor(sm, 32);
    const float mean = sm * (1.0f / 64.0f); float vs = 0.f;
#pragma unroll
    for (int e = 0; e < 16; ++e) { const float d = yv[e] - mean; vs += d * d; }
    vs += __shfl_xor(vs, 16); vs += __shfl_xor(vs, 32);
    const float rstd = __builtin_amdgcn_rsqf(vs * (1.0f / 64.0f) + GN_EPS);
    const float bon = BONUS[row * 16 + h];
#pragma unroll
    for (int ti = 0; ti < 4; ++ti) {
        const int ch0 = 64 * h + 16 * ti + 4 * fq;
        const f32x4 lg = *(const f32x4*)(ln_g + ch0), lb = *(const f32x4*)(ln_b + ch0);
        const u32x2 v2 = ld8(V + row * CD + ch0);
        const float vv[4] = {bf2f((unsigned short)(v2.x & 0xffffu)), bf2f((unsigned short)(v2.x >> 16)), bf2f((unsigned short)(v2.y & 0xffffu)), bf2f((unsigned short)(v2.y >> 16))};
        f32x4 o;
#pragma unroll
        for (int i = 0; i < 4; ++i) o[i] = ((yv[4 * ti + i] - mean) * rstd * lg[i] + lb[i] + bon * vv[i]) * gt[4 * ti + i];
        *(u32x2*)(YG + row * CD + ch0) = pack4(o);
    }
}

#ifndef PH_MASK
#define PH_MASK 0xFFFFFFFFu
#endif
#define PH(k) ((PH_MASK >> (k)) & 1u)
struct Args { Inputs in; float* out; unsigned char* ws; };
__device__ __forceinline__ Frame make_frame(LAS unsigned char* lds) {
    Frame F; int tid = threadIdx.x; asm volatile("" : "+v"(tid)); int bx = blockIdx.x; asm volatile("" : "+s"(bx));
    F.lds = lds; F.tid = tid; F.lane = tid & 63; F.wave = __builtin_amdgcn_readfirstlane(tid >> 6);
    F.G = gridDim.x; F.vcu = (F.G % 8 == 0) ? (bx % 8) * (F.G / 8) + bx / 8 : bx;
    F.gw = F.vcu * NWAVES + F.wave; F.NGW = F.G * NWAVES; return F;
}
#define PHASE_BEGIN Frame F = make_frame((LAS unsigned char*)lds_raw); unsigned char* ws = args.ws; asm volatile("" : "+s"(ws)); (void)F; \
    bf16_t* Wb = (bf16_t*)(ws + WS_W); bf16_t* U = (bf16_t*)(ws + WS_U); (void)Wb; (void)U;
#define GRID_BAR() do { unsigned char* wsb = args.ws; asm volatile("" : "+s"(wsb)); XcdBarrier bar; bar.bar = (unsigned*)(wsb + WS_CTL) + CW_BAR; bar.x = xb_xcc_id(); \
    bar.st = (volatile LAS unsigned*)((LAS unsigned char*)lds_raw + MISC_OFF) + 8; xcd_barrier(bar); } while (0)
__global__ void __launch_bounds__(NWAVES * 64, 2) hybrid_fwd(Args args) {
    extern __shared__ __attribute__((aligned(16))) unsigned char lds_raw[];
    {
        LAS unsigned char* l3 = (LAS unsigned char*)lds_raw;
        for (int u = threadIdx.x; u < (LDS_BYTES - LDSCTL_OFF) / 4; u += NWAVES * 64) ((LAS unsigned*)(l3 + LDSCTL_OFF))[u] = 0u;
        __syncthreads();
        (void)xcd_barrier_post((unsigned*)(args.ws + WS_CTL) + CW_BAR, (volatile LAS unsigned*)(l3 + MISC_OFF) + 8);
    }
    const Inputs& in = args.in;
    float* HOUT = args.out;
    {
        PHASE_BEGIN
        if (PH(0)) { convert_layer(F, in, Wb, 0); }
        __syncthreads();
        if (PH(1)) { RowPassArgs A{in.p[0], nullptr, nullptr, nullptr, U, in.p[1] + 0, 0, in.p[2], in.p[3], (float*)(ws + WS_GATES)}; row_pass(F, A); }
    }
    GRID_BAR();

    for (int L = 0; L < 4; ++L) {
        if ((L & 1) == 0) {
            const int e = L >> 1;
            if (PH(2)) {
                PHASE_BEGIN
                pg8::ProbPlain<1024, 1024, 16> P{U, Wb + W_IN}; pg8::StaticOrder S; S.init(CM, NPROJ, F.G, (int)blockIdx.x);
                pg8::EpiStore E{(bf16_t*)(ws + WS_PROJ), NPROJ, 0, 0, 0, nullptr};
                pg8::gemm_phase(F.lds, P, S, E);
            }
            GRID_BAR();
            if (PH(3)) { PHASE_BEGIN conv_vt_pass(F, (const bf16_t*)(ws + WS_PROJ), in.p[4] + (size_t)e * 4 * 1024, (bf16_t*)(ws + WS_QKC), (bf16_t*)(ws + WS_VT)); }
            GRID_BAR();
            if (PH(4)) { PHASE_BEGIN mixers_even_phase(F, (const bf16_t*)(ws + WS_PROJ), (const bf16_t*)(ws + WS_QKC), (const bf16_t*)(ws + WS_VT), (const float*)(ws + WS_GATES), U  , (bf16_t*)(ws + WS_NUM), (float*)(ws + WS_DEN), (float*)(ws + WS_EMT)); }
            GRID_BAR();
            if (PH(5)) { PHASE_BEGIN mlstm_post_pass(F, (const bf16_t*)(ws + WS_NUM), (const float*)(ws + WS_DEN), (const float*)(ws + WS_EMT), (const bf16_t*)(ws + WS_PROJ), in.p[5] + (size_t)e * 512, U); }
            GRID_BAR();
        } else {
            const int o = L >> 1;
            if (PH(6)) { PHASE_BEGIN mix_pass(F, U, in.p[7] + (size_t)o * 6 * 1024, (bf16_t*)(ws + WS_XR), (bf16_t*)(ws + WS_XK), (bf16_t*)(ws + WS_XV)); }
            GRID_BAR();
            if (PH(7)) {
                PHASE_BEGIN
                pg8::ProbRkv P{(const bf16_t*)(ws + WS_XR), (size_t)(WS_XK - WS_XR) / 2, Wb + W_RKV, U, Wb + W_LB1, (long)(W_LB2 - W_LB1) * 2};
                pg8::RkvOrder S{(int)blockIdx.x};
                pg8::EpiStore E{(bf16_t*)(ws + WS_RO), 1024, 0, 1, (size_t)(WS_KO - WS_RO) / 2, (bf16_t*)(ws + WS_LORA)};
                pg8::gemm_phase(F.lds, P, S, E);
            }
            GRID_BAR();
            if (PH(8)) {
                PHASE_BEGIN
                RwkvPrepArgs P{(const bf16_t*)(ws + WS_RO), (const bf16_t*)(ws + WS_KO), CD, (const bf16_t*)(ws + WS_LORA), 256, Wb + W_W2T, Wb + W_A2T, in.p[9] + (size_t)o * 1024, in.p[12] + (size_t)o * 1024, in.p[17] + (size_t)o * 1024, in.p[18] + (size_t)o * 1024,
                               in.p[19] + (size_t)o * 1024, (bf16_t*)(ws + WS_KT), (bf16_t*)(ws + WS_BT), (bf16_t*)(ws + WS_KK), (bf16_t*)(ws + WS_RT), (float*)(ws + WS_GL), (float*)(ws + WS_BONUS)};
                for (int u = F.gw; u < (CM / 16) * 16; u += F.NGW) rwkv_prep_unit(P, u >> 4, u & 15);
            }
            GRID_BAR();
            if (PH(9)) {
                PHASE_BEGIN
                if (F.wave < 2) {
                    const int bx = blockIdx.x, bh = bx >> 1, sl = 2 * (bx & 1) + F.wave, b = bh >> 4, h = bh & 15;
                    const size_t r0 = (size_t)b * CS, co = 64 * h;
                    rwkv_scan_stream((const bf16_t*)(ws + WS_KT) + r0 * CD + co, (const bf16_t*)(ws + WS_BT) + r0 * CD + co, (const bf16_t*)(ws + WS_KK) + r0 * CD + co, (const bf16_t*)(ws + WS_RT) + r0 * CD + co,
                                     (const bf16_t*)(ws + WS_VO) + r0 * CD + co + 16 * sl, CD, (const float*)(ws + WS_GL) + (r0 / 16) * 1024 + co, CS, (bf16_t*)(ws + WS_YRAW) + r0 * CD + co + 16 * sl, CD, F.lds + F.wave * 8192);
                }
            }
            GRID_BAR();
            if (PH(10)) {
                PHASE_BEGIN
                for (int u = F.gw; u < (CM / 16) * 16; u += F.NGW)
                    rwkv_post_unit((const bf16_t*)(ws + WS_YRAW), (const bf16_t*)(ws + WS_VO), (const bf16_t*)(ws + WS_LORA), Wb + W_G2T, (const float*)(ws + WS_BONUS), in.p[20] + (size_t)o * 1024, in.p[21] + (size_t)o * 1024, (bf16_t*)(ws + WS_YG), u >> 4, u & 15);
            }
            GRID_BAR();
        }
        if (PH(11)) {
            PHASE_BEGIN
            const bool odd = (L & 1) != 0;
            pg8::ProbPlain<1024, 1024, 16> P{odd ? (const bf16_t*)(ws + WS_YG) : (const bf16_t*)U, Wb + (odd ? W_OUTO : W_OUTE)}; pg8::StaticOrder S; S.init(CM, CD, F.G, (int)blockIdx.x);
            pg8::EpiStore E{(bf16_t*)(ws + WS_MIX), CD, 0, 0, 0, nullptr};
            pg8::gemm_phase(F.lds, P, S, E);
        }
        GRID_BAR();
        if (PH(12)) { PHASE_BEGIN const float* ng = in.p[1] + (size_t)L * 4 * 1024; RowPassArgs A{L == 0 ? in.p[0] : HOUT, (const bf16_t*)(ws + WS_MIX), ng + 1 * 1024, HOUT, U, ng + 2 * 1024, 0, nullptr, nullptr, nullptr}; row_pass(F, A); }
        GRID_BAR();
        if (PH(13)) {
            PHASE_BEGIN
            pg8::ProbPlain<1024, 1024, 16> P{U, Wb + W_UP}; pg8::StaticOrder S; S.init(CM, FF, F.G, (int)blockIdx.x);
            pg8::EpiStore E{(bf16_t*)(ws + WS_HID), FF, 1, 0, 0, nullptr};
            pg8::gemm_phase(F.lds, P, S, E);
        }
        GRID_BAR();
        if (PH(14)) {
            PHASE_BEGIN
            pg8::ProbPlain<FF, FF, 64> P{(const bf16_t*)(ws + WS_HID), Wb + W_DN}; pg8::StaticOrder S; S.init(CM, CD, F.G, (int)blockIdx.x);
            pg8::EpiStore E{(bf16_t*)(ws + WS_FFO), CD, 0, 0, 0, nullptr};
            pg8::gemm_phase(F.lds, P, S, E);
        }
        GRID_BAR();
        if (PH(15)) {
            PHASE_BEGIN
            const float* ng = in.p[1] + (size_t)L * 4 * 1024;
            const bool lastL = (L == 3); const bool next_even = ((L + 1) & 1) == 0;
            if (!lastL) { convert_layer(F, in, Wb, L + 1); }
            __syncthreads();
            const float* ngn = in.p[1] + (size_t)(L + 1) * 4 * 1024;
            const bool gts = !lastL && next_even;
            RowPassArgs A{HOUT, (const bf16_t*)(ws + WS_FFO), ng + 3 * 1024, HOUT, lastL ? nullptr : U, lastL ? nullptr : ngn, next_even ? 0 : 1,
                          gts ? in.p[2] + (size_t)((L + 1) >> 1) * 1024 * PITCH_WIN : nullptr, gts ? in.p[3] + (size_t)((L + 1) >> 1) * 8 : nullptr, gts ? (float*)(ws + WS_GATES) : nullptr};
            row_pass(F, A);
        }
        if (L < 3) GRID_BAR();
    }
}

extern "C" void kernel_launch(void* const* d_in, const int* in_sizes, int n_in, void* d_out, int out_size, void* d_ws, size_t ws_size, hipStream_t stream) {
    static int grid = 0;
    if (grid == 0) {
        if (n_in != 25 || out_size != CM * CD || ws_size < WS_END) { fprintf(stderr, "kernel_launch: unexpected shapes (n_in %d, out %d, ws %zu)\n", n_in, out_size, ws_size); grid = -1; return; }
        int dev = 0, cus = 0, per_cu = 0;
        if (hipGetDevice(&dev) != hipSuccess || hipDeviceGetAttribute(&cus, hipDeviceAttributeMultiprocessorCount, dev) != hipSuccess) { grid = -1; return; }
        if (hipFuncSetAttribute((const void*)hybrid_fwd, hipFuncAttributeMaxDynamicSharedMemorySize, LDS_BYTES) != hipSuccess) { grid = -1; return; }
        if (hipOccupancyMaxActiveBlocksPerMultiprocessor(&per_cu, (const void*)hybrid_fwd, NWAVES * 64, LDS_BYTES) != hipSuccess || per_cu < 1) fprintf(stderr, "kernel_launch: occupancy query reports %d\n", per_cu);
        (void)hipGetLastError();
        grid = cus;
        if (grid != 256) fprintf(stderr, "kernel_launch: %d CUs (the phase deals assume 256)\n", grid);
    }
    if (grid < 0) return;
    if (hipMemsetAsync((char*)d_ws + WS_CTL, 0, CTL_ZERO_BYTES, stream) != hipSuccess) return;
    Args a{};
    for (int i = 0; i < 25; ++i) a.in.p[i] = (const float*)d_in[i];
    a.out = (float*)d_out; a.ws = (unsigned char*)d_ws;
    hipLaunchKernelGGL(hybrid_fwd, dim3(grid), dim3(NWAVES * 64), LDS_BYTES, stream, a);
}
```

```cpp
#include <hip/hip_runtime.h>
#include <cstdio>
#include <cstdint>
typedef short bf16x8 __attribute__((ext_vector_type(8)));
typedef short s16x4 __attribute__((ext_vector_type(4)));
typedef float f32x4 __attribute__((ext_vector_type(4)));
typedef float f32x16 __attribute__((ext_vector_type(16)));
typedef unsigned u32x4 __attribute__((ext_vector_type(4)));
typedef unsigned u32x2 __attribute__((ext_vector_type(2)));
#ifdef HOST_EMU
#define GQ
#define LDSQ
#define DI inline
DI int lane_id() { return emu_lane(); }
DI s16x4 TR16(const LDSQ void* p) { return emu_tr16(p); }
DI unsigned short f2bf(float f) { return (unsigned short)emu_f2bf(f); }
#define MEMFENCE() do {} while (0)
#define WAVE_SYNC() emu_sync()
#else
#define LDSQ __attribute__((address_space(3)))
#define GQ __attribute__((address_space(1)))
#define DI __device__ __forceinline__
typedef short v4i16_t __attribute__((ext_vector_type(4)));
typedef __bf16 bf16x2_t __attribute__((ext_vector_type(2)));
typedef float f32x2_t __attribute__((ext_vector_type(2)));
DI int lane_id() { int l = (int)__builtin_amdgcn_mbcnt_hi(~0u, __builtin_amdgcn_mbcnt_lo(~0u, 0u)); asm volatile("" : "+v"(l)); return l; }
DI s16x4 TR16(const LDSQ void* p) { return __builtin_bit_cast(s16x4, __builtin_amdgcn_ds_read_tr16_b64_v4i16((LDSQ v4i16_t*)p)); }
DI unsigned short f2bf(float f) { f32x2_t v = {f, 0.f}; bf16x2_t b = __builtin_convertvector(v, bf16x2_t); return (unsigned short)(__builtin_bit_cast(unsigned, b) & 0xffffu); }
#define MEMFENCE() asm volatile("" ::: "memory")
#define WAVE_SYNC() do {} while (0)
#endif
typedef unsigned short bf16_t;
#ifdef HOST_EMU
#define ROW_SHR(v, d) ((lane_id() & 15) >= (d) ? __shfl_up((v), (d), 16) : (__shfl_up((v), (d), 16), 0.f))
#else
#define ROW_SHR(v, d) __builtin_bit_cast(float, __builtin_amdgcn_update_dpp(0, __builtin_bit_cast(int, (v)), 0x110 + (d), 0xF, 0xF, true))
#endif
DI float bf2f(unsigned short s) { unsigned u = ((unsigned)s) << 16; return __builtin_bit_cast(float, u); }
DI unsigned pk2(float lo, float hi) {
#ifdef HOST_EMU
    return (unsigned)f2bf(lo) | ((unsigned)f2bf(hi) << 16);
#else
    f32x2_t v = {lo, hi}; bf16x2_t b = __builtin_convertvector(v, bf16x2_t); return __builtin_bit_cast(unsigned, b);
#endif
}
DI f32x4 mfma16(bf16x8 a, bf16x8 b, f32x4 c) { return __builtin_amdgcn_mfma_f32_16x16x32_bf16(a, b, c, 0, 0, 0); }
DI f32x16 mfma32(bf16x8 a, bf16x8 b, f32x16 c) { return __builtin_amdgcn_mfma_f32_32x32x16_bf16(a, b, c, 0, 0, 0); }
DI bf16x8 mk8(u32x2 lo, u32x2 hi) { u32x4 v = {lo.x, lo.y, hi.x, hi.y}; return __builtin_bit_cast(bf16x8, v); }
DI u32x2 pack4(f32x4 v) { u32x2 r = {pk2(v[0], v[1]), pk2(v[2], v[3])}; return r; }
DI u32x2 ld8(const GQ bf16_t* p) { return *(const GQ u32x2*)p; }
DI u32x4 ld16(const GQ bf16_t* p) { return *(const GQ u32x4*)p; }
DI u32x2 tr2(s16x4 v) { return __builtin_bit_cast(u32x2, v); }
DI u32x2 ldl8(const LDSQ unsigned char* p) { return *(const LDSQ u32x2*)p; }
DI float fexp(float x) { return __builtin_amdgcn_exp2f(x * 1.4426950408889634f); }
DI float flog(float x) { return __builtin_amdgcn_logf(x) * 0.6931471805599453f; }
DI float softplusf(float x) { return fmaxf(x, 0.f) + flog(1.0f + fexp(-fabsf(x))); }
DI float sigmoidf_(float x) { return __builtin_amdgcn_rcpf(1.0f + fexp(-x)); }
DI float tanhf_(float x) { const float xc = fminf(fmaxf(x, -15.f), 15.f); const float e = fexp(2.f * xc); return (e - 1.f) * __builtin_amdgcn_rcpf(e + 1.f); }

#define SB_STOP 36.0f
DI int crow32(int i, int h) { return (i & 3) + 8 * (i >> 2) + 4 * h; }
DI void sb_attn_unit(const GQ bf16_t* __restrict__ Q, const GQ bf16_t* __restrict__ K, int ldqk, const GQ bf16_t* __restrict__ VT, int S, GQ bf16_t* __restrict__ O, int ldo, int t0  ) {
    const int lane = lane_id(), r = lane & 31, hi = lane >> 5;
    bf16x8 qf[4];
#pragma unroll
    for (int s = 0; s < 4; ++s) qf[s] = __builtin_bit_cast(bf16x8, ld16(Q + (size_t)(t0 + r) * ldqk + 16 * s + 8 * hi));
    f32x16 o0, o1;
#pragma unroll
    for (int i = 0; i < 16; ++i) { o0[i] = 0.f; o1[i] = 0.f; }
    float carry = 0.f;
    const int tq = t0 + r;
    u32x4 kn[4]; u32x2 vn[8];
    int s0 = t0;
#define SB_LOAD(kd, vd, s0_) do { \
    _Pragma("unroll") for (int s = 0; s < 4; ++s) kd[s] = ld16(K + (size_t)((s0_) + r) * ldqk + 16 * s + 8 * hi); \
    _Pragma("unroll") for (int db = 0; db < 2; ++db) _Pragma("unroll") for (int s = 0; s < 2; ++s) { \
        const GQ bf16_t* vp = VT + (size_t)(32 * db + r) * S + (s0_) + 16 * s + 4 * hi; vd[(db * 2 + s) * 2] = ld8(vp); vd[(db * 2 + s) * 2 + 1] = ld8(vp + 8); } } while (0)
    SB_LOAD(kn, vn, s0);
    for (;;) {
        u32x4 kc[4]; u32x2 vc[8];
#pragma unroll
        for (int s = 0; s < 4; ++s) kc[s] = kn[s];
#pragma unroll
        for (int s = 0; s < 8; ++s) vc[s] = vn[s];
        const int sn = s0 - 32;
        if (sn >= 0) SB_LOAD(kn, vn, sn);
        f32x16 z;
#pragma unroll
        for (int i = 0; i < 16; ++i) z[i] = 0.f;
#pragma unroll
        for (int s = 0; s < 4; ++s) z = mfma32(__builtin_bit_cast(bf16x8, kc[s]), qf[s], z);
        float sp[16];
        const bool diag = (s0 == t0);
#pragma unroll
        for (int i = 0; i < 16; ++i) { z[i] *= 0.125f; const bool valid = !diag || (s0 + crow32(i, hi) < tq); sp[i] = valid ? softplusf(z[i]) : 0.f; if (!valid) z[i] = -1e30f; }
        float gs[4], pg[4];
#pragma unroll
        for (int g = 0; g < 4; ++g) gs[g] = (sp[4 * g] + sp[4 * g + 1]) + (sp[4 * g + 2] + sp[4 * g + 3]);
#pragma unroll
        for (int g = 0; g < 4; ++g) pg[g] = __shfl_xor(gs[g], 32);
        float after[4];
        {
            const float o3 = 0.f, o2 = gs[3], o1_ = gs[3] + gs[2], o0_ = o1_ + gs[1];
            const float p3i = pg[3], p2i = pg[3] + pg[2], p1i = p2i + pg[1], p0i = p1i + pg[0];
            const float pe3 = 0.f, pe2 = p3i, pe1 = p2i, pe0 = p1i;
            after[0] = o0_ + (hi ? pe0 : p0i); after[1] = o1_ + (hi ? pe1 : p1i); after[2] = o2 + (hi ? pe2 : p2i); after[3] = o3 + (hi ? pe3 : p3i);
        }
        const float tot = (gs[0] + gs[1]) + (gs[2] + gs[3]) + (pg[0] + pg[1]) + (pg[2] + pg[3]);
        f32x16 p;
#pragma unroll
        for (int g = 0; g < 4; ++g) {
            float c = carry + after[g];
#pragma unroll
            for (int j = 3; j >= 0; --j) { c += sp[4 * g + j]; p[4 * g + j] = fexp(z[4 * g + j] - c); }
        }
        carry += tot;
#pragma unroll
        for (int s = 0; s < 2; ++s) {
            u32x4 pb = {pk2(p[8 * s], p[8 * s + 1]), pk2(p[8 * s + 2], p[8 * s + 3]), pk2(p[8 * s + 4], p[8 * s + 5]), pk2(p[8 * s + 6], p[8 * s + 7])};
            const bf16x8 pbv = __builtin_bit_cast(bf16x8, pb);
            o0 = mfma32(mk8(vc[(0 * 2 + s) * 2], vc[(0 * 2 + s) * 2 + 1]), pbv, o0);
            o1 = mfma32(mk8(vc[(1 * 2 + s) * 2], vc[(1 * 2 + s) * 2 + 1]), pbv, o1);
        }
        if (sn < 0) break;
        if (__all(carry > SB_STOP)) break;
        s0 = sn;
    }
#undef SB_LOAD
#pragma unroll
    for (int g = 0; g < 4; ++g) {
        u32x2 w0 = {pk2(o0[4 * g], o0[4 * g + 1]), pk2(o0[4 * g + 2], o0[4 * g + 3])};
        u32x2 w1 = {pk2(o1[4 * g], o1[4 * g + 1]), pk2(o1[4 * g + 2], o1[4 * g + 3])};
        GQ bf16_t* op = O + (size_t)(t0 + r) * ldo + 8 * g + 4 * hi;
        *(GQ u32x2*)op = w0; *(GQ u32x2*)(op + 32) = w1;
    }
}

DI void mlstm_stream(const GQ bf16_t* __restrict__ Qp, const GQ bf16_t* __restrict__ Kp, int ldqk, const GQ bf16_t* __restrict__ Vp, int ldv, const GQ float* __restrict__ G, int gi, int gf,
                     int S, int den, GQ bf16_t* __restrict__ NUM, int ldn, GQ float* __restrict__ DEN, GQ float* __restrict__ EMT, int ldd, LDSQ unsigned char* lds) {
    const int lane = lane_id(), fr = lane & 15, fq = lane >> 4;
    LDSQ unsigned char* Kimg = lds;
    LDSQ unsigned char* Vimg = lds + 4096;
    f32x4 C[8];
#pragma unroll
    for (int ci = 0; ci < 8; ++ci) C[ci] = (f32x4){0.f, 0.f, 0.f, 0.f};
    float Fcarry = 0.f, Mcarry = 0.f;
    const int NC = S / 16;
    u32x2 qn[8], kn[8]; u32x4 vn = {0u, 0u, 0u, 0u}; float lin, lfn;
#define ML_LOAD(c_) do { const size_t row = (size_t)(16 * (c_) + fr); \
    _Pragma("unroll") for (int ks = 0; ks < 4; ++ks) { qn[2 * ks] = ld8(Qp + row * ldqk + 32 * ks + 4 * fq); qn[2 * ks + 1] = ld8(Qp + row * ldqk + 32 * ks + 16 + 4 * fq); \
        kn[2 * ks] = ld8(Kp + row * ldqk + 32 * ks + 4 * fq); kn[2 * ks + 1] = ld8(Kp + row * ldqk + 32 * ks + 16 + 4 * fq); } \
    if (!den && lane < 32) vn = ld16(Vp + (size_t)(16 * (c_) + (lane >> 1)) * ldv + 8 * (lane & 1)); \
    lin = G[row * 8 + gi]; lfn = G[row * 8 + gf]; } while (0)
    ML_LOAD(0);
    for (int c = 0; c < NC; ++c) {
        u32x2 qc[8], kc[8]; u32x4 vcur = vn; const float li = lin, lf = lfn;
#pragma unroll
        for (int i = 0; i < 8; ++i) { qc[i] = qn[i]; kc[i] = kn[i]; }
        if (c + 1 < NC) ML_LOAD(c + 1);
        MEMFENCE();
#pragma unroll
        for (int ks = 0; ks < 4; ++ks) { *(LDSQ u32x2*)(Kimg + fr * 256 + (32 * ks + 4 * fq) * 2) = kc[2 * ks]; *(LDSQ u32x2*)(Kimg + fr * 256 + (32 * ks + 16 + 4 * fq) * 2) = kc[2 * ks + 1]; }
        if (den) { if (lane < 32) { u32x4 e0 = {(lane & 1) ? 0u : 0x3F80u, 0u, 0u, 0u}; *(LDSQ u32x4*)(Vimg + (lane >> 1) * 32 + (lane & 1) * 16) = e0; } }
        else { if (lane < 32) *(LDSQ u32x4*)(Vimg + (lane >> 1) * 32 + (lane & 1) * 16) = vcur; }
        MEMFENCE();
        float inc = lf;
#pragma unroll
        for (int d = 1; d < 16; d <<= 1) { const float t = __shfl_up(inc, d, 16); if (fr >= d) inc += t; }
        const float Fg = Fcarry + inc, a = li - Fg;
        float mx = a;
#pragma unroll
        for (int d = 1; d < 16; d <<= 1) { const float t = __shfl_up(mx, d, 16); if (fr >= d) mx = fmaxf(mx, t); }
        const float Mx = fmaxf(Mcarry, mx);
        const float Mend = __shfl(Mx, 15, 16), Ftot = __shfl(inc, 15, 16);
        float as_[4], Mxs[4], Fgs[4];
#pragma unroll
        for (int i = 0; i < 4; ++i) { as_[i] = __shfl(a, 4 * fq + i, 16); Mxs[i] = __shfl(Mx, 4 * fq + i, 16); Fgs[i] = __shfl(Fg, 4 * fq + i, 16); }
        f32x4 st = {0.f, 0.f, 0.f, 0.f};
#pragma unroll
        for (int ks = 0; ks < 4; ++ks) st = mfma16(mk8(kc[2 * ks], kc[2 * ks + 1]), mk8(qc[2 * ks], qc[2 * ks + 1]), st);
        f32x4 pt;
#pragma unroll
        for (int i = 0; i < 4; ++i) pt[i] = (4 * fq + i <= fr) ? st[i] * fexp(as_[i] - Mx) : 0.f;
        const s16x4 v4 = TR16(Vimg + (4 * fq + (fr >> 2)) * 32 + 8 * (fr & 3));
        const u32x2 z2 = {0u, 0u};
        f32x4 numI = mfma16(mk8(pack4(pt), z2), mk8(tr2(v4), z2), (f32x4){0.f, 0.f, 0.f, 0.f});
        f32x4 inter = {0.f, 0.f, 0.f, 0.f};
#pragma unroll
        for (int ks = 0; ks < 4; ++ks) inter = mfma16(mk8(qc[2 * ks], qc[2 * ks + 1]), mk8(pack4(C[2 * ks]), pack4(C[2 * ks + 1])), inter);
        f32x4 num;
#pragma unroll
        for (int i = 0; i < 4; ++i) num[i] = numI[i] + fexp(Mcarry - Mxs[i]) * inter[i];
        if (den) {
            if (fr == 0) {
#pragma unroll
                for (int i = 0; i < 4; ++i) { const size_t row = (size_t)(16 * c + 4 * fq + i); DEN[row * ldd] = num[i]; EMT[row * ldd] = fexp(-(Fgs[i] + Mxs[i])); }
            }
        } else {
#pragma unroll
            for (int i = 0; i < 4; ++i) NUM[(size_t)(16 * c + 4 * fq + i) * ldn + fr] = f2bf(num[i]);
        }
        const float wstate = fexp(Mcarry - Mend);
        f32x4 vw;
#pragma unroll
        for (int i = 0; i < 4; ++i) vw[i] = bf2f((unsigned short)v4[i]) * fexp(as_[i] - Mend);
        const bf16x8 vwb = mk8(pack4(vw), z2);
#pragma unroll
        for (int ci = 0; ci < 8; ++ci) {
            const s16x4 k4 = TR16(Kimg + (4 * fq + (fr >> 2)) * 256 + (16 * ci + 4 * (fr & 3)) * 2);
            C[ci] = mfma16(mk8(tr2(k4), z2), vwb, C[ci] * wstate);
        }
        Mcarry = Mend; Fcarry += Ftot;
        MEMFENCE();
    }
#undef ML_LOAD
}

struct RwkvPrepArgs {
    const GQ bf16_t *R, *K; int ld;
    const GQ bf16_t* LORA; int ldl;
    const GQ bf16_t *W2T, *A2T;
    const GQ float *w0, *a0, *k_k, *k_a, *r_k;
    GQ bf16_t *KT, *BT, *KK, *RT;
    GQ float* GL;
    GQ float* BONUS;
};
struct RwkvPrepIn { u32x4 lw[2], la[2]; u32x2 r2[4], k2[4]; };
DI void rwkv_prep_load(const RwkvPrepArgs& P, int chunk, int h, RwkvPrepIn& I) {
    const int lane = lane_id(), fr = lane & 15, fq = lane >> 4;
    const size_t row = (size_t)chunk * 16 + fr;
#pragma unroll
    for (int s = 0; s < 2; ++s) { I.lw[s] = ld16(P.LORA + row * P.ldl + 32 * s + 8 * fq); I.la[s] = ld16(P.LORA + row * P.ldl + 64 + 32 * s + 8 * fq); }
#pragma unroll
    for (int ti = 0; ti < 4; ++ti) { const int ch0 = 64 * h + 16 * ti + 4 * fq; I.r2[ti] = ld8(P.R + row * P.ld + ch0); I.k2[ti] = ld8(P.K + row * P.ld + ch0); }
}
DI void rwkv_prep_compute(const RwkvPrepArgs& P, int chunk, int h, const RwkvPrepIn& I) {
    const int lane = lane_id(), fr = lane & 15, fq = lane >> 4;
    const size_t row = (size_t)chunk * 16 + fr;
    bf16x8 bw[2], ba[2];
#pragma unroll
    for (int s = 0; s < 2; ++s) {
        u32x4 t;
#pragma unroll
        for (int j = 0; j < 4; ++j) { const unsigned w = I.lw[s][j]; t[j] = pk2(tanhf_(bf2f((unsigned short)(w & 0xffffu))), tanhf_(bf2f((unsigned short)(w >> 16)))); }
        bw[s] = __builtin_bit_cast(bf16x8, t);
        ba[s] = __builtin_bit_cast(bf16x8, I.la[s]);
    }
    float ss = 0.f, bon = 0.f;
    float kap[16], av[16], kp[16], rv[16], ld_[16];
#pragma unroll
    for (int ti = 0; ti < 4; ++ti) {
        const int chl = 16 * ti + fr;
        f32x4 dw = {0.f, 0.f, 0.f, 0.f}, da = {0.f, 0.f, 0.f, 0.f};
#pragma unroll
        for (int s = 0; s < 2; ++s) {
            dw = mfma16(__builtin_bit_cast(bf16x8, ld16(P.W2T + (size_t)(64 * h + chl) * 64 + 32 * s + 8 * fq)), bw[s], dw);
            da = mfma16(__builtin_bit_cast(bf16x8, ld16(P.A2T + (size_t)(64 * h + chl) * 64 + 32 * s + 8 * fq)), ba[s], da);
        }
        const int ch0 = 64 * h + 16 * ti + 4 * fq;
        const u32x2 r2 = I.r2[ti], k2 = I.k2[ti];
        const f32x4 w0v = *(const GQ f32x4*)(P.w0 + ch0), a0v = *(const GQ f32x4*)(P.a0 + ch0), kkv = *(const GQ f32x4*)(P.k_k + ch0), kav = *(const GQ f32x4*)(P.k_a + ch0), rkv = *(const GQ f32x4*)(P.r_k + ch0);
#pragma unroll
        for (int i = 0; i < 4; ++i) {
            const int e = 4 * ti + i;
            const float r = bf2f((unsigned short)((i & 1) ? (r2[i >> 1] >> 16) : (r2[i >> 1] & 0xffffu)));
            const float k = bf2f((unsigned short)((i & 1) ? (k2[i >> 1] >> 16) : (k2[i >> 1] & 0xffffu)));
            const float wl = w0v[i] + dw[i];
            const float logw = -softplusf(-wl) - 0.5f;
            ld_[e] = -fexp(logw);
            const float a = sigmoidf_(a0v[i] + da[i]);
            const float kkr = k * kkv[i];
            ss += kkr * kkr;
            const float k1 = k * (1.0f + (a - 1.0f) * kav[i]);
            bon += r * k1 * rkv[i];
            kap[e] = kkr; av[e] = a; kp[e] = k1; rv[e] = r;
        }
    }
    ss += __shfl_xor(ss, 16); ss += __shfl_xor(ss, 32);
    bon += __shfl_xor(bon, 16); bon += __shfl_xor(bon, 32);
    const float rn = __builtin_amdgcn_rsqf(fmaxf(ss, 1e-24f));
    if (fq == 0) P.BONUS[row * 16 + h] = bon;
#pragma unroll
    for (int ti = 0; ti < 4; ++ti) {
        const int ch0 = 64 * h + 16 * ti + 4 * fq;
        f32x4 okt, obt, okk, ort, ogl;
#pragma unroll
        for (int i = 0; i < 4; ++i) {
            const int e = 4 * ti + i;
            float cs = ld_[e];
            cs += ROW_SHR(cs, 1); cs += ROW_SHR(cs, 2); cs += ROW_SHR(cs, 4); cs += ROW_SHR(cs, 8);
            const float gi = fexp(cs), ginv = __builtin_amdgcn_rcpf(gi);
            float gx = ROW_SHR(gi, 1); if (fr == 0) gx = 1.0f;
            const float kappa = kap[e] * rn;
            okt[i] = kappa * gx; obt[i] = kappa * av[e] * ginv; okk[i] = kp[e] * ginv; ort[i] = rv[e] * gi; ogl[i] = gi;
        }
        *(GQ u32x2*)(P.KT + row * P.ld + ch0) = pack4(okt);
        *(GQ u32x2*)(P.BT + row * P.ld + ch0) = pack4(obt);
        *(GQ u32x2*)(P.KK + row * P.ld + ch0) = pack4(okk);
        *(GQ u32x2*)(P.RT + row * P.ld + ch0) = pack4(ort);
        if (fr == 15) *(GQ f32x4*)(P.GL + (size_t)chunk * 1024 + ch0) = ogl;
    }
}
DI void rwkv_prep_unit(const RwkvPrepArgs& P, int chunk, int h) { RwkvPrepIn I; rwkv_prep_load(P, chunk, h, I); rwkv_prep_compute(P, chunk, h, I); }
constexpr int RPP = 144, RPT = 16 * RPP, RPL = 272, RP_R = 0, RP_K = RPT, RP_L = 2 * RPT, RP_BYTES = 4 * RPT;
DI void rwkv_prep_loop(const RwkvPrepArgs& P, int first, int stride, int nunits, LDSQ unsigned char* scr) {
    if (first >= nunits) return;
    const int lane = lane_id(), fr = lane & 15, fq = lane >> 4, h = first & 15;
    const int lrow = lane >> 3, lpc = lane & 7, qrow = lane >> 4, qpc = lane & 15;
    bf16x8 wA[4][2];
#pragma unroll
    for (int ti = 0; ti < 4; ++ti)
#pragma unroll
        for (int s = 0; s < 2; ++s) wA[ti][s] = __builtin_bit_cast(bf16x8, ld16(P.W2T + (size_t)(64 * h + 16 * ti + fr) * 64 + 32 * s + 8 * fq));
    u32x4 tr_[2], tk_[2], tl_[4];
#define RP_LOAD(u_) do { const size_t r0_ = (size_t)((u_) >> 4) * 16; \
    _Pragma("unroll") for (int hf = 0; hf < 2; ++hf) { tr_[hf] = ld16(P.R + (r0_ + 8 * hf + lrow) * P.ld + 64 * h + 8 * lpc); tk_[hf] = ld16(P.K + (r0_ + 8 * hf + lrow) * P.ld + 64 * h + 8 * lpc); } \
    _Pragma("unroll") for (int g = 0; g < 4; ++g) tl_[g] = ld16(P.LORA + (r0_ + 4 * g + qrow) * P.ldl + 8 * qpc); } while (0)
#define RP_PARK() do { MEMFENCE(); \
    _Pragma("unroll") for (int hf = 0; hf < 2; ++hf) { *(LDSQ u32x4*)(scr + RP_R + (8 * hf + lrow) * RPP + lpc * 16) = tr_[hf]; *(LDSQ u32x4*)(scr + RP_K + (8 * hf + lrow) * RPP + lpc * 16) = tk_[hf]; } \
    _Pragma("unroll") for (int g = 0; g < 4; ++g) *(LDSQ u32x4*)(scr + RP_L + (4 * g + qrow) * RPL + qpc * 16) = tl_[g]; MEMFENCE(); WAVE_SYNC(); } while (0)
    RP_LOAD(first); RP_PARK();
    for (int u = first; u < nunits; u += stride) {
        const int chunk = u >> 4;
        const size_t row = (size_t)chunk * 16 + fr;
        if (u + stride < nunits) RP_LOAD(u + stride);
        bf16x8 bw[2], ba[2];
#pragma unroll
        for (int s = 0; s < 2; ++s) {
            const u32x4 lw = *(const LDSQ u32x4*)(scr + RP_L + fr * RPL + (32 * s + 8 * fq) * 2); u32x4 t;
#pragma unroll
            for (int j = 0; j < 4; ++j) { const unsigned w = lw[j]; t[j] = pk2(tanhf_(bf2f((unsigned short)(w & 0xffffu))), tanhf_(bf2f((unsigned short)(w >> 16)))); }
            bw[s] = __builtin_bit_cast(bf16x8, t);
            ba[s] = __builtin_bit_cast(bf16x8, *(const LDSQ u32x4*)(scr + RP_L + fr * RPL + (64 + 32 * s + 8 * fq) * 2));
        }
        u32x2 r2a[4], k2a[4];
#pragma unroll
        for (int ti = 0; ti < 4; ++ti) { r2a[ti] = ldl8(scr + RP_R + fr * RPP + (16 * ti + 4 * fq) * 2); k2a[ti] = ldl8(scr + RP_K + fr * RPP + (16 * ti + 4 * fq) * 2); }
        MEMFENCE(); WAVE_SYNC();
        float ss = 0.f, bon = 0.f;
        float kap[16], av[16], kp[16], ld_[16];
#pragma unroll
        for (int ti = 0; ti < 4; ++ti) {
            f32x4 dw = {0.f, 0.f, 0.f, 0.f}, da = {0.f, 0.f, 0.f, 0.f};
#pragma unroll
            for (int s = 0; s < 2; ++s) { dw = mfma16(wA[ti][s], bw[s], dw); da = mfma16(__builtin_bit_cast(bf16x8, ld16(P.A2T + (size_t)(64 * h + 16 * ti + fr) * 64 + 32 * s + 8 * fq)), ba[s], da); }
            const int ch0 = 64 * h + 16 * ti + 4 * fq;
            const u32x2 r2 = r2a[ti], k2 = k2a[ti];
            const f32x4 w0v = *(const GQ f32x4*)(P.w0 + ch0), a0v = *(const GQ f32x4*)(P.a0 + ch0), kkv = *(const GQ f32x4*)(P.k_k + ch0), kav = *(const GQ f32x4*)(P.k_a + ch0), rkv = *(const GQ f32x4*)(P.r_k + ch0);
#pragma unroll
            for (int i = 0; i < 4; ++i) {
                const int e = 4 * ti + i;
                const float r = bf2f((unsigned short)((i & 1) ? (r2[i >> 1] >> 16) : (r2[i >> 1] & 0xffffu)));
                const float k = bf2f((unsigned short)((i & 1) ? (k2[i >> 1] >> 16) : (k2[i >> 1] & 0xffffu)));
                ld_[e] = -0.6065306597126334f * sigmoidf_(w0v[i] + dw[i]);
                const float a = sigmoidf_(a0v[i] + da[i]);
                const float kkr = k * kkv[i];
                ss += kkr * kkr;
                const float k1 = k * (1.0f + (a - 1.0f) * kav[i]);
                bon += r * k1 * rkv[i];
                kap[e] = kkr; av[e] = a; kp[e] = k1;
            }
        }
        ss += __shfl_xor(ss, 16); ss += __shfl_xor(ss, 32);
        bon += __shfl_xor(bon, 16); bon += __shfl_xor(bon, 32);
        const float rn = __builtin_amdgcn_rsqf(fmaxf(ss, 1e-24f));
        if (fq == 0) P.BONUS[row * 16 + h] = bon;
#pragma unroll
        for (int ti = 0; ti < 4; ++ti) {
            f32x4 okt, obt, okk, ort, ogl;
#pragma unroll
            for (int i = 0; i < 4; ++i) {
                const int e = 4 * ti + i;
                float cs = ld_[e];
                cs += ROW_SHR(cs, 1); cs += ROW_SHR(cs, 2); cs += ROW_SHR(cs, 4); cs += ROW_SHR(cs, 8);
                const float gi = fexp(cs), ginv = __builtin_amdgcn_rcpf(gi);
                float gx = ROW_SHR(gi, 1); if (fr == 0) gx = 1.0f;
                const float kappa = kap[e] * rn;
                const float rr_ = bf2f((unsigned short)((i & 1) ? (r2a[ti][i >> 1] >> 16) : (r2a[ti][i >> 1] & 0xffffu)));
                okt[i] = kappa * gx; obt[i] = kappa * av[e] * ginv; okk[i] = kp[e] * ginv; ort[i] = rr_ * gi; ogl[i] = gi;
            }
            const int o = fr * RPP + (16 * ti + 4 * fq) * 2;
            *(LDSQ u32x2*)(scr + 0 * RPT + o) = pack4(okt); *(LDSQ u32x2*)(scr + 1 * RPT + o) = pack4(obt); *(LDSQ u32x2*)(scr + 2 * RPT + o) = pack4(okk); *(LDSQ u32x2*)(scr + 3 * RPT + o) = pack4(ort);
            if (fr == 15) *(GQ f32x4*)(P.GL + (size_t)chunk * 1024 + 64 * h + 16 * ti + 4 * fq) = ogl;
        }
        MEMFENCE(); WAVE_SYNC();
#pragma unroll
        for (int hf = 0; hf < 2; ++hf) {
            const size_t go = ((size_t)chunk * 16 + 8 * hf + lrow) * P.ld + 64 * h + 8 * lpc; const int lo = (8 * hf + lrow) * RPP + lpc * 16;
            *(GQ u32x4*)(P.KT + go) = *(const LDSQ u32x4*)(scr + 0 * RPT + lo); *(GQ u32x4*)(P.BT + go) = *(const LDSQ u32x4*)(scr + 1 * RPT + lo);
            *(GQ u32x4*)(P.KK + go) = *(const LDSQ u32x4*)(scr + 2 * RPT + lo); *(GQ u32x4*)(P.RT + go) = *(const LDSQ u32x4*)(scr + 3 * RPT + lo);
        }
        MEMFENCE(); WAVE_SYNC();
        if (u + stride < nunits) RP_PARK();
    }
#undef RP_LOAD
#undef RP_PARK
}

DI void rwkv_post_loop(const GQ bf16_t* __restrict__ YRAW, const GQ bf16_t* __restrict__ V, const GQ bf16_t* __restrict__ LORA, const GQ bf16_t* __restrict__ G2T, const GQ float* __restrict__ BONUS,
                       const GQ float* __restrict__ ln_g, const GQ float* __restrict__ ln_b, GQ bf16_t* __restrict__ YG, int ld, int first, int stride, int nunits, LDSQ unsigned char* scr) {
    if (first >= nunits) return;
    const int lane = lane_id(), fr = lane & 15, fq = lane >> 4, h = first & 15;
    const int lrow = lane >> 3, lpc = lane & 7, qrow = lane >> 4, qpc = lane & 15;
    bf16x8 gA[2][4];
#pragma unroll
    for (int ti = 0; ti < 2; ++ti)
#pragma unroll
        for (int s = 0; s < 4; ++s) gA[ti][s] = __builtin_bit_cast(bf16x8, ld16(G2T + (size_t)(64 * h + 16 * ti + fr) * 128 + 32 * s + 8 * fq));
    u32x4 ty_[2], tv_[2], tl_[4]; float bonn = 0.f;
#define PO_LOAD(u_) do { const size_t r0_ = (size_t)((u_) >> 4) * 16; \
    _Pragma("unroll") for (int hf = 0; hf < 2; ++hf) { ty_[hf] = ld16(YRAW + (r0_ + 8 * hf + lrow) * ld + 64 * h + 8 * lpc); tv_[hf] = ld16(V + (r0_ + 8 * hf + lrow) * ld + 64 * h + 8 * lpc); } \
    _Pragma("unroll") for (int g = 0; g < 4; ++g) tl_[g] = ld16(LORA + (r0_ + 4 * g + qrow) * 256 + 128 + 8 * qpc); \
    bonn = BONUS[(r0_ + fr) * 16 + h]; } while (0)
#define PO_PARK() do { MEMFENCE(); \
    _Pragma("unroll") for (int hf = 0; hf < 2; ++hf) { *(LDSQ u32x4*)(scr + RP_R + (8 * hf + lrow) * RPP + lpc * 16) = ty_[hf]; *(LDSQ u32x4*)(scr + RP_K + (8 * hf + lrow) * RPP + lpc * 16) = tv_[hf]; } \
    _Pragma("unroll") for (int g = 0; g < 4; ++g) *(LDSQ u32x4*)(scr + RP_L + (4 * g + qrow) * RPL + qpc * 16) = tl_[g]; MEMFENCE(); WAVE_SYNC(); } while (0)
    PO_LOAD(first); PO_PARK();
    for (int u = first; u < nunits; u += stride) {
        const int chunk = u >> 4;
        const float bon = bonn;
        if (u + stride < nunits) PO_LOAD(u + stride);
        bf16x8 bg[4];
#pragma unroll
        for (int s = 0; s < 4; ++s) { const u32x4 lg = *(const LDSQ u32x4*)(scr + RP_L + fr * RPL + (32 * s + 8 * fq) * 2); u32x4 t;
#pragma unroll
            for (int j = 0; j < 4; ++j) t[j] = pk2(sigmoidf_(bf2f((unsigned short)(lg[j] & 0xffffu))), sigmoidf_(bf2f((unsigned short)(lg[j] >> 16))));
            bg[s] = __builtin_bit_cast(bf16x8, t); }
        u32x2 y2a[4], v2a[4];
#pragma unroll
        for (int ti = 0; ti < 4; ++ti) { y2a[ti] = ldl8(scr + RP_R + fr * RPP + (16 * ti + 4 * fq) * 2); v2a[ti] = ldl8(scr + RP_K + fr * RPP + (16 * ti + 4 * fq) * 2); }
        MEMFENCE(); WAVE_SYNC();
        float yv[16], gt[16]; float sm = 0.f;
#pragma unroll
        for (int ti = 0; ti < 4; ++ti) {
            f32x4 g = {0.f, 0.f, 0.f, 0.f};
#pragma unroll
            for (int s = 0; s < 4; ++s) g = mfma16(ti < 2 ? gA[ti & 1][s] : __builtin_bit_cast(bf16x8, ld16(G2T + (size_t)(64 * h + 16 * ti + fr) * 128 + 32 * s + 8 * fq)), bg[s], g);
            const u32x2 y2 = y2a[ti];
            yv[4 * ti] = bf2f((unsigned short)(y2.x & 0xffffu)); yv[4 * ti + 1] = bf2f((unsigned short)(y2.x >> 16)); yv[4 * ti + 2] = bf2f((unsigned short)(y2.y & 0xffffu)); yv[4 * ti + 3] = bf2f((unsigned short)(y2.y >> 16));
#pragma unroll
            for (int i = 0; i < 4; ++i) { gt[4 * ti + i] = g[i]; sm += yv[4 * ti + i]; }
        }
        sm += __shfl_xor(sm, 16); sm += __shfl_xor(sm, 32);
        const float mean = sm * (1.0f / 64.0f); float vs = 0.f;
#pragma unroll
        for (int e2 = 0; e2 < 16; ++e2) { const float d = yv[e2] - mean; vs += d * d; }
        vs += __shfl_xor(vs, 16); vs += __shfl_xor(vs, 32);
        const float rstd = __builtin_amdgcn_rsqf(vs * (1.0f / 64.0f) + 64e-5f);
#pragma unroll
        for (int ti = 0; ti < 4; ++ti) {
            const int ch0 = 64 * h + 16 * ti + 4 * fq;
            const f32x4 lg = *(const GQ f32x4*)(ln_g + ch0), lb = *(const GQ f32x4*)(ln_b + ch0);
            const u32x2 v2 = v2a[ti];
            const float vv[4] = {bf2f((unsigned short)(v2.x & 0xffffu)), bf2f((unsigned short)(v2.x >> 16)), bf2f((unsigned short)(v2.y & 0xffffu)), bf2f((unsigned short)(v2.y >> 16))};
            f32x4 o;
#pragma unroll
            for (int i = 0; i < 4; ++i) o[i] = ((yv[4 * ti + i] - mean) * rstd * lg[i] + lb[i] + bon * vv[i]) * gt[4 * ti + i];
            *(LDSQ u32x2*)(scr + fr * RPP + (16 * ti + 4 * fq) * 2) = pack4(o);
        }
        MEMFENCE(); WAVE_SYNC();
#pragma unroll
        for (int hf = 0; hf < 2; ++hf) *(GQ u32x4*)(YG + ((size_t)chunk * 16 + 8 * hf + lrow) * ld + 64 * h + 8 * lpc) = *(const LDSQ u32x4*)(scr + (8 * hf + lrow) * RPP + lpc * 16);
        MEMFENCE(); WAVE_SYNC();
        if (u + stride < nunits) PO_PARK();
    }
#undef PO_LOAD
#undef PO_PARK
}

DI bf16x8 pk_lo(f32x4 v) { const u32x2 z2 = {0u, 0u}; return mk8(pack4(v), z2); }
DI f32x4 mm16(f32x4 accPT, f32x4 accQ) { return mfma16(pk_lo(accPT), pk_lo(accQ), (f32x4){0.f, 0.f, 0.f, 0.f}); }
DI void rwkv_scan_stream(const GQ bf16_t* __restrict__ KT, const GQ bf16_t* __restrict__ BT, const GQ bf16_t* __restrict__ KK, const GQ bf16_t* __restrict__ RT, const GQ bf16_t* __restrict__ V, int ld,
                         const GQ float* __restrict__ GL, int S, GQ bf16_t* __restrict__ Y, int ldy, LDSQ unsigned char* lds) {
    const int lane = lane_id(), fr = lane & 15, fq = lane >> 4;
    LDSQ unsigned char* BTimg = lds;
    LDSQ unsigned char* KKimg = lds + 2048;
    LDSQ unsigned char* Vimg = lds + 4096;
    f32x4 H[4];
#pragma unroll
    for (int ci = 0; ci < 4; ++ci) H[ci] = (f32x4){0.f, 0.f, 0.f, 0.f};
    const int NC = S / 16;
    u32x2 ktn[4], btn[4], kkn[4], rtn[4]; u32x4 vn = {0u, 0u, 0u, 0u}; f32x4 gln[4];
#define RW_LOAD(c_) do { const size_t row = (size_t)(16 * (c_) + fr); \
    _Pragma("unroll") for (int s = 0; s < 2; ++s) _Pragma("unroll") for (int q = 0; q < 2; ++q) { const size_t o = row * ld + 32 * s + 16 * q + 4 * fq; \
        ktn[2 * s + q] = ld8(KT + o); btn[2 * s + q] = ld8(BT + o); kkn[2 * s + q] = ld8(KK + o); rtn[2 * s + q] = ld8(RT + o); } \
    if (lane < 32) vn = ld16(V + (size_t)(16 * (c_) + (lane >> 1)) * ld + 8 * (lane & 1)); \
    _Pragma("unroll") for (int ci = 0; ci < 4; ++ci) gln[ci] = *(const GQ f32x4*)(GL + (size_t)(c_) * 1024 + 16 * ci + 4 * fq); } while (0)
    RW_LOAD(0);
    const bool dg[4] = {4 * fq + 0 == fr, 4 * fq + 1 == fr, 4 * fq + 2 == fr, 4 * fq + 3 == fr};
    for (int c = 0; c < NC; ++c) {
        u32x2 kt[4], bt[4], kk[4], rt[4]; const u32x4 vcur = vn; f32x4 gl[4];
#pragma unroll
        for (int i = 0; i < 4; ++i) { kt[i] = ktn[i]; bt[i] = btn[i]; kk[i] = kkn[i]; rt[i] = rtn[i]; gl[i] = gln[i]; }
        if (c + 1 < NC) RW_LOAD(c + 1);
        MEMFENCE();
#pragma unroll
        for (int s = 0; s < 2; ++s)
#pragma unroll
            for (int q = 0; q < 2; ++q) { const int off = fr * 128 + (32 * s + 16 * q + 4 * fq) * 2; *(LDSQ u32x2*)(BTimg + off) = bt[2 * s + q]; *(LDSQ u32x2*)(KKimg + off) = kk[2 * s + q]; }
        if (lane < 32) *(LDSQ u32x4*)(Vimg + (lane >> 1) * 32 + (lane & 1) * 16) = vcur;
        MEMFENCE();
        const f32x4 z4 = {0.f, 0.f, 0.f, 0.f};
        f32x4 x1 = z4, x2 = z4, akt = z4, arbt = z4, arkt = z4;
#pragma unroll
        for (int s = 0; s < 2; ++s) {
            const bf16x8 fkt = mk8(kt[2 * s], kt[2 * s + 1]), fbt = mk8(bt[2 * s], bt[2 * s + 1]), fkk = mk8(kk[2 * s], kk[2 * s + 1]), frt = mk8(rt[2 * s], rt[2 * s + 1]);
            x1 = mfma16(fbt, fkt, x1);
            x2 = mfma16(fkt, fbt, x2);
            akt = mfma16(fkk, fkt, akt);
            arbt = mfma16(fbt, frt, arbt);
            arkt = mfma16(fkk, frt, arkt);
        }
        f32x4 yT, y_;
#pragma unroll
        for (int i = 0; i < 4; ++i) {
            const int rr = 4 * fq + i;
            yT[i] = (rr < fr) ? -x1[i] : 0.f;
            y_[i] = (fr < rr) ? -x2[i] : 0.f;
            akt[i] = (rr < fr) ? akt[i] : 0.f;
            arbt[i] = (rr <= fr) ? arbt[i] : 0.f;
            arkt[i] = (rr <= fr) ? arkt[i] : 0.f;
        }
#define IA(x) ((f32x4){(x)[0] + (dg[0] ? 1.f : 0.f), (x)[1] + (dg[1] ? 1.f : 0.f), (x)[2] + (dg[2] ? 1.f : 0.f), (x)[3] + (dg[3] ? 1.f : 0.f)})
        const f32x4 y2 = mm16(yT, y_), y2T = mm16(y_, yT);
        const f32x4 y4 = mm16(y2T, y2), y4T = mm16(y2, y2T);
        const f32x4 y8T = mm16(y4, y4T);
        const f32x4 w1 = mm16(IA(y_), IA(y2T)), w1T = mm16(IA(yT), IA(y2));
        const f32x4 w2 = mm16(w1T, IA(y4T)), w2T = mm16(w1, IA(y4));
        const f32x4 tT = mm16(w2T, IA(y8T));
#undef IA
        const bf16x8 hb0 = mk8(pack4(H[0]), pack4(H[1])), hb1 = mk8(pack4(H[2]), pack4(H[3]));
        const s16x4 v4 = TR16(Vimg + (4 * fq + (fr >> 2)) * 32 + 8 * (fr & 3));
        const u32x2 z2 = {0u, 0u};
        f32x4 g = mfma16(mk8(kt[0], kt[1]), hb0, z4);
        g = mfma16(mk8(kt[2], kt[3]), hb1, g);
        g = mfma16(pk_lo(akt), mk8(tr2(v4), z2), g);
        const f32x4 tg = mfma16(pk_lo(tT), pk_lo(g), z4);
        const f32x4 u = -tg;
        f32x4 yo = mfma16(mk8(rt[0], rt[1]), hb0, z4);
        yo = mfma16(mk8(rt[2], rt[3]), hb1, yo);
        const bf16x8 uv = mk8(pack4(u), tr2(v4));
        yo = mfma16(mk8(pack4(arbt), pack4(arkt)), uv, yo);
#pragma unroll
        for (int i = 0; i < 4; ++i) Y[(size_t)(16 * c + 4 * fq + i) * ldy + fr] = f2bf(yo[i]);
#pragma unroll
        for (int ci = 0; ci < 4; ++ci) {
            const int off = (4 * fq + (fr >> 2)) * 128 + (16 * ci + 4 * (fr & 3)) * 2;
            const s16x4 b4 = TR16(BTimg + off), k4 = TR16(KKimg + off);
            H[ci] = mfma16(mk8(tr2(b4), tr2(k4)), uv, H[ci]) * gl[ci];
        }
        MEMFENCE();
    }
#undef RW_LOAD
}

#ifdef HOST_EMU
DI unsigned flag_ld(const LDSQ unsigned* p) { return __atomic_load_n(p, __ATOMIC_ACQUIRE); }
DI void flag_st(LDSQ unsigned* p, unsigned v) { emu_sync(); __atomic_store_n(p, v, __ATOMIC_RELEASE); }
DI void spin_pause() { std::this_thread::yield(); }
#else
DI unsigned flag_ld(const LDSQ unsigned* p) { unsigned v; asm volatile("ds_read_b32 %0, %1\n\ts_waitcnt lgkmcnt(0)" : "=v"(v) : "v"((unsigned)(size_t)p) : "memory"); return v; }
DI void flag_st(LDSQ unsigned* p, unsigned v) { asm volatile("ds_write_b32 %0, %1" :: "v"((unsigned)(size_t)p), "v"(v) : "memory"); }
DI void spin_pause() { asm volatile("s_nop 7"); }
#endif
#define COOP_SPIN_CAP (1u << 24)
#if defined(COOP_PROBE) && !defined(HOST_EMU)
DI void wait_ge_t(const LDSQ unsigned* p, unsigned want, LDSQ unsigned* acc) { const unsigned long long t0 = __builtin_amdgcn_s_memrealtime(); unsigned n = 0; while (flag_ld(p) < want) { spin_pause(); if (++n > COOP_SPIN_CAP) break; } MEMFENCE();
    const unsigned dt = (unsigned)(__builtin_amdgcn_s_memrealtime() - t0); if (lane_id() == 0) *acc += dt; }
#else
#define wait_ge_t(p, want, acc) wait_ge(p, want)
#endif
DI void wait_ge(const LDSQ unsigned* p, unsigned want) { unsigned n = 0; while (flag_ld(p) < want) { spin_pause(); if (++n > COOP_SPIN_CAP) break; } MEMFENCE(); }

#if defined(SEG_PROBE) && !defined(HOST_EMU)
#define SEG_STAMP(i) do { if (wave == 0) { const unsigned now_ = (unsigned)__builtin_amdgcn_s_memrealtime(); if (lane == 0) ready[40 + (i)] += now_ - seg_last_; seg_last_ = now_; } } while (0)
#else
#define SEG_STAMP(i) do {} while (0)
#endif
constexpr int RWP = 144, RWTS = 16 * RWP;
constexpr int RWT_KT = 0, RWT_BT = RWTS, RWT_KK = 2 * RWTS, RWT_RT = 3 * RWTS, RWT_V = 4 * RWTS, RWT_GL = 5 * RWTS, RWT_TT = RWT_GL + 256, RWT_AK = RWT_TT + 512, RWT_ARB = RWT_AK + 512, RWT_Y = RWT_ARB + 1024;
constexpr int RWS_SLOT = RWT_Y + RWTS, RWS_NSLOT = 8, RWS_FLAGS = RWS_SLOT * RWS_NSLOT, RWS_LDS = RWS_FLAGS + 256;
DI void rwkv_scan_coop(int wave, const GQ bf16_t* __restrict__ KT, const GQ bf16_t* __restrict__ BT, const GQ bf16_t* __restrict__ KK, const GQ bf16_t* __restrict__ RT, const GQ bf16_t* __restrict__ V, int ld,
                       const GQ float* __restrict__ GL, int S, GQ bf16_t* __restrict__ Y, int ldy, LDSQ unsigned char* lds) {
    const int lane = lane_id(), fr = lane & 15, fq = lane >> 4;
    const int NC = S / 16;
    LDSQ unsigned* ready = (LDSQ unsigned*)(lds + RWS_FLAGS);
    LDSQ unsigned* done = ready + 16;
    const u32x2 z2 = {0u, 0u};
    const f32x4 z4 = {0.f, 0.f, 0.f, 0.f};
    if (wave < 4) {
#ifndef HOST_EMU
        __builtin_amdgcn_s_setprio(3);
#endif
        f32x4 H[4];
#pragma unroll
        for (int ci = 0; ci < 4; ++ci) H[ci] = z4;
        for (int c = 0; c < NC; ++c) {
            LDSQ unsigned char* slot = lds + (c & (RWS_NSLOT - 1)) * RWS_SLOT;
            wait_ge_t(ready + (c & (RWS_NSLOT - 1)), (unsigned)c + 1u, ready + 32 + wave);
            u32x2 kt[4], rt[4];
#pragma unroll
            for (int s = 0; s < 2; ++s)
#pragma unroll
                for (int q = 0; q < 2; ++q) { const int o = fr * RWP + (32 * s + 16 * q + 4 * fq) * 2; kt[2 * s + q] = ldl8(slot + RWT_KT + o); rt[2 * s + q] = ldl8(slot + RWT_RT + o); }
            const u32x2 tT = ldl8(slot + RWT_TT + lane * 8), ak = ldl8(slot + RWT_AK + lane * 8);
            const u32x4 arbk = *(const LDSQ u32x4*)(slot + RWT_ARB + lane * 16);
            f32x4 gl[4];
#pragma unroll
            for (int ci = 0; ci < 4; ++ci) gl[ci] = *(const LDSQ f32x4*)(slot + RWT_GL + (16 * ci + 4 * fq) * 4);
            const s16x4 v4 = TR16(slot + RWT_V + (4 * fq + (fr >> 2)) * RWP + (16 * wave + 4 * (fr & 3)) * 2);
            s16x4 b4[4], k4[4];
#pragma unroll
            for (int ci = 0; ci < 4; ++ci) { const int off = (4 * fq + (fr >> 2)) * RWP + (16 * ci + 4 * (fr & 3)) * 2; b4[ci] = TR16(slot + RWT_BT + off); k4[ci] = TR16(slot + RWT_KK + off); }
            const bf16x8 hb0 = mk8(pack4(H[0]), pack4(H[1])), hb1 = mk8(pack4(H[2]), pack4(H[3]));
            f32x4 g = mfma16(mk8(kt[0], kt[1]), hb0, z4);
            g = mfma16(mk8(kt[2], kt[3]), hb1, g);
            g = mfma16(mk8(ak, z2), mk8(tr2(v4), z2), g);
            const f32x4 tg = mfma16(mk8(tT, z2), pk_lo(g), z4);
            const f32x4 u = -tg;
            f32x4 yo = mfma16(mk8(rt[0], rt[1]), hb0, z4);
            yo = mfma16(mk8(rt[2], rt[3]), hb1, yo);
            const bf16x8 uv = mk8(pack4(u), tr2(v4));
            yo = mfma16(__builtin_bit_cast(bf16x8, arbk), uv, yo);
#pragma unroll
            for (int i = 0; i < 4; ++i) *(LDSQ unsigned short*)(slot + RWT_Y + (4 * fq + i) * RWP + (16 * wave + fr) * 2) = f2bf(yo[i]);
#pragma unroll
            for (int ci = 0; ci < 4; ++ci) H[ci] = mfma16(mk8(tr2(b4[ci]), tr2(k4[ci])), uv, H[ci]) * gl[ci];
            flag_st(done + wave, (unsigned)c + 1u);
        }
    } else {
#ifndef HOST_EMU
        __builtin_amdgcn_s_setprio(0);
#endif
        const int p = wave - 4;
        const int lrow = lane >> 3, lpc = lane & 7;
        u32x4 tn[5][2]; float gln = 0.f;
#define RWP_LOAD(c_) do { _Pragma("unroll") for (int hf = 0; hf < 2; ++hf) { const size_t o = (size_t)(16 * (c_) + 8 * hf + lrow) * ld + 8 * lpc; \
        tn[0][hf] = ld16(KT + o); tn[1][hf] = ld16(BT + o); tn[2][hf] = ld16(KK + o); tn[3][hf] = ld16(RT + o); tn[4][hf] = ld16(V + o); } \
    gln = GL[(size_t)(c_) * 1024 + lane]; } while (0)
#define RWP_FLUSH(cc_) do { const u32x4 y0 = *(const LDSQ u32x4*)(slot + RWT_Y + lrow * RWP + lpc * 16), y1 = *(const LDSQ u32x4*)(slot + RWT_Y + (8 + lrow) * RWP + lpc * 16); \
    *(GQ u32x4*)(Y + (size_t)(16 * (cc_) + lrow) * ldy + 8 * lpc) = y0; *(GQ u32x4*)(Y + (size_t)(16 * (cc_) + 8 + lrow) * ldy + 8 * lpc) = y1; MEMFENCE(); } while (0)
        const bool dg[4] = {4 * fq + 0 == fr, 4 * fq + 1 == fr, 4 * fq + 2 == fr, 4 * fq + 3 == fr};
#define RWP_PARK(cc_) do { LDSQ unsigned char* ps_ = lds + ((cc_) & (RWS_NSLOT - 1)) * RWS_SLOT; \
        if ((cc_) >= RWS_NSLOT) { const unsigned want_ = (unsigned)((cc_) - RWS_NSLOT + 1); wait_ge(done + 0, want_); wait_ge(done + 1, want_); wait_ge(done + 2, want_); wait_ge(done + 3, want_); \
            { LDSQ unsigned char* slot = ps_; RWP_FLUSH((cc_) - RWS_NSLOT); } } \
        MEMFENCE(); \
        _Pragma("unroll") for (int a = 0; a < 5; ++a) _Pragma("unroll") for (int hf = 0; hf < 2; ++hf) *(LDSQ u32x4*)(ps_ + a * RWTS + (8 * hf + lrow) * RWP + lpc * 16) = tn[a][hf]; \
        *(LDSQ float*)(ps_ + RWT_GL + lane * 4) = gln; MEMFENCE(); WAVE_SYNC(); } while (0)
        if (p < NC) { RWP_LOAD(p); RWP_PARK(p); }
        for (int c = p; c < NC; c += 4) {
            if (c + 4 < NC) RWP_LOAD(c + 4);
            LDSQ unsigned char* slot = lds + (c & (RWS_NSLOT - 1)) * RWS_SLOT;
            u32x2 kt[4], bt[4], kk[4], rt[4];
#pragma unroll
            for (int s = 0; s < 2; ++s)
#pragma unroll
                for (int q = 0; q < 2; ++q) { const int o = fr * RWP + (32 * s + 16 * q + 4 * fq) * 2;
                    kt[2 * s + q] = ldl8(slot + RWT_KT + o); bt[2 * s + q] = ldl8(slot + RWT_BT + o); kk[2 * s + q] = ldl8(slot + RWT_KK + o); rt[2 * s + q] = ldl8(slot + RWT_RT + o); }
            f32x4 x1 = z4, x2 = z4, akt = z4, arbt = z4, arkt = z4;
#pragma unroll
            for (int s = 0; s < 2; ++s) {
                const bf16x8 fkt = mk8(kt[2 * s], kt[2 * s + 1]), fbt = mk8(bt[2 * s], bt[2 * s + 1]), fkk = mk8(kk[2 * s], kk[2 * s + 1]), frt = mk8(rt[2 * s], rt[2 * s + 1]);
                x1 = mfma16(fbt, fkt, x1); x2 = mfma16(fkt, fbt, x2); akt = mfma16(fkk, fkt, akt); arbt = mfma16(fbt, frt, arbt); arkt = mfma16(fkk, frt, arkt);
            }
            f32x4 yT, y_;
#pragma unroll
            for (int i = 0; i < 4; ++i) {
                const int rr = 4 * fq + i;
                yT[i] = (rr < fr) ? -x1[i] : 0.f; y_[i] = (fr < rr) ? -x2[i] : 0.f;
                akt[i] = (rr < fr) ? akt[i] : 0.f; arbt[i] = (rr <= fr) ? arbt[i] : 0.f; arkt[i] = (rr <= fr) ? arkt[i] : 0.f;
            }
#define IA(x) ((f32x4){(x)[0] + (dg[0] ? 1.f : 0.f), (x)[1] + (dg[1] ? 1.f : 0.f), (x)[2] + (dg[2] ? 1.f : 0.f), (x)[3] + (dg[3] ? 1.f : 0.f)})
            const f32x4 y2 = mm16(yT, y_), y2T = mm16(y_, yT);
            const f32x4 y4 = mm16(y2T, y2), y4T = mm16(y2, y2T);
            const f32x4 y8T = mm16(y4, y4T);
            const f32x4 w1 = mm16(IA(y_), IA(y2T)), w1T = mm16(IA(yT), IA(y2));
            const f32x4 w2 = mm16(w1T, IA(y4T)), w2T = mm16(w1, IA(y4));
            const f32x4 tT = mm16(w2T, IA(y8T));
#undef IA
            *(LDSQ u32x2*)(slot + RWT_TT + lane * 8) = pack4(tT);
            *(LDSQ u32x2*)(slot + RWT_AK + lane * 8) = pack4(akt);
            { const u32x2 a = pack4(arbt), b = pack4(arkt); *(LDSQ u32x4*)(slot + RWT_ARB + lane * 16) = (u32x4){a.x, a.y, b.x, b.y}; }
            flag_st(ready + (c & (RWS_NSLOT - 1)), (unsigned)c + 1u);
            if (c + 4 < NC) RWP_PARK(c + 4);
        }
#undef RWP_PARK
        for (int c = NC - RWS_NSLOT; c < NC; ++c) if (c >= 0 && (c & 3) == p) {
            LDSQ unsigned char* slot = lds + (c & (RWS_NSLOT - 1)) * RWS_SLOT; const unsigned want = (unsigned)c + 1u;
            wait_ge(done + 0, want); wait_ge(done + 1, want); wait_ge(done + 2, want); wait_ge(done + 3, want);
            RWP_FLUSH(c);
        }
#undef RWP_FLUSH
#undef RWP_LOAD
    }
}

DI void mlstm_gate_scan(const GQ float* __restrict__ G, int gi, int gf, int S, GQ float* __restrict__ SC_A, GQ float* __restrict__ SC_M, GQ float* __restrict__ SC_E) {
    const int lane = lane_id(), TPL = S / 64, t0 = lane * TPL;
    float tot = 0.f;
    for (int i = 0; i < TPL; ++i) tot += G[(size_t)(t0 + i) * 8 + gf];
    float inc = tot;
#pragma unroll
    for (int d = 1; d < 64; d <<= 1) { const float t = __shfl_up(inc, d, 64); if (lane >= d) inc += t; }
    const float Fbase = inc - tot;
    float run = Fbase, lmax = -3.0e38f;
    for (int i = 0; i < TPL; ++i) { run += G[(size_t)(t0 + i) * 8 + gf]; const float a = G[(size_t)(t0 + i) * 8 + gi] - run; SC_A[t0 + i] = a; lmax = fmaxf(lmax, a); }
    float mi = lmax;
#pragma unroll
    for (int d = 1; d < 64; d <<= 1) { const float t = __shfl_up(mi, d, 64); if (lane >= d) mi = fmaxf(mi, t); }
    float mprev = __shfl_up(mi, 1, 64); if (lane == 0) mprev = 0.f;
    float M = fmaxf(mprev, 0.f); run = Fbase;
    for (int i = 0; i < TPL; ++i) { run += G[(size_t)(t0 + i) * 8 + gf]; const float a = G[(size_t)(t0 + i) * 8 + gi] - run; M = fmaxf(M, a); SC_M[t0 + i] = M; SC_E[t0 + i] = fexp(-(run + M)); }
}


#ifdef HOST_EMU
#define WG_SYNC() emu_syncthreads()
#else
#define WG_SYNC() __syncthreads()
#endif
DI void mlstm_gate_scan_wg(int wave, const GQ float* __restrict__ G, int gi, int gf, int S, GQ float* __restrict__ SC_A, GQ float* __restrict__ SC_M, GQ float* __restrict__ SC_E, LDSQ float* red) {
    const int lane = lane_id(), TPW = S / 8, NG = TPW / 64, t0 = wave * TPW;
    float F[8], A[8];
    float run = 0.f;
    for (int g = 0; g < NG; ++g) {
        const size_t t = (size_t)(t0 + 64 * g + lane);
        float inc = G[t * 8 + gf]; A[g] = G[t * 8 + gi];
#pragma unroll
        for (int d = 1; d < 64; d <<= 1) { const float x = __shfl_up(inc, d, 64); if (lane >= d) inc += x; }
        F[g] = run + inc; run += __shfl(inc, 63, 64);
    }
    if (lane == 0) red[wave] = run;
    MEMFENCE(); WG_SYNC();
    float base = 0.f;
    for (int w = 0; w < wave; ++w) base += red[w];
    float mrun = -3.0e38f;
    for (int g = 0; g < NG; ++g) {
        F[g] += base; const float a = A[g] - F[g]; A[g] = a;
        SC_A[t0 + 64 * g + lane] = a;
        float mx = a;
#pragma unroll
        for (int d = 1; d < 64; d <<= 1) { const float x = __shfl_up(mx, d, 64); if (lane >= d) mx = fmaxf(mx, x); }
        const float gm = __shfl(mx, 63, 64);
        mx = fmaxf(mx, mrun); mrun = fmaxf(mrun, gm);
        A[g] = mx;
    }
    if (lane == 0) red[8 + wave] = mrun;
    MEMFENCE(); WG_SYNC();
    float mb = 0.f;
    for (int w = 0; w < wave; ++w) mb = fmaxf(mb, red[8 + w]);
    for (int g = 0; g < NG; ++g) { const float M = fmaxf(A[g], mb); SC_M[t0 + 64 * g + lane] = M; SC_E[t0 + 64 * g + lane] = fexp(-(F[g] + M)); }
}
constexpr int MLKP = 288;
constexpr int MLS_SLOT = 9472, MLS_NSLOT = 6, MLS_FLAGS = MLS_SLOT * MLS_NSLOT, MLS_VIMG = MLS_FLAGS + 256, MLS_LDS = MLS_VIMG + 4 * 1024;
DI void mlstm_coop(int wave, const GQ bf16_t* __restrict__ Qp, const GQ bf16_t* __restrict__ Kp, int ldqk, const GQ bf16_t* __restrict__ Vp, int ldv, const GQ float* __restrict__ SC_A, const GQ float* __restrict__ SC_M,
                   int S, GQ bf16_t* __restrict__ NUM, int ldn, GQ float* __restrict__ DEN, int ldd, LDSQ unsigned char* lds) {
    const int lane = lane_id(), fr = lane & 15, fq = lane >> 4;
    const int NC = S / 16;
    LDSQ unsigned* ready = (LDSQ unsigned*)(lds + MLS_FLAGS);
    LDSQ unsigned* done = ready + 16;
    const u32x2 z2 = {0u, 0u};
    const f32x4 z4 = {0.f, 0.f, 0.f, 0.f};
    if (wave < 5) {
        const bool isden = (wave == 4);
        LDSQ unsigned char* Vimg = lds + MLS_VIMG + (wave & 3) * 1024;
        f32x4 C[8][2];
#pragma unroll
        for (int ci = 0; ci < 8; ++ci) { C[ci][0] = z4; C[ci][1] = z4; }
        u32x4 vn = {0u, 0u, 0u, 0u};
#define MLC_LOAD(c_) do { if (!isden) vn = ld16(Vp + (size_t)(16 * (c_) + (lane >> 2)) * ldv + 32 * wave + 8 * (lane & 3)); } while (0)
        MLC_LOAD(0);
        for (int c = 0; c < NC; ++c) {
            const u32x4 vcur = vn;
            if (c + 1 < NC) MLC_LOAD(c + 1);
            MEMFENCE();
            if (!isden) *(LDSQ u32x4*)(Vimg + (lane >> 2) * 64 + (lane & 3) * 16) = vcur;
            MEMFENCE();
            const int sl = c % MLS_NSLOT;
            LDSQ unsigned char* slot = lds + sl * MLS_SLOT;
            wait_ge_t(ready + sl, (unsigned)c + 1u, ready + 32 + wave);
            const u32x2 pf = *(const LDSQ u32x2*)(slot + 4608 + lane * 8);
            u32x2 qc[8];
#pragma unroll
            for (int i = 0; i < 8; ++i) qc[i] = *(const LDSQ u32x2*)(slot + 5376 + i * 512 + lane * 8);
            const f32x4 wi = *(const LDSQ f32x4*)(slot + 5120 + fq * 16), wt = *(const LDSQ f32x4*)(slot + 5184 + fq * 16), rs4 = *(const LDSQ f32x4*)(slot + 5248 + fq * 16);
            const float wst = *(const LDSQ float*)(slot + 5312);
            s16x4 k4[8];
#pragma unroll
            for (int ci = 0; ci < 8; ++ci) k4[ci] = TR16(slot + (4 * fq + (fr >> 2)) * MLKP + (16 * ci + 4 * (fr & 3)) * 2);
            if (!isden) {
                bf16x8 vwb[2];
#pragma unroll
                for (int j = 0; j < 2; ++j) {
                    const s16x4 v4 = TR16(Vimg + (4 * fq + (fr >> 2)) * 64 + 32 * j + 8 * (fr & 3));
                    const f32x4 numI = mfma16(mk8(pf, z2), mk8(tr2(v4), z2), z4);
                    f32x4 inter = z4;
#pragma unroll
                    for (int ks = 0; ks < 4; ++ks) inter = mfma16(mk8(qc[2 * ks], qc[2 * ks + 1]), mk8(pack4(C[2 * ks][j]), pack4(C[2 * ks + 1][j])), inter);
#pragma unroll
                    for (int i = 0; i < 4; ++i) NUM[(size_t)(16 * c + 4 * fq + i) * ldn + 32 * wave + 16 * j + fr] = f2bf(numI[i] + wi[i] * inter[i]);
                    f32x4 vw;
#pragma unroll
                    for (int i = 0; i < 4; ++i) vw[i] = bf2f((unsigned short)v4[i]) * wt[i];
                    vwb[j] = mk8(pack4(vw), z2);
                }
#pragma unroll
                for (int ci = 0; ci < 8; ++ci) { const bf16x8 ka = mk8(tr2(k4[ci]), z2); C[ci][0] = mfma16(ka, vwb[0], C[ci][0] * wst); C[ci][1] = mfma16(ka, vwb[1], C[ci][1] * wst); }
            } else {
                f32x4 inter = z4;
#pragma unroll
                for (int ks = 0; ks < 4; ++ks) inter = mfma16(mk8(qc[2 * ks], qc[2 * ks + 1]), mk8(pack4(C[2 * ks][0]), pack4(C[2 * ks + 1][0])), inter);
                if (fr == 0) {
#pragma unroll
                    for (int i = 0; i < 4; ++i) DEN[(size_t)(16 * c + 4 * fq + i) * ldd] = rs4[i] + wi[i] * inter[i];
                }
                f32x4 vw;
#pragma unroll
                for (int i = 0; i < 4; ++i) vw[i] = (fr == 0) ? wt[i] : 0.f;
                const bf16x8 vwb = mk8(pack4(vw), z2);
#pragma unroll
                for (int ci = 0; ci < 8; ++ci) C[ci][0] = mfma16(mk8(tr2(k4[ci]), z2), vwb, C[ci][0] * wst);
            }
            flag_st(done + wave, (unsigned)c + 1u);
        }
#undef MLC_LOAD
    } else {
        const int p = wave - 5;
        u32x2 qn[8], kn[8]; float an = 0.f, mn = 0.f, mcn = 0.f;
#define MLP_LOAD(c_) do { const size_t row = (size_t)(16 * (c_) + fr); \
    _Pragma("unroll") for (int ks = 0; ks < 4; ++ks) { qn[2 * ks] = ld8(Qp + row * ldqk + 32 * ks + 4 * fq); qn[2 * ks + 1] = ld8(Qp + row * ldqk + 32 * ks + 16 + 4 * fq); \
        kn[2 * ks] = ld8(Kp + row * ldqk + 32 * ks + 4 * fq); kn[2 * ks + 1] = ld8(Kp + row * ldqk + 32 * ks + 16 + 4 * fq); } \
    an = SC_A[row]; mn = SC_M[row]; mcn = ((c_) > 0) ? SC_M[16 * (c_) - 1] : 0.f; } while (0)
        if (p < NC) MLP_LOAD(p);
        for (int c = p; c < NC; c += 3) {
            u32x2 qc[8], kc[8]; const float a = an, Mx = mn, Mcarry = mcn;
#pragma unroll
            for (int i = 0; i < 8; ++i) { qc[i] = qn[i]; kc[i] = kn[i]; }
            if (c + 3 < NC) MLP_LOAD(c + 3);
            const float Mend = __shfl(Mx, 15, 16);
            float as_[4];
#pragma unroll
            for (int i = 0; i < 4; ++i) as_[i] = __shfl(a, 4 * fq + i, 16);
            f32x4 st = z4;
#pragma unroll
            for (int ks = 0; ks < 4; ++ks) st = mfma16(mk8(kc[2 * ks], kc[2 * ks + 1]), mk8(qc[2 * ks], qc[2 * ks + 1]), st);
            f32x4 pt;
#pragma unroll
            for (int i = 0; i < 4; ++i) pt[i] = (4 * fq + i <= fr) ? st[i] * fexp(as_[i] - Mx) : 0.f;
            float rs = (pt[0] + pt[1]) + (pt[2] + pt[3]);
            rs += __shfl_xor(rs, 16); rs += __shfl_xor(rs, 32);
            const int sl = c % MLS_NSLOT;
            if (c >= MLS_NSLOT) { const unsigned want = (unsigned)(c - MLS_NSLOT + 1); wait_ge_t(done + 0, want, ready + 32 + wave); wait_ge(done + 1, want); wait_ge(done + 2, want); wait_ge(done + 3, want); wait_ge(done + 4, want); }
            LDSQ unsigned char* slot = lds + sl * MLS_SLOT;
            MEMFENCE();
#pragma unroll
            for (int ks = 0; ks < 4; ++ks) { *(LDSQ u32x2*)(slot + fr * MLKP + (32 * ks + 4 * fq) * 2) = kc[2 * ks]; *(LDSQ u32x2*)(slot + fr * MLKP + (32 * ks + 16 + 4 * fq) * 2) = kc[2 * ks + 1]; }
            *(LDSQ u32x2*)(slot + 4608 + lane * 8) = pack4(pt);
#pragma unroll
            for (int i = 0; i < 8; ++i) *(LDSQ u32x2*)(slot + 5376 + i * 512 + lane * 8) = qc[i];
            if (fq == 0) { *(LDSQ float*)(slot + 5120 + fr * 4) = fexp(Mcarry - Mx); *(LDSQ float*)(slot + 5184 + fr * 4) = fexp(a - Mend); *(LDSQ float*)(slot + 5248 + fr * 4) = rs; }
            if (lane == 0) *(LDSQ float*)(slot + 5312) = fexp(Mcarry - Mend);
            flag_st(ready + sl, (unsigned)c + 1u);
        }
#undef MLP_LOAD
    }
}

constexpr int M3P = 288, M3T = 32 * M3P;
constexpr int M3_K = 0, M3_Q = M3T, M3_V = 2 * M3T, M3_P = 3 * M3T, M3_WI = M3_P + 2048, M3_WT = M3_WI + 128, M3_RS = M3_WT + 128, M3_A = M3_RS + 128, M3_MX = M3_A + 128, M3_WS = M3_MX + 128;
constexpr int M3_SLOT = M3_P + 2048 + 1024;
template <int NJ, int NCONS, int ABL = 0> DI void mlstm_coop32(int wave, int cbase  , bool with_den, const GQ bf16_t* __restrict__ Qp, const GQ bf16_t* __restrict__ Kp, int ldqk, const GQ bf16_t* __restrict__ Vp, int ldv, const GQ float* __restrict__ SC_A, const GQ float* __restrict__ SC_M,
                     int S, GQ bf16_t* __restrict__ NUM, int ldn, GQ float* __restrict__ DEN, int ldd, LDSQ unsigned char* lds, LDSQ unsigned* flags) {
    constexpr int NTP = (16 * NJ * NCONS == 128) ? 272 : 144, M3_NT = M3_SLOT, M3_DN = M3_NT + 32 * NTP, M3_SLOTX = M3_DN + 128, M3_NSLOT = 3;
    const int lane = lane_id(), fr = lane & 15, fq = lane >> 4;
    const int NC = S / 32;
    LDSQ unsigned* ready = flags;
    LDSQ unsigned* done = flags + 16;
    LDSQ unsigned* flushed = flags + 24;
    const int lrow = lane >> 4, lpc = lane & 15;
#define M3_FLUSH(sp_, cc_) do { MEMFENCE(); \
        if (16 * NJ * NCONS == 128) { _Pragma("unroll") for (int g = 0; g < 8; ++g) { const int r_ = 4 * g + lrow; \
            *(GQ u32x4*)(NUM + (size_t)(32 * (cc_) + r_) * ldn + cbase + 8 * lpc) = *(const LDSQ u32x4*)((sp_) + M3_NT + r_ * NTP + lpc * 16); } } \
        else { _Pragma("unroll") for (int g = 0; g < 4; ++g) { const int r_ = 8 * g + (lane >> 3), pc_ = lane & 7; \
            *(GQ u32x4*)(NUM + (size_t)(32 * (cc_) + r_) * ldn + cbase + 8 * pc_) = *(const LDSQ u32x4*)((sp_) + M3_NT + r_ * NTP + pc_ * 16); } } \
        if (with_den && lane < 32) DEN[(size_t)(32 * (cc_) + lane) * ldd] = *(const LDSQ float*)((sp_) + M3_DN + lane * 4); \
        MEMFENCE(); } while (0)
    const u32x2 z2 = {0u, 0u};
    const f32x4 z4 = {0.f, 0.f, 0.f, 0.f};
    if (wave < 5) {
        if (wave >= NCONS && wave != 4) return;
        const bool isden = (wave == 4);
        f32x4 C[8][NJ];
#pragma unroll
        for (int ci = 0; ci < 8; ++ci)
#pragma unroll
            for (int j = 0; j < NJ; ++j) C[ci][j] = z4;
        const int cw = cbase + 16 * NJ * wave;
        for (int c = 0; c < NC; ++c) {
            const int sl = c % M3_NSLOT;
            LDSQ unsigned char* slot = lds + sl * M3_SLOTX;
            wait_ge_t(ready + sl, (unsigned)c + 1u, flags + 32 + wave);
            const float wst = *(const LDSQ float*)(slot + M3_WS);
            f32x4 wi[2], wt[2];
#pragma unroll
            for (int h = 0; h < 2; ++h) { wi[h] = *(const LDSQ f32x4*)(slot + M3_WI + (16 * h + 4 * fq) * 4); wt[h] = *(const LDSQ f32x4*)(slot + M3_WT + (16 * h + 4 * fq) * 4); }
#define M3_QF(tt_, ks_) mk8(ldl8(slot + M3_Q + (16 * (tt_) + fr) * M3P + (32 * (ks_) + 4 * fq) * 2), ldl8(slot + M3_Q + (16 * (tt_) + fr) * M3P + (32 * (ks_) + 4 * fq) * 2 + 32))
            if (isden && !with_den) { flag_st(done + wave, (unsigned)c + 1u); continue; }
            if (!isden) {
                const u32x4 pf0 = *(const LDSQ u32x4*)(slot + M3_P + lane * 16), pf1 = *(const LDSQ u32x4*)(slot + M3_P + 1024 + lane * 16);
                bf16x8 vwb[NJ];
#pragma unroll
                for (int j = 0; j < NJ; ++j) {
                    const int vo = (4 * fq + (fr >> 2)) * M3P + (cw + 16 * j + 4 * (fr & 3)) * 2;
                    s16x4 v0 = {0, 0, 0, 0}, v1 = {0, 0, 0, 0}; if (!(ABL & 4)) { v0 = TR16(slot + M3_V + vo); v1 = TR16(slot + M3_V + 16 * M3P + vo); }
                    const bf16x8 vb = mk8(tr2(v0), tr2(v1));
                    bf16x8 cb[4];
#pragma unroll
                    for (int ks = 0; ks < 4; ++ks) cb[ks] = mk8(pack4(C[2 * ks][j]), pack4(C[2 * ks + 1][j]));
#pragma unroll
                    for (int tt = 0; tt < 2; ++tt) {
                        f32x4 numI = z4; if (!(ABL & 4)) numI = mfma16(__builtin_bit_cast(bf16x8, tt ? pf1 : pf0), vb, z4);
                        f32x4 inter = z4;
                        if (!(ABL & 2)) {
#pragma unroll
                        for (int ks = 0; ks < 4; ++ks) inter = mfma16(M3_QF(tt, ks), cb[ks], inter); }
#pragma unroll
                        for (int i = 0; i < 4; ++i) *(LDSQ unsigned short*)(slot + M3_NT + (16 * tt + 4 * fq + i) * NTP + (16 * NJ * wave + 16 * j + fr) * 2) = f2bf(numI[i] + wi[tt][i] * inter[i]);
                    }
                    f32x4 w0, w1;
#pragma unroll
                    for (int i = 0; i < 4; ++i) { w0[i] = bf2f((unsigned short)v0[i]) * wt[0][i]; w1[i] = bf2f((unsigned short)v1[i]) * wt[1][i]; }
                    vwb[j] = mk8(pack4(w0), pack4(w1));
                }
#pragma unroll
                for (int ci = 0; ci < ((ABL & 1) ? 0 : 8); ++ci) {
                    const int ko = (4 * fq + (fr >> 2)) * M3P + (16 * ci + 4 * (fr & 3)) * 2;
                    const bf16x8 ka = mk8(tr2(TR16(slot + M3_K + ko)), tr2(TR16(slot + M3_K + 16 * M3P + ko)));
#pragma unroll
                    for (int j = 0; j < NJ; ++j) {
                        C[ci][j] *= wst;
#ifndef HOST_EMU
                        asm volatile("" : "+v"(C[ci][j]));
#endif
                        C[ci][j] = mfma16(ka, vwb[j], C[ci][j]); }
                }
                flag_st(done + wave, (unsigned)c + 1u);
            } else {
                const f32x4 rs0 = *(const LDSQ f32x4*)(slot + M3_RS + (4 * fq) * 4), rs1 = *(const LDSQ f32x4*)(slot + M3_RS + (16 + 4 * fq) * 4);
                bf16x8 cb[4];
#pragma unroll
                for (int ks = 0; ks < 4; ++ks) cb[ks] = mk8(pack4(C[2 * ks][0]), pack4(C[2 * ks + 1][0]));
#pragma unroll
                for (int tt = 0; tt < 2; ++tt) {
                    f32x4 inter = z4;
#pragma unroll
                    for (int ks = 0; ks < 4; ++ks) inter = mfma16(M3_QF(tt, ks), cb[ks], inter);
                    if (fr == 0) {
#pragma unroll
                        for (int i = 0; i < 4; ++i) *(LDSQ float*)(slot + M3_DN + (16 * tt + 4 * fq + i) * 4) = (tt ? rs1[i] : rs0[i]) + wi[tt][i] * inter[i];
                    }
                }
                f32x4 w0, w1;
#pragma unroll
                for (int i = 0; i < 4; ++i) { w0[i] = (fr == 0) ? wt[0][i] : 0.f; w1[i] = (fr == 0) ? wt[1][i] : 0.f; }
                const bf16x8 vwb = mk8(pack4(w0), pack4(w1));
#pragma unroll
                for (int ci = 0; ci < 8; ++ci) {
                    const int ko = (4 * fq + (fr >> 2)) * M3P + (16 * ci + 4 * (fr & 3)) * 2;
                    const bf16x8 ka = mk8(tr2(TR16(slot + M3_K + ko)), tr2(TR16(slot + M3_K + 16 * M3P + ko)));
                    C[ci][0] = mfma16(ka, vwb, C[ci][0] * wst);
                }
                flag_st(done + wave, (unsigned)c + 1u);
            }
        }
    } else {
        const int p = wave - 5;
        u32x4 tk[8], tq[8], tv[8]; float an = 0.f, mn = 0.f, mcn = 0.f;
#define M3_LOAD(c_) do { _Pragma("unroll") for (int g = 0; g < 8; ++g) { const size_t r = (size_t)(32 * (c_) + 4 * g + lrow); \
        tk[g] = ld16(Kp + r * ldqk + 8 * lpc); tq[g] = ld16(Qp + r * ldqk + 8 * lpc); tv[g] = ld16(Vp + r * ldv + 8 * lpc); } \
    an = SC_A[32 * (c_) + (lane & 31)]; mn = SC_M[32 * (c_) + (lane & 31)]; mcn = ((c_) > 0) ? SC_M[32 * (c_) - 1] : 0.f; } while (0)
#define M3_PARK(cc_) do { LDSQ unsigned char* ps_ = lds + ((cc_) % M3_NSLOT) * M3_SLOTX; \
        if ((cc_) >= M3_NSLOT) { const unsigned want_ = (unsigned)((cc_) - M3_NSLOT + 1); _Pragma("unroll") for (int w_ = 0; w_ < NCONS; ++w_) wait_ge_t(done + w_, want_, flags + 32 + wave); wait_ge_t(done + 4, want_, flags + 32 + wave); M3_FLUSH(ps_, (cc_) - M3_NSLOT); } \
        MEMFENCE(); \
        _Pragma("unroll") for (int g = 0; g < 8; ++g) { const int o_ = (4 * g + lrow) * M3P + lpc * 16; *(LDSQ u32x4*)(ps_ + M3_K + o_) = tk[g]; *(LDSQ u32x4*)(ps_ + M3_Q + o_) = tq[g]; *(LDSQ u32x4*)(ps_ + M3_V + o_) = tv[g]; } \
        { const float Mend_ = __shfl(mn, 31, 32); \
          if (lane < 32) { *(LDSQ float*)(ps_ + M3_A + lane * 4) = an; *(LDSQ float*)(ps_ + M3_MX + lane * 4) = mn; \
              *(LDSQ float*)(ps_ + M3_WI + lane * 4) = fexp(mcn - mn); *(LDSQ float*)(ps_ + M3_WT + lane * 4) = fexp(an - Mend_); } \
          if (lane == 0) *(LDSQ float*)(ps_ + M3_WS) = fexp(mcn - Mend_); } \
        MEMFENCE(); WAVE_SYNC(); } while (0)
        if (p < NC) { M3_LOAD(p); M3_PARK(p); }
        for (int c = p; c < NC; c += 3) {
            if (c + 3 < NC) M3_LOAD(c + 3);
            const int sl = c % M3_NSLOT;
            LDSQ unsigned char* slot = lds + sl * M3_SLOTX;
            f32x4 st00 = z4, st01 = z4, st11 = z4;
#pragma unroll
            for (int ks = 0; ks < 4; ++ks) {
                const int o = fr * M3P + (32 * ks + 4 * fq) * 2;
                const bf16x8 k0 = mk8(ldl8(slot + M3_K + o), ldl8(slot + M3_K + o + 32)), k1 = mk8(ldl8(slot + M3_K + 16 * M3P + o), ldl8(slot + M3_K + 16 * M3P + o + 32));
                const bf16x8 q0 = mk8(ldl8(slot + M3_Q + o), ldl8(slot + M3_Q + o + 32)), q1 = mk8(ldl8(slot + M3_Q + 16 * M3P + o), ldl8(slot + M3_Q + 16 * M3P + o + 32));
                st00 = mfma16(k0, q0, st00); st01 = mfma16(k0, q1, st01); st11 = mfma16(k1, q1, st11);
            }
            const f32x4 as0 = *(const LDSQ f32x4*)(slot + M3_A + (4 * fq) * 4), as1 = *(const LDSQ f32x4*)(slot + M3_A + (16 + 4 * fq) * 4);
            const float mx0 = *(const LDSQ float*)(slot + M3_MX + fr * 4), mx1 = *(const LDSQ float*)(slot + M3_MX + (16 + fr) * 4);
            f32x4 p00, p01, p11;
#pragma unroll
            for (int i = 0; i < 4; ++i) {
                p00[i] = (4 * fq + i <= fr) ? st00[i] * fexp(as0[i] - mx0) : 0.f;
                p01[i] = st01[i] * fexp(as0[i] - mx1);
                p11[i] = (4 * fq + i <= fr) ? st11[i] * fexp(as1[i] - mx1) : 0.f;
            }
            float r0 = (p00[0] + p00[1]) + (p00[2] + p00[3]);
            float r1 = ((p01[0] + p01[1]) + (p01[2] + p01[3])) + ((p11[0] + p11[1]) + (p11[2] + p11[3]));
            r0 += __shfl_xor(r0, 16); r0 += __shfl_xor(r0, 32); r1 += __shfl_xor(r1, 16); r1 += __shfl_xor(r1, 32);
            if (fq == 0) { *(LDSQ float*)(slot + M3_RS + fr * 4) = r0; *(LDSQ float*)(slot + M3_RS + (16 + fr) * 4) = r1; }
            { const u32x2 a0 = pack4(p00); *(LDSQ u32x4*)(slot + M3_P + lane * 16) = (u32x4){a0.x, a0.y, 0u, 0u};
              const u32x2 b0 = pack4(p01), b1 = pack4(p11); *(LDSQ u32x4*)(slot + M3_P + 1024 + lane * 16) = (u32x4){b0.x, b0.y, b1.x, b1.y}; }
            flag_st(ready + sl, (unsigned)c + 1u);
            if (c + 3 < NC) M3_PARK(c + 3);
        }
        for (int c = NC - M3_NSLOT; c < NC; ++c) if (c >= 0 && (c % 3) == p) {
            const unsigned want = (unsigned)c + 1u;
#pragma unroll
            for (int w_ = 0; w_ < NCONS; ++w_) wait_ge(done + w_, want);
            wait_ge(done + 4, want);
            LDSQ unsigned char* sp = lds + (c % M3_NSLOT) * M3_SLOTX; M3_FLUSH(sp, c);
        }
#undef M3_FLUSH
#undef M3_PARK
#undef M3_LOAD
    }
}
#define GAS __attribute__((address_space(1)))
#define LAS __attribute__((address_space(3)))
typedef GAS unsigned gu32;
#define RLX_AGENT __ATOMIC_RELAXED, __HIP_MEMORY_SCOPE_AGENT
#define LDS_WAIT() asm volatile("s_waitcnt lgkmcnt(0)" ::: "memory")
#define VM_WAIT() asm volatile("s_waitcnt vmcnt(0)" ::: "memory")

constexpr int CB = 8, CS = 4096, CD = 1024, CM = CB * CS;
constexpr int NPROJ = 3584, PITCH_WIN = 3592, FF = 4096;
constexpr float NORM_EPS = 1e-6f, GN_EPS = 64e-5f;
constexpr int NWAVES = 8;
constexpr size_t MiB = 1u << 20;
constexpr size_t WS_CTL = 0, CTL_ZERO_BYTES = 1 * MiB;
constexpr size_t WS_W = 1 * MiB;
constexpr size_t WS_GATES = 27 * MiB, WS_DEN = 28 * MiB, WS_EMT = 28 * MiB + 512 * 1024, WS_BONUS = 29 * MiB;
constexpr size_t WS_SCA = 31 * MiB, WS_SCM = 31 * MiB + 512 * 1024;
constexpr size_t WS_U = 32 * MiB;
constexpr size_t WS_BIG = 97 * MiB;
constexpr size_t WS_PROJ = WS_BIG, WS_QKC = 321 * MiB, WS_VT = 385 * MiB, WS_NUM = 417 * MiB;
constexpr size_t WS_MIX = WS_BIG;
constexpr size_t WS_HID = WS_BIG, WS_FFO = 353 * MiB;
constexpr size_t WS_XR = 97 * MiB, WS_XK = 161 * MiB, WS_XV = 225 * MiB, WS_RO = 289 * MiB, WS_KO = 353 * MiB, WS_VO = 417 * MiB, WS_LORA = 481 * MiB, WS_GL = 497 * MiB;
constexpr size_t WS_KT = WS_XR, WS_BT = WS_XK, WS_KK = WS_XV, WS_RT = WS_U, WS_YRAW = WS_RO, WS_YG = WS_KO;
constexpr size_t WS_END = 505 * MiB;
constexpr size_t W_IN = 0, W_OUTE = 3670016, W_UP = 5242880, W_DN = 9437184;
constexpr size_t W_RKV = 0, W_LB1 = 3145728, W_LB2 = 3407872, W_W2T = 3670016, W_A2T = 3735552, W_G2T = 3801088, W_OUTO = 3932160;
constexpr int CW_BAR = 4096;

constexpr int RING_BYTES = 131072, LDSCTL_OFF = RING_BYTES, MISC_OFF = LDSCTL_OFF + 320, LDS_BYTES = 147456;

#define XB_TMO      128
#define XB_XCNT(j)  (256  + 64 * (j))
#define XB_XSUB(j)  (1280 + 64 * (j))
#define XB_XGEN(j)  (2304 + 64 * (j))
#define XB_TOP      3328
#define XB_TOPGEN   3392
#define XCD_BAR_WORDS 3456
#define XB_SPIN_CAP (1u << 18)
__device__ __forceinline__ unsigned xb_ld(unsigned* p)              { return __hip_atomic_load(p, __ATOMIC_RELAXED, __HIP_MEMORY_SCOPE_AGENT); }
__device__ __forceinline__ unsigned xb_add(unsigned* p, unsigned v) { return __hip_atomic_fetch_add(p, v, __ATOMIC_RELAXED, __HIP_MEMORY_SCOPE_AGENT); }
__device__ __forceinline__ unsigned xb_xcc_id() { return (unsigned)__builtin_amdgcn_s_getreg((3 << 11) | 20) & 0xFu; }
#define XB_SPIN(cond, bar) do { unsigned _sp = 0; while (cond) { __builtin_amdgcn_s_sleep(1); \
    if ((++_sp & 255u) == 0u) { if (xb_ld(&(bar)[XB_TMO])) break; if (_sp > XB_SPIN_CAP) { atomicAdd(&(bar)[XB_TMO], 1u); break; } } } } while (0)
struct XcdBarrier { unsigned* bar; unsigned x; volatile LAS unsigned* st; };
__device__ __forceinline__ XcdBarrier xcd_barrier_post(unsigned* bar, volatile LAS unsigned* st, bool t0) {
    XcdBarrier b; b.bar = bar; b.x = xb_xcc_id(); b.st = st;
    if (t0) (void)xb_add(&bar[XB_XCNT(b.x)], 1u);
    return b;
}
__device__ __forceinline__ void xcd_barrier_complete(unsigned* bar, unsigned x, unsigned& nloc, unsigned& nx) {
    const unsigned G = gridDim.x * gridDim.y * gridDim.z;
    unsigned sum, cnt, mine, sp = 0u;
    for (;;) {
        sum = 0u; cnt = 0u; mine = 0u;
#pragma unroll
        for (unsigned j = 0; j < 16; ++j) { const unsigned c = xb_ld(&bar[XB_XCNT(j)]); sum += c; cnt += (c > 0u) ? 1u : 0u; mine = (j == x) ? c : mine; }
        if (sum == G) break;
        __builtin_amdgcn_s_sleep(1);
        if ((++sp & 255u) == 0u) { if (xb_ld(&bar[XB_TMO])) break; if (sp > XB_SPIN_CAP) { atomicAdd(&bar[XB_TMO], 1u); break; } }
    }
    nloc = mine > 0u ? mine : 1u; nx = cnt > 0u ? cnt : 1u;
}
__device__ __forceinline__ void xcd_barrier(const XcdBarrier& b, bool t0) {
    asm volatile("s_waitcnt vmcnt(0)" ::: "memory");
    __syncthreads();
    if (t0) {
        unsigned* bar = b.bar;
        __builtin_amdgcn_s_waitcnt(0);
        unsigned nloc = b.st[0], nx = b.st[1];
        if (nloc == 0u) { xcd_barrier_complete(bar, b.x, nloc, nx); b.st[0] = nloc; b.st[1] = nx; }
        const unsigned old = xb_add(&bar[XB_XSUB(b.x)], 1u);
        const unsigned gen = old / nloc;
        if (old + 1u == (gen + 1u) * nloc) {
            __builtin_amdgcn_fence(__ATOMIC_RELEASE, "agent");
            asm volatile("s_waitcnt vmcnt(0)" ::: "memory");
            const unsigned og = xb_add(&bar[XB_TOP], 1u);
            const unsigned tg = og / nx;
            if (og + 1u == (tg + 1u) * nx) xb_add(&bar[XB_TOPGEN], 1u);
            else XB_SPIN(xb_ld(&bar[XB_TOPGEN]) == tg, bar);
            __builtin_amdgcn_fence(__ATOMIC_ACQUIRE, "agent");
            xb_add(&bar[XB_XGEN(b.x)], 1u);
            asm volatile("s_waitcnt vmcnt(0)" ::: "memory");
        } else {
            XB_SPIN(xb_ld(&bar[XB_XGEN(b.x)]) == gen, bar);
            __builtin_amdgcn_fence(__ATOMIC_ACQUIRE, "agent");
            asm volatile("s_waitcnt vmcnt(0)" ::: "memory");
        }
    }
    __syncthreads();
}

namespace pg8 {
constexpr int BM = 256, BK = 64, HALF = 128, HTB = HALF * BK * 2, STAGE_BYTES = 8 * HTB, NXCD = 8, WGM = 8;
__host__ __device__ __forceinline__ int lds_byte(int r, int c) { const int st = (r >> 4) * 2 + (c >> 5), rr = r & 15, cc = c & 31, ob = rr * 64 + cc * 2; return st * 1024 + (ob ^ (((ob >> 9) & 1) << 5)); }
__host__ __device__ __forceinline__ void stage_rc(int b, int& R, int& C) { const int st = b / 1024, sb = b % 1024, swz = sb ^ (((sb >> 9) & 1) << 5); R = (st >> 1) * 16 + swz / 64; C = (st & 1) * 32 + (swz % 64) / 2; }
__host__ __device__ __forceinline__ int perm32(int rho) { const int n = rho >> 4, i = rho & 15; return 8 * (i >> 2) + 4 * n + (i & 3); }
struct Unit { int pm, pn; };
struct UnitPtrs { const GAS char* A; const GAS char* B; int two; };
struct StaticOrder {
    int nM, nN, nwg, G, c;
    __device__ void init(int M, int N, int G_, int c_) { nM = M / BM; nN = N / BM; nwg = nM * nN; G = G_; c = c_; }
    __device__ bool next(int i, Unit& u) const {
        const long L = (long)i * G + c; if (L >= nwg) return false;
        int wgid = (int)L; { const int q = nwg / NXCD, r = nwg % NXCD, xcd = wgid % NXCD, off = wgid / NXCD; wgid = (xcd < r ? xcd * (q + 1) : r * (q + 1) + (xcd - r) * q) + off; }
        const int nig = WGM * nN, gid = wgid / nig, fm = gid * WGM, gsz = (nM - fm) < WGM ? (nM - fm) : WGM;
        u.pm = fm + ((wgid % nig) % gsz); u.pn = (wgid % nig) / gsz; return true;
    }
};
__device__ __forceinline__ unsigned cvt_pk_bf16(float lo, float hi) { unsigned r; asm volatile("v_cvt_pk_bf16_f32 %0, %1, %2" : "=v"(r) : "v"(lo), "v"(hi)); return r; }

template <int LDA, int LDB, int NT> struct ProbPlain {
    const GAS bf16_t* A; const GAS bf16_t* Bt;
    static constexpr long lda = LDA, ldb = LDB; static constexpr bool TWO_SRC = false; static constexpr int NTC = NT;
    __device__ __forceinline__ void ptrs(const Unit& u, UnitPtrs& p) const {
        p.A = (const GAS char*)(A + (size_t)u.pm * BM * lda); p.B = (const GAS char*)(Bt + (size_t)u.pn * BM * ldb);
    }
};
struct ProbRkv {
    const GAS bf16_t* X; size_t xstride; const GAS bf16_t* Wt; const GAS bf16_t* Upad; const GAS bf16_t* LB1; long lb2d;
    static constexpr long lda = 1024, ldb = 1024; static constexpr bool TWO_SRC = true; static constexpr int NTC = 16;
    __device__ __forceinline__ void ptrs(const Unit& u, UnitPtrs& p) const {
        if (u.pn < 12) { p.A = (const GAS char*)(X + (size_t)(u.pn >> 2) * xstride + (size_t)u.pm * BM * 1024); p.B = (const GAS char*)(Wt + (size_t)u.pn * BM * 1024); p.two = 0; }
        else { const size_t arow = (size_t)u.pm * BM + (size_t)(u.pm >> 4) + 1; p.A = (const GAS char*)(Upad + arow * 1024); p.B = (const GAS char*)LB1; p.two = 1; }
    }
};
struct RkvOrder {
    int c;
    __device__ bool next(int i, Unit& u) const { const int half = c & 1; if (i >= (half ? 6 : 7)) return false; u.pm = c >> 1; u.pn = half ? 7 + i : i; return true; }
};
struct EpiStore {
    GAS bf16_t* O; int ldc; int act; int rkv; size_t gstride; GAS bf16_t* Ol;
    static constexpr bool PERM = true;
    __device__ __forceinline__ void operator()(const f32x4 (&acc)[2][2][4][2], const Unit& u, int wr, int wc, int fr, int fq) const {
        GAS bf16_t* base = O; int ld = ldc, colt = u.pn * BM;
        if (rkv) { if (u.pn < 12) { base = O + (size_t)(u.pn >> 2) * gstride; colt = (u.pn & 3) * BM; } else { base = Ol; ld = 256; colt = 0; } }
        const int row0 = u.pm * BM + wr * 64 + fr, col0 = colt + wc * 32 + 8 * fq;
#pragma unroll
        for (int ai = 0; ai < 2; ++ai)
#pragma unroll
            for (int m = 0; m < 4; ++m) { GAS bf16_t* rowp = base + (size_t)(row0 + ai * HALF + m * 16) * ld + col0;
#pragma unroll
                for (int bj = 0; bj < 2; ++bj) { f32x4 v0 = acc[ai][bj][m][0], v1 = acc[ai][bj][m][1];
                    if (act == 1) {
#pragma unroll
                        for (int q = 0; q < 4; ++q) { const float a = fmaxf(v0[q], 0.f), b = fmaxf(v1[q], 0.f); v0[q] = a * a; v1[q] = b * b; } }
                    u32x4 w; w.x = cvt_pk_bf16(v0[0], v0[1]); w.y = cvt_pk_bf16(v0[2], v0[3]); w.z = cvt_pk_bf16(v1[0], v1[1]); w.w = cvt_pk_bf16(v1[2], v1[3]);
                    *(GAS u32x4*)(rowp + bj * HALF) = w; } }
    }
};

template <class Prob, class Epi, class Sched>
__device__ __forceinline__ void gemm_phase(LAS unsigned char* lds, int wave_in, const Prob& P, const Sched& S, const Epi& E) {
    const int wid = __builtin_amdgcn_readfirstlane(wave_in); const int lane = lane_id(); const int tid = wid * 64 + lane;
    const int wr = wid >> 2, wc = wid & 3, fr = lane & 15, fq = lane >> 4;
    constexpr long lda = Prob::lda, ldb = Prob::ldb; long lb2d = 0; if constexpr (Prob::TWO_SRC) lb2d = P.lb2d;
    unsigned voffA[2], voffB[2];
#pragma unroll
    for (int i = 0; i < 2; ++i) { int R, C; stage_rc(tid * 16 + i * 8192, R, C); const int Rb = Epi::PERM ? ((R & ~31) + perm32(R & 31)) : R;
        voffA[i] = (unsigned)(R * lda + C) * 2u; voffB[i] = (unsigned)(Rb * ldb + C) * 2u; }
    const long kstep = (long)(BK * 2);
    const long hstepA = (long)HALF * lda * 2, hstepB = (long)HALF * ldb * 2;
    const unsigned ldsw = (unsigned)wid * 1024u;
    const int aoff = lds_byte(wr * 64 + fr, fq * 8), boff = lds_byte(wc * 32 + fr, fq * 8);
#define PG8_SA(b, h) (((b) * 2 + (h)) * HTB)
#define PG8_SB(b, h) ((4 + (b) * 2 + (h)) * HTB)
#define PG8_STAGE(bufoff, gbase, voff) do { _Pragma("unroll") for (int _i = 0; _i < 2; ++_i) \
        __builtin_amdgcn_global_load_lds((const GAS unsigned*)((const GAS char*)(gbase) + (voff)[_i]), (LAS unsigned*)(lds + (bufoff) + ldsw + _i * 8192), 16, 0, 0); } while (0)
#define PG8_LDA(dst, b, h) do { _Pragma("unroll") for (int m = 0; m < 4; ++m) _Pragma("unroll") for (int k = 0; k < 2; ++k) dst[m][k] = *(const LAS bf16x8*)(lds + PG8_SA(b, h) + aoff + m * 2048 + k * 1024); } while (0)
#define PG8_LDB(dst, b, h) do { _Pragma("unroll") for (int n = 0; n < 2; ++n) _Pragma("unroll") for (int k = 0; k < 2; ++k) dst[n][k] = *(const LAS bf16x8*)(lds + PG8_SB(b, h) + boff + n * 2048 + k * 1024); } while (0)
#define PG8_MMA(ai, bj, At, Bt) do { __builtin_amdgcn_s_setprio(1); _Pragma("unroll") for (int m = 0; m < 4; ++m) _Pragma("unroll") for (int n = 0; n < 2; ++n) _Pragma("unroll") for (int k = 0; k < 2; ++k) \
        acc[ai][bj][m][n] = __builtin_amdgcn_mfma_f32_16x16x32_bf16(Bt[n][k], At[m][k], acc[ai][bj][m][n], 0, 0, 0); __builtin_amdgcn_s_setprio(0); } while (0)
#define PG8_WAIT_V(n) asm volatile("s_waitcnt vmcnt(" #n ")" ::: "memory")
#define PG8_WAIT_L(n) asm volatile("s_waitcnt lgkmcnt(" #n ")" ::: "memory")
#define PG8_BAR __builtin_amdgcn_s_barrier()
#define PG8_SCHED __builtin_amdgcn_sched_barrier(0)
#define PG8_KTA(p, tau) ((p).A + ((!Prob::TWO_SRC || (tau) < 16) ? (long)(tau) * kstep : (long)((tau) - 16) * kstep - 2048))
#define PG8_KTB(p, tau) ((p).B + ((!Prob::TWO_SRC || (tau) < 16) ? (long)(tau) * kstep : (long)((tau) - 16) * kstep + lb2d))
    Unit cur, nxt; int ui = 0;
    if (!S.next(0, cur)) return;
    UnitPtrs cp, np; P.ptrs(cur, cp);
    f32x4 acc[2][2][4][2];
#pragma unroll
    for (int a = 0; a < 2; ++a)
#pragma unroll
        for (int b = 0; b < 2; ++b)
#pragma unroll
            for (int m = 0; m < 4; ++m)
#pragma unroll
                for (int n = 0; n < 2; ++n) acc[a][b][m][n] = (f32x4){0.f, 0.f, 0.f, 0.f};
    bf16x8 At[4][2], B0[2][2], B1[2][2];
    {
        const GAS char* cA = cp.A; const GAS char* cB = cp.B;
        PG8_STAGE(PG8_SB(0, 0), cB, voffB); PG8_STAGE(PG8_SB(0, 1), cB + hstepB, voffB); PG8_STAGE(PG8_SA(0, 0), cA, voffA); PG8_STAGE(PG8_SA(0, 1), cA + hstepA, voffA);
        if (wr == 1) PG8_BAR;
        PG8_WAIT_V(2); PG8_BAR;
        PG8_STAGE(PG8_SB(1, 0), cB + kstep, voffB); PG8_STAGE(PG8_SA(1, 0), cA + kstep, voffA); PG8_STAGE(PG8_SB(1, 1), cB + hstepB + kstep, voffB);
        PG8_WAIT_V(6); PG8_BAR;
    }
    for (;;) {
        const bool has_next = S.next(ui + 1, nxt);
        if (has_next) P.ptrs(nxt, np); else np = cp;
        int nt = Prob::NTC; if constexpr (Prob::TWO_SRC) { if (cp.two) nt = 32; }
        for (int t = 0; t < nt; t += 2) {
            const bool last = (t == nt - 2);
            const GAS char* a1 = PG8_KTA(cp, t + 1);
            const GAS char* a2 = last ? np.A : PG8_KTA(cp, t + 2); const GAS char* b2 = last ? np.B : PG8_KTB(cp, t + 2);
            const GAS char* a3 = a2 + kstep; const GAS char* b3 = b2 + kstep;
            PG8_LDB(B0, 0, 0); PG8_LDB(B1, 0, 1); PG8_SCHED; PG8_LDA(At, 0, 0); PG8_STAGE(PG8_SA(1, 1), a1 + hstepA, voffA);
            PG8_WAIT_V(8); PG8_WAIT_L(0); PG8_BAR; PG8_MMA(0, 0, At, B0); PG8_MMA(0, 1, At, B1); PG8_BAR; PG8_SCHED;
            PG8_LDA(At, 0, 1); PG8_STAGE(PG8_SB(0, 0), b2, voffB); PG8_STAGE(PG8_SB(0, 1), b2 + hstepB, voffB); PG8_STAGE(PG8_SA(0, 0), a2, voffA);
            PG8_WAIT_V(8); PG8_WAIT_L(0); PG8_BAR; PG8_MMA(1, 0, At, B0); PG8_MMA(1, 1, At, B1); PG8_BAR; PG8_SCHED;
            PG8_LDB(B0, 1, 0); PG8_LDB(B1, 1, 1); PG8_SCHED; PG8_LDA(At, 1, 0); PG8_STAGE(PG8_SA(0, 1), a2 + hstepA, voffA);
            PG8_WAIT_V(8); PG8_WAIT_L(0); PG8_BAR; PG8_MMA(0, 0, At, B0); PG8_MMA(0, 1, At, B1); PG8_BAR; PG8_SCHED;
            PG8_LDA(At, 1, 1); PG8_STAGE(PG8_SB(1, 0), b3, voffB); PG8_STAGE(PG8_SB(1, 1), b3 + hstepB, voffB); PG8_STAGE(PG8_SA(1, 0), a3, voffA);
            PG8_WAIT_V(8); PG8_WAIT_L(0); PG8_BAR; PG8_MMA(1, 0, At, B0); PG8_MMA(1, 1, At, B1); PG8_BAR; PG8_SCHED;
        }
        if (wr == 0) PG8_BAR;
        E(acc, cur, wr, wc, fr, fq);
        if (!has_next) break;
#pragma unroll
        for (int a = 0; a < 2; ++a)
#pragma unroll
            for (int b = 0; b < 2; ++b)
#pragma unroll
                for (int m = 0; m < 4; ++m)
#pragma unroll
                    for (int n = 0; n < 2; ++n) acc[a][b][m][n] = (f32x4){0.f, 0.f, 0.f, 0.f};
        cur = nxt; cp = np; ++ui;
        if (wr == 1) PG8_BAR;
    }
    PG8_WAIT_V(0);
    PG8_BAR;
#undef PG8_SA
#undef PG8_SB
#undef PG8_STAGE
#undef PG8_LDA
#undef PG8_LDB
#undef PG8_MMA
#undef PG8_WAIT_V
#undef PG8_WAIT_L
#undef PG8_BAR
#undef PG8_SCHED
#undef PG8_KTA
#undef PG8_KTB
}
}

struct Frame {
    LAS unsigned char* lds;
    int tid, lane, wave, vcu, G, gw, NGW;
};
#define DPP_ADD(v, ctrl) v += __builtin_bit_cast(float, __builtin_amdgcn_update_dpp(0, __builtin_bit_cast(int, v), ctrl, 0xF, 0xF, true))
__device__ __forceinline__ float wave_sum(float v) {
    DPP_ADD(v, 0xB1); DPP_ADD(v, 0x4E); DPP_ADD(v, 0x141); DPP_ADD(v, 0x140);
    v += __shfl_xor(v, 16); v += __shfl_xor(v, 32);
    return v;
}
__device__ __forceinline__ void cvt_item(const GAS float* W, int ldw, GAS bf16_t* WT, int ldt, int k0, int n0, const GAS float* sc, int mode, LAS float* scr, int lane) {
#pragma unroll 8
    for (int i = 0; i < 32; ++i) { const int kk = 2 * i + (lane >> 5); float v = W[(size_t)(k0 + kk) * ldw + n0 + (lane & 31)];
        if (mode) { const float s = sc[k0 + kk]; v *= (mode == 1) ? s : (1.0f - s); }
        scr[kk * 33 + (lane & 31)] = v; }
    LDS_WAIT(); asm volatile("" ::: "memory");
    const int c = lane & 7;
#pragma unroll
    for (int j = 0; j < 4; ++j) { const int n = (lane >> 3) + 8 * j; const LAS float* s = scr + (8 * c) * 33 + n;
        u32x4 o; o.x = pk2(s[0 * 33], s[1 * 33]); o.y = pk2(s[2 * 33], s[3 * 33]); o.z = pk2(s[4 * 33], s[5 * 33]); o.w = pk2(s[6 * 33], s[7 * 33]);
        *(GAS u32x4*)(WT + (size_t)(n0 + n) * ldt + k0 + 8 * c) = o; }
    LDS_WAIT(); asm volatile("" ::: "memory");
}
__device__ __forceinline__ void cvt_matrix(const Frame& F, const GAS float* W, int ldw, int K, int N, GAS bf16_t* WT, int ldt, const GAS float* sc, int mode, int& cursor) {
    LAS float* scr = (LAS float*)(F.lds + F.wave * 16384);
    const int nnb = N / 32, nitems = (K / 64) * nnb;
    int first = (F.gw - cursor) % F.NGW; if (first < 0) first += F.NGW;
    for (int it = first; it < nitems; it += F.NGW) cvt_item(W, ldw, WT, ldt, 64 * (it / nnb), 32 * (it % nnb), sc, mode, scr, F.lane);
    cursor += nitems;
}
struct Inputs { const float* p[25]; };
#define INP(i) ((const GAS float*)in.p[i])
__device__ __forceinline__ void convert_layer(const Frame& F, const Inputs& in, GAS bf16_t* Wb, int L) {
    int cur = 0;
    if ((L & 1) == 0) {
        const int e = L >> 1;
        cvt_matrix(F, INP(2) + (size_t)e * 1024 * PITCH_WIN, PITCH_WIN, 1024, NPROJ, Wb + W_IN, 1024, nullptr, 0, cur);
        cvt_matrix(F, INP(6) + (size_t)e * 1024 * 1024, 1024, 1024, 1024, Wb + W_OUTE, 1024, nullptr, 0, cur);
    } else {
        const int o = L >> 1; const GAS float* mu = INP(7) + (size_t)o * 6 * 1024;
        for (int j = 0; j < 3; ++j) cvt_matrix(F, INP(8) + ((size_t)o * 3 + j) * 1024 * 1024, 1024, 1024, 1024, Wb + W_RKV + (size_t)j * 1024 * 1024, 1024, nullptr, 0, cur);
        for (int s = 0; s < 2; ++s) { GAS bf16_t* LB = Wb + (s ? W_LB2 : W_LB1); const int mode = s ? 1 : 2;
            cvt_matrix(F, INP(10) + (size_t)o * 1024 * 64, 64, 1024, 64, LB, 1024, mu + 1 * 1024, mode, cur);
            cvt_matrix(F, INP(13) + (size_t)o * 1024 * 64, 64, 1024, 64, LB + 64 * 1024, 1024, mu + 4 * 1024, mode, cur);
            cvt_matrix(F, INP(15) + (size_t)o * 1024 * 128, 128, 1024, 128, LB + 128 * 1024, 1024, mu + 5 * 1024, mode, cur); }
        cvt_matrix(F, INP(11) + (size_t)o * 64 * 1024, 1024, 64, 1024, Wb + W_W2T, 64, nullptr, 0, cur);
        cvt_matrix(F, INP(14) + (size_t)o * 64 * 1024, 1024, 64, 1024, Wb + W_A2T, 64, nullptr, 0, cur);
        cvt_matrix(F, INP(16) + (size_t)o * 128 * 1024, 1024, 128, 1024, Wb + W_G2T, 128, nullptr, 0, cur);
        cvt_matrix(F, INP(22) + (size_t)o * 1024 * 1024, 1024, 1024, 1024, Wb + W_OUTO, 1024, nullptr, 0, cur);
    }
    cvt_matrix(F, INP(23) + (size_t)L * 1024 * FF, FF, 1024, FF, Wb + W_UP, 1024, nullptr, 0, cur);
    cvt_matrix(F, INP(24) + (size_t)L * FF * 1024, 1024, FF, 1024, Wb + W_DN, FF, nullptr, 0, cur);
}

struct RowPassArgs {
    const GAS float* hsrc; const GAS bf16_t* y; const GAS float* gpost; GAS float* hdst;
    GAS bf16_t* udst; const GAS float* gpre; int upad;
    const GAS float* gate_w; const GAS float* gate_b; GAS float* gates;
};
template <int R>
__device__ __forceinline__ void row_pass(const Frame& F, const RowPassArgs& A) {
    LAS float* GWT = (LAS float*)(F.lds + 65536);
    if (A.gates) {
        for (int idx = F.tid; idx < 8192; idx += NWAVES * 64) { const int k = idx >> 3, j = idx & 7; GWT[j * 1024 + k] = A.gate_w[(size_t)k * PITCH_WIN + NPROJ + j]; }
        __syncthreads();
    }
    f32x4 gp[4], gq[4];
#pragma unroll
    for (int j = 0; j < 4; ++j) { gp[j] = A.gpost ? *(const GAS f32x4*)(A.gpost + 4 * F.lane + 256 * j) : (f32x4){0.f, 0.f, 0.f, 0.f}; gq[j] = A.gpre ? *(const GAS f32x4*)(A.gpre + 4 * F.lane + 256 * j) : (f32x4){0.f, 0.f, 0.f, 0.f}; }
    for (int base = F.gw * R; base < CM; base += F.NGW * R) {
        f32x4 hv[R][4]; u32x2 yw[R][4];
#pragma unroll
        for (int r = 0; r < R; ++r)
#pragma unroll
            for (int j = 0; j < 4; ++j) { hv[r][j] = *(const GAS f32x4*)(A.hsrc + (size_t)(base + r) * CD + 4 * F.lane + 256 * j); if (A.y) yw[r][j] = ld8(A.y + (size_t)(base + r) * CD + 4 * F.lane + 256 * j); }
        if (A.y) {
            f32x4 yf[R][4]; float ss[R];
#pragma unroll
            for (int r = 0; r < R; ++r) { ss[r] = 0.f;
#pragma unroll
                for (int j = 0; j < 4; ++j) { const u32x2 w = yw[r][j];
                    yf[r][j] = (f32x4){bf2f((unsigned short)(w.x & 0xffffu)), bf2f((unsigned short)(w.x >> 16)), bf2f((unsigned short)(w.y & 0xffffu)), bf2f((unsigned short)(w.y >> 16))};
                    ss[r] += (yf[r][j][0] * yf[r][j][0] + yf[r][j][1] * yf[r][j][1]) + (yf[r][j][2] * yf[r][j][2] + yf[r][j][3] * yf[r][j][3]); } }
#pragma unroll
            for (int r = 0; r < R; ++r) ss[r] = wave_sum(ss[r]);
#pragma unroll
            for (int r = 0; r < R; ++r) { const float rs = __builtin_amdgcn_rsqf(ss[r] * (1.0f / CD) + NORM_EPS);
#pragma unroll
                for (int j = 0; j < 4; ++j) { hv[r][j] += yf[r][j] * rs * gp[j]; *(GAS f32x4*)(A.hdst + (size_t)(base + r) * CD + 4 * F.lane + 256 * j) = hv[r][j]; } }
        }
        if (A.udst) {
            float ss[R];
#pragma unroll
            for (int r = 0; r < R; ++r) { ss[r] = 0.f;
#pragma unroll
                for (int j = 0; j < 4; ++j) ss[r] += (hv[r][j][0] * hv[r][j][0] + hv[r][j][1] * hv[r][j][1]) + (hv[r][j][2] * hv[r][j][2] + hv[r][j][3] * hv[r][j][3]); }
#pragma unroll
            for (int r = 0; r < R; ++r) ss[r] = wave_sum(ss[r]);
#pragma unroll
            for (int r = 0; r < R; ++r) {
                const int row = base + r;
                const float rs = __builtin_amdgcn_rsqf(ss[r] * (1.0f / CD) + NORM_EPS);
                const size_t urow = A.upad ? (size_t)row + (size_t)(row / CS) + 1 : (size_t)row;
                f32x4 uf[4];
#pragma unroll
                for (int j = 0; j < 4; ++j) { uf[j] = hv[r][j] * rs * gq[j]; *(GAS u32x2*)(A.udst + urow * CD + 4 * F.lane + 256 * j) = pack4(uf[j]); }
                if (A.upad && (row % CS) == 0) {
#pragma unroll
                    for (int j = 0; j < 4; ++j) *(GAS u32x2*)(A.udst + (urow - 1) * CD + 4 * F.lane + 256 * j) = (u32x2){0u, 0u};
                }
                if (A.gates) {
                    float v[8];
                    int goff = 4 * F.lane; asm volatile("" : "+v"(goff));
#pragma unroll
                    for (int g = 0; g < 8; ++g) { float s = 0.f;
#pragma unroll
                        for (int j = 0; j < 4; ++j) { const f32x4 w = *(const LAS f32x4*)(GWT + g * 1024 + goff + 256 * j); s += (uf[j][0] * w[0] + uf[j][1] * w[1]) + (uf[j][2] * w[2] + uf[j][3] * w[3]); }
                        v[g] = s; }
                    const bool b5 = (F.lane & 32) != 0, b4 = (F.lane & 16) != 0, b3 = (F.lane & 8) != 0;
                    float r4[4], r2[2];
#pragma unroll
                    for (int i = 0; i < 4; ++i) { const float snd = b5 ? v[i] : v[i + 4], kp = b5 ? v[i + 4] : v[i]; r4[i] = kp + __shfl_xor(snd, 32); }
#pragma unroll
                    for (int i = 0; i < 2; ++i) { const float snd = b4 ? r4[i] : r4[i + 2], kp = b4 ? r4[i + 2] : r4[i]; r2[i] = kp + __shfl_xor(snd, 16); }
                    float r1; { const float snd = b3 ? r2[0] : r2[1], kp = b3 ? r2[1] : r2[0]; r1 = kp + __shfl_xor(snd, 8); }
                    r1 += __shfl_xor(r1, 4); r1 += __shfl_xor(r1, 2); r1 += __shfl_xor(r1, 1);
                    if ((F.lane & 7) == 0) { const int o = F.lane >> 3; float g = r1 + A.gate_b[o]; if (o >= 4) g = -softplusf(-g); A.gates[(size_t)row * 8 + o] = g; }
                }
            }
        }
    }
}
__device__ __forceinline__ void mix_pass(const Frame& F, const GAS bf16_t* Upad, const GAS float* mu, GAS bf16_t* XR, GAS bf16_t* XK, GAS bf16_t* XV) {
    f32x4 m0[4], m2[4], m3[4];
#pragma unroll
    for (int j = 0; j < 4; ++j) { m0[j] = *(const GAS f32x4*)(mu + 0 * 1024 + 4 * F.lane + 256 * j); m2[j] = *(const GAS f32x4*)(mu + 2 * 1024 + 4 * F.lane + 256 * j); m3[j] = *(const GAS f32x4*)(mu + 3 * 1024 + 4 * F.lane + 256 * j); }
    constexpr int R = 4;
    for (int base = F.gw * R; base < CM; base += F.NGW * R) {
        u32x2 a[R][4], b[R][4];
#pragma unroll
        for (int r = 0; r < R; ++r) { const size_t urow = (size_t)(base + r) + (size_t)((base + r) / CS) + 1;
#pragma unroll
            for (int j = 0; j < 4; ++j) { const size_t c = 4 * F.lane + 256 * j; a[r][j] = ld8(Upad + urow * CD + c); b[r][j] = ld8(Upad + (urow - 1) * CD + c); } }
#pragma unroll
        for (int r = 0; r < R; ++r)
#pragma unroll
            for (int j = 0; j < 4; ++j) {
                const size_t c = 4 * F.lane + 256 * j;
                const f32x4 u = {bf2f((unsigned short)(a[r][j].x & 0xffffu)), bf2f((unsigned short)(a[r][j].x >> 16)), bf2f((unsigned short)(a[r][j].y & 0xffffu)), bf2f((unsigned short)(a[r][j].y >> 16))};
                const f32x4 p = {bf2f((unsigned short)(b[r][j].x & 0xffffu)), bf2f((unsigned short)(b[r][j].x >> 16)), bf2f((unsigned short)(b[r][j].y & 0xffffu)), bf2f((unsigned short)(b[r][j].y >> 16))};
                const f32x4 xx = p - u;
                *(GAS u32x2*)(XR + (size_t)(base + r) * CD + c) = pack4(u + xx * m0[j]);
                *(GAS u32x2*)(XK + (size_t)(base + r) * CD + c) = pack4(u + xx * m2[j]);
                *(GAS u32x2*)(XV + (size_t)(base + r) * CD + c) = pack4(u + xx * m3[j]);
            }
    }
}
__device__ __forceinline__ void conv_vt_pass(const Frame& F, const GAS bf16_t* PROJ, const GAS float* convw, GAS bf16_t* QKC, GAS bf16_t* VT, const GAS float* GATES, GAS float* SCA, GAS float* SCM, GAS float* SCE) {
    if (blockIdx.x < 32) { const int st = blockIdx.x, b = st >> 2, mh = st & 3; mlstm_gate_scan_wg(F.wave, GATES + (size_t)b * CS * 8, mh, 4 + mh, CS, SCA + (size_t)st * CS, SCM + (size_t)st * CS, SCE + (size_t)st * CS, (LAS float*)(F.lds + 80000)); }
    {
        const int cg = F.tid & 127, rs = F.tid >> 7, c0 = 8 * cg;
        float w[4][8];
#pragma unroll
        for (int j = 0; j < 4; ++j) { const f32x4 a = *(const GAS f32x4*)(convw + j * 1024 + c0), b = *(const GAS f32x4*)(convw + j * 1024 + c0 + 4);
#pragma unroll
            for (int q = 0; q < 4; ++q) { w[j][q] = a[q]; w[j][4 + q] = b[q]; } }
        const float osc = (c0 >= 512) ? 0.08838834764831845f : 1.0f;
        for (int ub = blockIdx.x; ub < CM / 64; ub += F.G) {
            const int r0 = ub * 64 + rs * 16;
            u32x4 x0, x1, x2;
            const int tin = r0 % CS;
            const u32x4 zz = {0u, 0u, 0u, 0u};
            x0 = (tin >= 3) ? ld16(PROJ + (size_t)(r0 - 3) * NPROJ + 1536 + c0) : zz;
            x1 = (tin >= 2) ? ld16(PROJ + (size_t)(r0 - 2) * NPROJ + 1536 + c0) : zz;
            x2 = (tin >= 1) ? ld16(PROJ + (size_t)(r0 - 1) * NPROJ + 1536 + c0) : zz;
#pragma unroll 4
            for (int i = 0; i < 16; ++i) {
                const u32x4 x3 = ld16(PROJ + (size_t)(r0 + i) * NPROJ + 1536 + c0);
                u32x4 o;
#pragma unroll
                for (int q = 0; q < 4; ++q) {
                    float acc0 = w[0][2 * q] * bf2f((unsigned short)(x0[q] & 0xffffu)) + w[1][2 * q] * bf2f((unsigned short)(x1[q] & 0xffffu)) + w[2][2 * q] * bf2f((unsigned short)(x2[q] & 0xffffu)) + w[3][2 * q] * bf2f((unsigned short)(x3[q] & 0xffffu));
                    float acc1 = w[0][2 * q + 1] * bf2f((unsigned short)(x0[q] >> 16)) + w[1][2 * q + 1] * bf2f((unsigned short)(x1[q] >> 16)) + w[2][2 * q + 1] * bf2f((unsigned short)(x2[q] >> 16)) + w[3][2 * q + 1] * bf2f((unsigned short)(x3[q] >> 16));
                    acc0 = acc0 * sigmoidf_(acc0) * osc; acc1 = acc1 * sigmoidf_(acc1) * osc;
                    o[q] = pk2(acc0, acc1);
                }
                *(GAS u32x4*)(QKC + (size_t)(r0 + i) * CD + c0) = o;
                x0 = x1; x1 = x2; x2 = x3;
            }
        }
    }
    {
        LAS unsigned char* tile = F.lds + F.wave * 9216;
        for (int it = F.gw; it < CB * 8 * (CS / 64); it += F.NGW) {
            const int bh = it / (CS / 64), tb = it % (CS / 64), b = bh >> 3, h = bh & 7;
            const size_t tok0 = (size_t)b * CS + (size_t)tb * 64;
#pragma unroll
            for (int i = 0; i < 8; ++i) { const int r = 8 * i + (F.lane >> 3), ch = F.lane & 7;
                *(LAS u32x4*)(tile + r * 144 + ch * 16) = ld16(PROJ + (tok0 + r) * NPROJ + 1024 + 64 * h + 8 * ch); }
            LDS_WAIT(); asm volatile("" ::: "memory");
#pragma unroll
            for (int i = 0; i < 8; ++i) { const int pidx = i * 64 + F.lane, d = pidx >> 3, tg = pidx & 7;
                unsigned short e[8];
#pragma unroll
                for (int q = 0; q < 8; ++q) e[q] = *(const LAS unsigned short*)(tile + (8 * tg + q) * 144 + d * 2);
                u32x4 o = {(unsigned)e[0] | ((unsigned)e[1] << 16), (unsigned)e[2] | ((unsigned)e[3] << 16), (unsigned)e[4] | ((unsigned)e[5] << 16), (unsigned)e[6] | ((unsigned)e[7] << 16)};
                *(GAS u32x4*)(VT + ((size_t)bh * 64 + d) * CS + (size_t)tb * 64 + 8 * tg) = o; }
            LDS_WAIT(); asm volatile("" ::: "memory");
        }
    }
}
#ifndef MLFORM
#define MLFORM 1
#endif
#if MLFORM == 4
#define MLWG 32
#else
#define MLWG 64
#endif
__device__ __forceinline__ void mixers_even_phase(const Frame& F, const GAS bf16_t* PROJ, const GAS bf16_t* QKC, const GAS bf16_t* VT, const GAS float* SCA, const GAS float* SCM, GAS bf16_t* MIXCAT, GAS bf16_t* NUM, GAS float* DEN) {
    const int wg = blockIdx.x;
#ifndef NO_ML
    if (wg < MLWG) {
        LAS unsigned* flags = (LAS unsigned*)(F.lds + LDSCTL_OFF);
        if (F.tid < 64) flags[F.tid] = 0u;
        __syncthreads();
#if MLFORM == 4
        const int st = wg, b = st >> 2, mh = st & 3; const size_t r0 = (size_t)b * CS;
        mlstm_coop32<4, 2>(F.wave, 0, true, QKC + r0 * CD + 128 * mh, QKC + r0 * CD + 512 + 128 * mh, CD, PROJ + r0 * NPROJ + 2560 + 128 * mh, NPROJ, SCA + (size_t)st * CS, SCM + (size_t)st * CS, CS,
                           NUM + r0 * 512 + 128 * mh, 512, DEN + r0 * 4 + mh, 4, F.lds, flags);
#else
        const int st = wg >> 1, half = wg & 1, b = st >> 2, mh = st & 3; const size_t r0 = (size_t)b * CS;
#ifdef ABL_PROBE
        { const unsigned long long t0 = __builtin_amdgcn_s_memrealtime();
          mlstm_coop32<1, 4, ABL_PROBE>(F.wave, 64 * half, half == 0, QKC + r0 * CD + 128 * mh, QKC + r0 * CD + 512 + 128 * mh, CD, PROJ + r0 * NPROJ + 2560 + 128 * mh, NPROJ, SCA + (size_t)st * CS, SCM + (size_t)st * CS, CS,
                           NUM + (size_t)17 * 1048576 + r0 * 512 + 128 * mh, 512, DEN + (size_t)115 * 1048576 + r0 * 4 + mh, 4, F.lds, flags);
          __syncthreads();
          if (blockIdx.x == 0 && F.tid == 0) ((volatile LAS unsigned long long*)(F.lds + MISC_OFF + 64))[1] += __builtin_amdgcn_s_memrealtime() - t0;
          if (F.tid < 64) flags[F.tid] = 0u;
          __syncthreads(); }
#endif
        mlstm_coop32<1, 4>(F.wave, 64 * half, half == 0, QKC + r0 * CD + 128 * mh, QKC + r0 * CD + 512 + 128 * mh, CD, PROJ + r0 * NPROJ + 2560 + 128 * mh, NPROJ, SCA + (size_t)st * CS, SCM + (size_t)st * CS, CS,
                           NUM + r0 * 512 + 128 * mh, 512, DEN + r0 * 4 + mh, 4, F.lds, flags);
#endif
        return;
    }
#endif
#ifndef NO_SB
    const int worker = (wg - MLWG) * NWAVES + F.wave;
    constexpr int NWORK = (256 - MLWG) * NWAVES, NUNIT = CB * 8 * (CS / 32);
    for (int u = worker; u < NUNIT; u += NWORK) {
        const int bh = u / (CS / 32), qb = u % (CS / 32), b = bh >> 3, h = bh & 7;
        const size_t r0 = (size_t)b * CS;
        sb_attn_unit(PROJ + r0 * NPROJ + 64 * h, PROJ + r0 * NPROJ + 512 + 64 * h, NPROJ, VT + (size_t)bh * 64 * CS, CS, MIXCAT + r0 * CD + 64 * h, CD, 32 * qb);
    }
#endif
}
__device__ __forceinline__ void mlstm_post_pass(const Frame& F, const GAS bf16_t* NUM, const GAS float* DEN, const GAS float* SCE, const GAS bf16_t* PROJ, const GAS float* head_g, GAS bf16_t* MIXCAT) {
    const int hd = F.lane >> 4;
    f32x4 g0 = *(const GAS f32x4*)(head_g + 8 * F.lane), g1 = *(const GAS f32x4*)(head_g + 8 * F.lane + 4);
    for (int row = F.gw; row < CM; row += F.NGW) {
        const u32x4 nv = ld16(NUM + (size_t)row * 512 + 8 * F.lane), ov = ld16(PROJ + (size_t)row * NPROJ + 3072 + 8 * F.lane);
        const float den = DEN[(size_t)row * 4 + hd], emt = SCE[(size_t)((row / CS) * 4 + hd) * CS + (row % CS)];
        const float inv = __builtin_amdgcn_rcpf(fmaxf(fabsf(den), emt));
        float hvv[8]; float ss = 0.f;
#pragma unroll
        for (int q = 0; q < 4; ++q) { hvv[2 * q] = bf2f((unsigned short)(nv[q] & 0xffffu)) * inv; hvv[2 * q + 1] = bf2f((unsigned short)(nv[q] >> 16)) * inv; ss += hvv[2 * q] * hvv[2 * q] + hvv[2 * q + 1] * hvv[2 * q + 1]; }
        ss += __shfl_xor(ss, 1); ss += __shfl_xor(ss, 2); ss += __shfl_xor(ss, 4); ss += __shfl_xor(ss, 8);
        const float rs = __builtin_amdgcn_rsqf(ss * (1.0f / 128.0f) + NORM_EPS);
        u32x4 o;
#pragma unroll
        for (int q = 0; q < 4; ++q) {
            const float ga = (q < 2) ? g0[2 * q] : g1[2 * q - 4], gb = (q < 2) ? g0[2 * q + 1] : g1[2 * q - 3];
            const float a = hvv[2 * q] * rs * ga * sigmoidf_(bf2f((unsigned short)(ov[q] & 0xffffu)));
            const float b = hvv[2 * q + 1] * rs * gb * sigmoidf_(bf2f((unsigned short)(ov[q] >> 16)));
            o[q] = pk2(a, b);
        }
        *(GAS u32x4*)(MIXCAT + (size_t)row * CD + 512 + 8 * F.lane) = o;
    }
}
#ifndef PH_MASK
#define PH_MASK 0xFFFFFFFFu
#endif
#define PH(k) ((PH_MASK >> (k)) & 1u)
#ifndef PROBE_MASK
#define PROBE_MASK 0u
#endif
#define REPS(k) (((PROBE_MASK >> (k)) & 1u) ? 2 : 1)
#ifndef PROBE_T
#define PROBE_T 0u
#endif
#define TWORDS ((volatile LAS unsigned long long*)((LAS unsigned char*)lds_raw + MISC_OFF + 64))
#ifndef PROBE_BLK
#define PROBE_BLK 0
#endif
#ifdef CLK_PHASE
#define CLKS(k) do { if ((k) == CLK_PHASE && blockIdx.x == PROBE_BLK && T0_()) TWORDS[2] = __builtin_amdgcn_s_memtime(); } while (0)
#define CLKE(k) do { if ((k) == CLK_PHASE && blockIdx.x == PROBE_BLK && T0_()) TWORDS[1] += (__builtin_amdgcn_s_memtime() - TWORDS[2]) / 100ull; } while (0)
#else
#define CLKS(k) do {} while (0)
#define CLKE(k) do {} while (0)
#endif
#define TSTART(k) do { if (((PROBE_T >> (k)) & 1u) && blockIdx.x == PROBE_BLK && T0_()) TWORDS[0] = __builtin_amdgcn_s_memrealtime(); } while (0)
#define TEND(k) do { if (((PROBE_T >> (k)) & 1u) && blockIdx.x == PROBE_BLK && T0_()) TWORDS[1] += __builtin_amdgcn_s_memrealtime() - TWORDS[0]; } while (0)
struct Args { Inputs in; float* out; unsigned char* ws; };
__device__ __forceinline__ Frame make_frame(LAS unsigned char* lds, int wave_s) {
    Frame F; int bx = blockIdx.x; asm volatile("" : "+s"(bx)); int wv = wave_s; asm volatile("" : "+s"(wv));
    F.lds = lds; F.lane = lane_id(); F.wave = wv; F.tid = wv * 64 + F.lane;
    F.G = gridDim.x; F.vcu = (F.G % 8 == 0) ? (bx % 8) * (F.G / 8) + bx / 8 : bx;
    F.gw = F.vcu * NWAVES + F.wave; F.NGW = F.G * NWAVES; return F;
}
#define PHASE_BEGIN Frame F = make_frame((LAS unsigned char*)lds_raw, wave_s_); unsigned char* wsg_ = args.ws; asm volatile("" : "+s"(wsg_)); GAS unsigned char* ws = (GAS unsigned char*)wsg_; (void)F; \
    GAS bf16_t* Wb = (GAS bf16_t*)(ws + WS_W); GAS bf16_t* U = (GAS bf16_t*)(ws + WS_U); (void)Wb; (void)U; GAS float* HOUT = (GAS float*)args.out; (void)HOUT;
#define T0_() (wave_s_ == 0 && lane_id() == 0)
#define GRID_BAR() do { unsigned char* wsb = args.ws; asm volatile("" : "+s"(wsb)); XcdBarrier bar; bar.bar = (unsigned*)(wsb + WS_CTL) + CW_BAR; bar.x = xb_xcc_id(); \
    bar.st = (volatile LAS unsigned*)((LAS unsigned char*)lds_raw + MISC_OFF) + 8; xcd_barrier(bar, T0_()); } while (0)
__global__ void __launch_bounds__(NWAVES * 64, 2) hybrid_fwd(Args args) {
    extern __shared__ __attribute__((aligned(16))) unsigned char lds_raw[];
    const int wave_s_ = __builtin_amdgcn_readfirstlane((int)(threadIdx.x >> 6));
    {
        LAS unsigned char* l3 = (LAS unsigned char*)lds_raw;
        for (int u = threadIdx.x; u < (LDS_BYTES - LDSCTL_OFF) / 4; u += NWAVES * 64) ((LAS unsigned*)(l3 + LDSCTL_OFF))[u] = 0u;
        __syncthreads();
        (void)xcd_barrier_post((unsigned*)(args.ws + WS_CTL) + CW_BAR, (volatile LAS unsigned*)(l3 + MISC_OFF) + 8, T0_());
    }
    const Inputs& in = args.in;
    {
        PHASE_BEGIN
        if (PH(0)) { convert_layer(F, in, Wb, 0); }
        __syncthreads();
        if (PH(1)) { RowPassArgs A{INP(0), nullptr, nullptr, nullptr, U, INP(1) + 0, 0, INP(2), INP(3), (GAS float*)(ws + WS_GATES)}; row_pass<2>(F, A); }
    }
    GRID_BAR();

    for (int L = 0; L < 4; ++L) {
        if ((L & 1) == 0) {
            const int e = L >> 1;
            TSTART(2); CLKS(2);
            if (PH(2)) {
                PHASE_BEGIN
                pg8::ProbPlain<1024, 1024, 16> P{U, Wb + W_IN}; pg8::StaticOrder S; S.init(CM, NPROJ, F.G, (int)blockIdx.x);
                pg8::EpiStore E{(GAS bf16_t*)(ws + WS_PROJ), NPROJ, 0, 0, 0, nullptr};
                pg8::gemm_phase(F.lds, F.wave, P, S, E);
            }
            GRID_BAR();
            CLKE(2); TEND(2);
            TSTART(3); CLKS(3);
            if (PH(3)) { PHASE_BEGIN conv_vt_pass(F, (const GAS bf16_t*)(ws + WS_PROJ), INP(4) + (size_t)e * 4 * 1024, (GAS bf16_t*)(ws + WS_QKC), (GAS bf16_t*)(ws + WS_VT), (const GAS float*)(ws + WS_GATES), (GAS float*)(ws + WS_SCA), (GAS float*)(ws + WS_SCM), (GAS float*)(ws + WS_EMT)); }
            GRID_BAR();
            CLKE(3); TEND(3);
            TSTART(4); CLKS(4);
            if (PH(4)) { PHASE_BEGIN mixers_even_phase(F, (const GAS bf16_t*)(ws + WS_PROJ), (const GAS bf16_t*)(ws + WS_QKC), (const GAS bf16_t*)(ws + WS_VT), (const GAS float*)(ws + WS_SCA), (const GAS float*)(ws + WS_SCM), U  , (GAS bf16_t*)(ws + WS_NUM), (GAS float*)(ws + WS_DEN)); }
#ifdef E3_PRE
            __syncthreads(); CLKE(4); TEND(4);
#endif
            GRID_BAR();
#ifndef E3_PRE
            CLKE(4); TEND(4);
#endif
            TSTART(5); CLKS(5);
            if (PH(5)) { PHASE_BEGIN mlstm_post_pass(F, (const GAS bf16_t*)(ws + WS_NUM), (const GAS float*)(ws + WS_DEN), (const GAS float*)(ws + WS_EMT), (const GAS bf16_t*)(ws + WS_PROJ), INP(5) + (size_t)e * 512, U); }
            GRID_BAR();
            CLKE(5); TEND(5);
        } else {
            const int o = L >> 1;
            TSTART(6); CLKS(6);
            if (PH(6)) { PHASE_BEGIN mix_pass(F, U, INP(7) + (size_t)o * 6 * 1024, (GAS bf16_t*)(ws + WS_XR), (GAS bf16_t*)(ws + WS_XK), (GAS bf16_t*)(ws + WS_XV)); }
            GRID_BAR();
            CLKE(6); TEND(6);
            TSTART(7); CLKS(7);
            if (PH(7)) {
                PHASE_BEGIN
                pg8::ProbRkv P{(const GAS bf16_t*)(ws + WS_XR), (size_t)(WS_XK - WS_XR) / 2, Wb + W_RKV, U, Wb + W_LB1, (long)(W_LB2 - W_LB1) * 2};
                pg8::RkvOrder S{F.vcu};
                pg8::EpiStore E{(GAS bf16_t*)(ws + WS_RO), 1024, 0, 1, (size_t)(WS_KO - WS_RO) / 2, (GAS bf16_t*)(ws + WS_LORA)};
                pg8::gemm_phase(F.lds, F.wave, P, S, E);
            }
            GRID_BAR();
            CLKE(7); TEND(7);
            TSTART(8); CLKS(8);
            if (PH(8)) {
                PHASE_BEGIN
                RwkvPrepArgs P{(const GAS bf16_t*)(ws + WS_RO), (const GAS bf16_t*)(ws + WS_KO), CD, (const GAS bf16_t*)(ws + WS_LORA), 256, Wb + W_W2T, Wb + W_A2T, INP(9) + (size_t)o * 1024, INP(12) + (size_t)o * 1024, INP(17) + (size_t)o * 1024, INP(18) + (size_t)o * 1024,
                               INP(19) + (size_t)o * 1024, (GAS bf16_t*)(ws + WS_KT), (GAS bf16_t*)(ws + WS_BT), (GAS bf16_t*)(ws + WS_KK), (GAS bf16_t*)(ws + WS_RT), (GAS float*)(ws + WS_GL), (GAS float*)(ws + WS_BONUS)};
                rwkv_prep_loop(P, F.gw, F.NGW, (CM / 16) * 16, F.lds + F.wave * 10240);
            }
            GRID_BAR();
            CLKE(8); TEND(8);
            TSTART(9); CLKS(9);
            if (PH(9)) {
                PHASE_BEGIN
#ifdef LAT_PROBE
                if (blockIdx.x == LAT_PROBE && T0_()) {
                    const GAS unsigned* base = (const GAS unsigned*)(ws + WS_KT) + (size_t)(blockIdx.x >> 4) * CS * 512 + (blockIdx.x & 15) * 32; unsigned x = 0;
                    const unsigned long long t0 = __builtin_amdgcn_s_memrealtime();
                    for (int i = 0; i < 256; ++i) { x = base[(size_t)(i * 16 + (x & 1u)) * 512]; }
                    const unsigned long long t1 = __builtin_amdgcn_s_memrealtime();
                    TWORDS[1] += (t1 - t0) + (x == 0x12345u ? 1 : 0);
                }
#endif
#ifdef CLK_PROBE
                if (blockIdx.x == 0 && T0_()) TWORDS[2] = __builtin_amdgcn_s_memtime();
#endif
                if (blockIdx.x < 128) {
                    if (F.tid < 64) ((LAS unsigned*)(F.lds + RWS_FLAGS))[F.tid] = 0u;
                    __syncthreads();
                    const int bh = blockIdx.x, b = bh >> 4, h = bh & 15;
                    const size_t r0 = (size_t)b * CS, co = 64 * h;
                    rwkv_scan_coop(F.wave, (const GAS bf16_t*)(ws + WS_KT) + r0 * CD + co, (const GAS bf16_t*)(ws + WS_BT) + r0 * CD + co, (const GAS bf16_t*)(ws + WS_KK) + r0 * CD + co, (const GAS bf16_t*)(ws + WS_RT) + r0 * CD + co,
                                   (const GAS bf16_t*)(ws + WS_VO) + r0 * CD + co, CD, (const GAS float*)(ws + WS_GL) + (r0 / 16) * 1024 + co, CS, (GAS bf16_t*)(ws + WS_YRAW) + r0 * CD + co, CD, F.lds);
#ifdef COOP_PROBE
                    __syncthreads(); if (blockIdx.x == 0 && T0_()) TWORDS[1] += ((LAS unsigned*)(F.lds + RWS_FLAGS))[32 + COOP_PROBE];
#endif
#ifdef CLK_PROBE
                    if (blockIdx.x == 0 && T0_()) TWORDS[1] += (__builtin_amdgcn_s_memtime() - TWORDS[2]) / 100ull;
#endif
                }
            }
#ifdef R9_PRE
            __syncthreads(); CLKE(9); TEND(9);
#endif
            GRID_BAR();
#ifndef R9_PRE
            CLKE(9); TEND(9);
#endif
            TSTART(10); CLKS(10);
            if (PH(10)) {
                PHASE_BEGIN
                rwkv_post_loop((const GAS bf16_t*)(ws + WS_YRAW), (const GAS bf16_t*)(ws + WS_VO), (const GAS bf16_t*)(ws + WS_LORA), Wb + W_G2T, (const GAS float*)(ws + WS_BONUS), INP(20) + (size_t)o * 1024, INP(21) + (size_t)o * 1024, (GAS bf16_t*)(ws + WS_YG), CD, F.gw, F.NGW, (CM / 16) * 16, F.lds + F.wave * 10240);
            }
            GRID_BAR();
            CLKE(10); TEND(10);
        }
        TSTART(11); CLKS(11);
        if (PH(11)) {
            PHASE_BEGIN
            const bool odd = (L & 1) != 0;
            pg8::ProbPlain<1024, 1024, 16> P{odd ? (const GAS bf16_t*)(ws + WS_YG) : (const GAS bf16_t*)U, Wb + (odd ? W_OUTO : W_OUTE)}; pg8::StaticOrder S; S.init(CM, CD, F.G, (int)blockIdx.x);
            pg8::EpiStore E{(GAS bf16_t*)(ws + WS_MIX), CD, 0, 0, 0, nullptr};
            pg8::gemm_phase(F.lds, F.wave, P, S, E);
        }
        GRID_BAR();
        CLKE(11); TEND(11);
        TSTART(12); CLKS(12);
        if (PH(12)) { PHASE_BEGIN const GAS float* ng = INP(1) + (size_t)L * 4 * 1024; RowPassArgs A{L == 0 ? INP(0) : HOUT, (const GAS bf16_t*)(ws + WS_MIX), ng + 1 * 1024, HOUT, U, ng + 2 * 1024, 0, nullptr, nullptr, nullptr}; row_pass<4>(F, A); }
        GRID_BAR();
        CLKE(12); TEND(12);
#ifdef CLK_PROBE2
        if (blockIdx.x == 0 && T0_()) TWORDS[2] = __builtin_amdgcn_s_memtime();
#endif
        TSTART(13); CLKS(13);
        if (PH(13)) {
            PHASE_BEGIN
            pg8::ProbPlain<1024, 1024, 16> P{U, Wb + W_UP}; pg8::StaticOrder S; S.init(CM, FF, F.G, (int)blockIdx.x);
            pg8::EpiStore E{(GAS bf16_t*)(ws + WS_HID), FF, 1, 0, 0, nullptr};
            pg8::gemm_phase(F.lds, F.wave, P, S, E);
        }
        GRID_BAR();
#ifdef CLK_PROBE2
        if (blockIdx.x == 0 && T0_()) TWORDS[1] += (__builtin_amdgcn_s_memtime() - TWORDS[2]) / 100ull;
#endif
        CLKE(13); TEND(13);
        TSTART(14); CLKS(14);
        if (PH(14)) {
            PHASE_BEGIN
            pg8::ProbPlain<FF, FF, 64> P{(const GAS bf16_t*)(ws + WS_HID), Wb + W_DN}; pg8::StaticOrder S; S.init(CM, CD, F.G, (int)blockIdx.x);
            pg8::EpiStore E{(GAS bf16_t*)(ws + WS_FFO), CD, 0, 0, 0, nullptr};
            pg8::gemm_phase(F.lds, F.wave, P, S, E);
        }
        GRID_BAR();
        CLKE(14); TEND(14);
        TSTART(15); CLKS(15);
        if (PH(15)) {
            PHASE_BEGIN
            const GAS float* ng = INP(1) + (size_t)L * 4 * 1024;
            const bool lastL = (L == 3); const bool next_even = ((L + 1) & 1) == 0;
            if (!lastL) { convert_layer(F, in, Wb, L + 1); }
            __syncthreads();
            const GAS float* ngn = INP(1) + (size_t)(L + 1) * 4 * 1024;
            const bool gts = !lastL && next_even;
            RowPassArgs A{HOUT, (const GAS bf16_t*)(ws + WS_FFO), ng + 3 * 1024, HOUT, lastL ? nullptr : U, lastL ? nullptr : ngn, next_even ? 0 : 1,
                          gts ? INP(2) + (size_t)((L + 1) >> 1) * 1024 * PITCH_WIN : nullptr, gts ? INP(3) + (size_t)((L + 1) >> 1) * 8 : nullptr, gts ? (GAS float*)(ws + WS_GATES) : nullptr};
            row_pass<2>(F, A);
        }
        if (L < 3) GRID_BAR();
        CLKE(15); TEND(15);
    }
#ifdef BAR_PROBE
    for (int i = 0; i < BAR_PROBE; ++i) GRID_BAR();
#endif
    if (PROBE_T != 0u && blockIdx.x == PROBE_BLK && T0_()) {
        const unsigned long long te = __builtin_amdgcn_s_memrealtime() + 4ull * TWORDS[1];
        while (__builtin_amdgcn_s_memrealtime() < te) __builtin_amdgcn_s_sleep(8);
    }
}

extern "C" void kernel_launch(void* const* d_in, const int* in_sizes, int n_in, void* d_out, int out_size, void* d_ws, size_t ws_size, hipStream_t stream) {
    static int grid = 0;
    if (grid == 0) {
        if (n_in != 25 || out_size != CM * CD || ws_size < WS_END) { fprintf(stderr, "kernel_launch: unexpected shapes (n_in %d, out %d, ws %zu)\n", n_in, out_size, ws_size); grid = -1; return; }
        int dev = 0, cus = 0, per_cu = 0;
        if (hipGetDevice(&dev) != hipSuccess || hipDeviceGetAttribute(&cus, hipDeviceAttributeMultiprocessorCount, dev) != hipSuccess) { grid = -1; return; }
        if (hipFuncSetAttribute((const void*)hybrid_fwd, hipFuncAttributeMaxDynamicSharedMemorySize, LDS_BYTES) != hipSuccess) { grid = -1; return; }
        if (hipOccupancyMaxActiveBlocksPerMultiprocessor(&per_cu, (const void*)hybrid_fwd, NWAVES * 64, LDS_BYTES) != hipSuccess || per_cu < 1) fprintf(stderr, "kernel_launch: occupancy query reports %d\n", per_cu);
        (void)hipGetLastError();
        grid = cus;
        if (grid != 256) fprintf(stderr, "kernel_launch: %d CUs (the phase deals assume 256)\n", grid);
    }
    if (grid < 0) return;
    if (hipMemsetAsync((char*)d_ws + WS_CTL, 0, CTL_ZERO_BYTES, stream) != hipSuccess) return;
    Args a{};
    for (int i = 0; i < 25; ++i) a.in.p[i] = (const float*)d_in[i];
    a.out = (float*)d_out; a.ws = (unsigned char*)d_ws;
    hipLaunchKernelGGL(hybrid_fwd, dim3(grid), dim3(NWAVES * 64), LDS_BYTES, stream, a);
}
```

```cpp
#include <hip/hip_runtime.h>
#include <cstdio>
#include <cstdint>
typedef short bf16x8 __attribute__((ext_vector_type(8)));
typedef short s16x4 __attribute__((ext_vector_type(4)));
typedef float f32x4 __attribute__((ext_vector_type(4)));
typedef float f32x16 __attribute__((ext_vector_type(16)));
typedef unsigned u32x4 __attribute__((ext_vector_type(4)));
typedef unsigned u32x2 __attribute__((ext_vector_type(2)));
#ifdef HOST_EMU
#define GQ
#define LDSQ
#define DI inline
DI int lane_id() { return emu_lane(); }
DI s16x4 TR16(const LDSQ void* p) { return emu_tr16(p); }
DI unsigned short f2bf(float f) { return (unsigned short)emu_f2bf(f); }
#define MEMFENCE() do {} while (0)
#define WAVE_SYNC() emu_sync()
#else
#define LDSQ __attribute__((address_space(3)))
#define GQ __attribute__((address_space(1)))
#define DI __device__ __forceinline__
typedef short v4i16_t __attribute__((ext_vector_type(4)));
typedef __bf16 bf16x2_t __attribute__((ext_vector_type(2)));
typedef float f32x2_t __attribute__((ext_vector_type(2)));
DI int lane_id() { int l = (int)__builtin_amdgcn_mbcnt_hi(~0u, __builtin_amdgcn_mbcnt_lo(~0u, 0u)); asm volatile("" : "+v"(l)); return l; }
DI s16x4 TR16(const LDSQ void* p) { return __builtin_bit_cast(s16x4, __builtin_amdgcn_ds_read_tr16_b64_v4i16((LDSQ v4i16_t*)p)); }
DI unsigned short f2bf(float f) { f32x2_t v = {f, 0.f}; bf16x2_t b = __builtin_convertvector(v, bf16x2_t); return (unsigned short)(__builtin_bit_cast(unsigned, b) & 0xffffu); }
#define MEMFENCE() asm volatile("" ::: "memory")
#define WAVE_SYNC() do {} while (0)
#endif
typedef unsigned short bf16_t;
#ifdef HOST_EMU
#define ROW_SHR(v, d) ((lane_id() & 15) >= (d) ? __shfl_up((v), (d), 16) : (__shfl_up((v), (d), 16), 0.f))
#else
#define ROW_SHR(v, d) __builtin_bit_cast(float, __builtin_amdgcn_update_dpp(0, __builtin_bit_cast(int, (v)), 0x110 + (d), 0xF, 0xF, true))
#endif
DI float bf2f(unsigned short s) { unsigned u = ((unsigned)s) << 16; return __builtin_bit_cast(float, u); }
DI unsigned pk2(float lo, float hi) {
#ifdef HOST_EMU
    return (unsigned)f2bf(lo) | ((unsigned)f2bf(hi) << 16);
#else
    f32x2_t v = {lo, hi}; bf16x2_t b = __builtin_convertvector(v, bf16x2_t); return __builtin_bit_cast(unsigned, b);
#endif
}
DI f32x4 mfma16(bf16x8 a, bf16x8 b, f32x4 c) { return __builtin_amdgcn_mfma_f32_16x16x32_bf16(a, b, c, 0, 0, 0); }
DI f32x16 mfma32(bf16x8 a, bf16x8 b, f32x16 c) { return __builtin_amdgcn_mfma_f32_32x32x16_bf16(a, b, c, 0, 0, 0); }
DI bf16x8 mk8(u32x2 lo, u32x2 hi) { u32x4 v = {lo.x, lo.y, hi.x, hi.y}; return __builtin_bit_cast(bf16x8, v); }
DI u32x2 pack4(f32x4 v) { u32x2 r = {pk2(v[0], v[1]), pk2(v[2], v[3])}; return r; }
DI u32x2 ld8(const GQ bf16_t* p) { return *(const GQ u32x2*)p; }
DI u32x4 ld16(const GQ bf16_t* p) { return *(const GQ u32x4*)p; }
DI u32x2 tr2(s16x4 v) { return __builtin_bit_cast(u32x2, v); }
DI u32x2 ldl8(const LDSQ unsigned char* p) { return *(const LDSQ u32x2*)p; }
DI float fexp(float x) { return __builtin_amdgcn_exp2f(x * 1.4426950408889634f); }
DI float flog(float x) { return __builtin_amdgcn_logf(x) * 0.6931471805599453f; }
DI float softplusf(float x) { return fmaxf(x, 0.f) + flog(1.0f + fexp(-fabsf(x))); }
DI float sigmoidf_(float x) { return __builtin_amdgcn_rcpf(1.0f + fexp(-x)); }
DI float tanhf_(float x) { const float xc = fminf(fmaxf(x, -15.f), 15.f); const float e = fexp(2.f * xc); return (e - 1.f) * __builtin_amdgcn_rcpf(e + 1.f); }

#define SB_STOP 36.0f
DI int crow32(int i, int h) { return (i & 3) + 8 * (i >> 2) + 4 * h; }
DI void sb_attn_unit(const GQ bf16_t* __restrict__ Q, const GQ bf16_t* __restrict__ K, int ldqk, const GQ bf16_t* __restrict__ VT, int S, GQ bf16_t* __restrict__ O, int ldo, int t0  ) {
    const int lane = lane_id(), r = lane & 31, hi = lane >> 5;
    bf16x8 qf[4];
#pragma unroll
    for (int s = 0; s < 4; ++s) qf[s] = __builtin_bit_cast(bf16x8, ld16(Q + (size_t)(t0 + r) * ldqk + 16 * s + 8 * hi));
    f32x16 o0, o1;
#pragma unroll
    for (int i = 0; i < 16; ++i) { o0[i] = 0.f; o1[i] = 0.f; }
    float carry = 0.f;
    const int tq = t0 + r;
    u32x4 kn[4]; u32x2 vn[8];
    int s0 = t0;
#define SB_LOAD(kd, vd, s0_) do { \
    _Pragma("unroll") for (int s = 0; s < 4; ++s) kd[s] = ld16(K + (size_t)((s0_) + r) * ldqk + 16 * s + 8 * hi); \
    _Pragma("unroll") for (int db = 0; db < 2; ++db) _Pragma("unroll") for (int s = 0; s < 2; ++s) { \
        const GQ bf16_t* vp = VT + (size_t)(32 * db + r) * S + (s0_) + 16 * s + 4 * hi; vd[(db * 2 + s) * 2] = ld8(vp); vd[(db * 2 + s) * 2 + 1] = ld8(vp + 8); } } while (0)
    SB_LOAD(kn, vn, s0);
    for (;;) {
        u32x4 kc[4]; u32x2 vc[8];
#pragma unroll
        for (int s = 0; s < 4; ++s) kc[s] = kn[s];
#pragma unroll
        for (int s = 0; s < 8; ++s) vc[s] = vn[s];
        const int sn = s0 - 32;
        if (sn >= 0) SB_LOAD(kn, vn, sn);
        f32x16 z;
#pragma unroll
        for (int i = 0; i < 16; ++i) z[i] = 0.f;
#pragma unroll
        for (int s = 0; s < 4; ++s) z = mfma32(__builtin_bit_cast(bf16x8, kc[s]), qf[s], z);
        float sp[16];
        const bool diag = (s0 == t0);
#pragma unroll
        for (int i = 0; i < 16; ++i) { z[i] *= 0.125f; const bool valid = !diag || (s0 + crow32(i, hi) < tq); sp[i] = valid ? softplusf(z[i]) : 0.f; if (!valid) z[i] = -1e30f; }
        float gs[4], pg[4];
#pragma unroll
        for (int g = 0; g < 4; ++g) gs[g] = (sp[4 * g] + sp[4 * g + 1]) + (sp[4 * g + 2] + sp[4 * g + 3]);
#pragma unroll
        for (int g = 0; g < 4; ++g) pg[g] = __shfl_xor(gs[g], 32);
        float after[4];
        {
            const float o3 = 0.f, o2 = gs[3], o1_ = gs[3] + gs[2], o0_ = o1_ + gs[1];
            const float p3i = pg[3], p2i = pg[3] + pg[2], p1i = p2i + pg[1], p0i = p1i + pg[0];
            const float pe3 = 0.f, pe2 = p3i, pe1 = p2i, pe0 = p1i;
            after[0] = o0_ + (hi ? pe0 : p0i); after[1] = o1_ + (hi ? pe1 : p1i); after[2] = o2 + (hi ? pe2 : p2i); after[3] = o3 + (hi ? pe3 : p3i);
        }
        const float tot = (gs[0] + gs[1]) + (gs[2] + gs[3]) + (pg[0] + pg[1]) + (pg[2] + pg[3]);
        f32x16 p;
#pragma unroll
        for (int g = 0; g < 4; ++g) {
            float c = carry + after[g];
#pragma unroll
            for (int j = 3; j >= 0; --j) { c += sp[4 * g + j]; p[4 * g + j] = fexp(z[4 * g + j] - c); }
        }
        carry += tot;
#pragma unroll
        for (int s = 0; s < 2; ++s) {
            u32x4 pb = {pk2(p[8 * s], p[8 * s + 1]), pk2(p[8 * s + 2], p[8 * s + 3]), pk2(p[8 * s + 4], p[8 * s + 5]), pk2(p[8 * s + 6], p[8 * s + 7])};
            const bf16x8 pbv = __builtin_bit_cast(bf16x8, pb);
            o0 = mfma32(mk8(vc[(0 * 2 + s) * 2], vc[(0 * 2 + s) * 2 + 1]), pbv, o0);
            o1 = mfma32(mk8(vc[(1 * 2 + s) * 2], vc[(1 * 2 + s) * 2 + 1]), pbv, o1);
        }
        if (sn < 0) break;
        if (__all(carry > SB_STOP)) break;
        s0 = sn;
    }
#undef SB_LOAD
#pragma unroll
    for (int g = 0; g < 4; ++g) {
        u32x2 w0 = {pk2(o0[4 * g], o0[4 * g + 1]), pk2(o0[4 * g + 2], o0[4 * g + 3])};
        u32x2 w1 = {pk2(o1[4 * g], o1[4 * g + 1]), pk2(o1[4 * g + 2], o1[4 * g + 3])};
        GQ bf16_t* op = O + (size_t)(t0 + r) * ldo + 8 * g + 4 * hi;
        *(GQ u32x2*)op = w0; *(GQ u32x2*)(op + 32) = w1;
    }
}

DI void mlstm_stream(const GQ bf16_t* __restrict__ Qp, const GQ bf16_t* __restrict__ Kp, int ldqk, const GQ bf16_t* __restrict__ Vp, int ldv, const GQ float* __restrict__ G, int gi, int gf,
                     int S, int den, GQ bf16_t* __restrict__ NUM, int ldn, GQ float* __restrict__ DEN, GQ float* __restrict__ EMT, int ldd, LDSQ unsigned char* lds) {
    const int lane = lane_id(), fr = lane & 15, fq = lane >> 4;
    LDSQ unsigned char* Kimg = lds;
    LDSQ unsigned char* Vimg = lds + 4096;
    f32x4 C[8];
#pragma unroll
    for (int ci = 0; ci < 8; ++ci) C[ci] = (f32x4){0.f, 0.f, 0.f, 0.f};
    float Fcarry = 0.f, Mcarry = 0.f;
    const int NC = S / 16;
    u32x2 qn[8], kn[8]; u32x4 vn = {0u, 0u, 0u, 0u}; float lin, lfn;
#define ML_LOAD(c_) do { const size_t row = (size_t)(16 * (c_) + fr); \
    _Pragma("unroll") for (int ks = 0; ks < 4; ++ks) { qn[2 * ks] = ld8(Qp + row * ldqk + 32 * ks + 4 * fq); qn[2 * ks + 1] = ld8(Qp + row * ldqk + 32 * ks + 16 + 4 * fq); \
        kn[2 * ks] = ld8(Kp + row * ldqk + 32 * ks + 4 * fq); kn[2 * ks + 1] = ld8(Kp + row * ldqk + 32 * ks + 16 + 4 * fq); } \
    if (!den && lane < 32) vn = ld16(Vp + (size_t)(16 * (c_) + (lane >> 1)) * ldv + 8 * (lane & 1)); \
    lin = G[row * 8 + gi]; lfn = G[row * 8 + gf]; } while (0)
    ML_LOAD(0);
    for (int c = 0; c < NC; ++c) {
        u32x2 qc[8], kc[8]; u32x4 vcur = vn; const float li = lin, lf = lfn;
#pragma unroll
        for (int i = 0; i < 8; ++i) { qc[i] = qn[i]; kc[i] = kn[i]; }
        if (c + 1 < NC) ML_LOAD(c + 1);
        MEMFENCE();
#pragma unroll
        for (int ks = 0; ks < 4; ++ks) { *(LDSQ u32x2*)(Kimg + fr * 256 + (32 * ks + 4 * fq) * 2) = kc[2 * ks]; *(LDSQ u32x2*)(Kimg + fr * 256 + (32 * ks + 16 + 4 * fq) * 2) = kc[2 * ks + 1]; }
        if (den) { if (lane < 32) { u32x4 e0 = {(lane & 1) ? 0u : 0x3F80u, 0u, 0u, 0u}; *(LDSQ u32x4*)(Vimg + (lane >> 1) * 32 + (lane & 1) * 16) = e0; } }
        else { if (lane < 32) *(LDSQ u32x4*)(Vimg + (lane >> 1) * 32 + (lane & 1) * 16) = vcur; }
        MEMFENCE();
        float inc = lf;
#pragma unroll
        for (int d = 1; d < 16; d <<= 1) { const float t = __shfl_up(inc, d, 16); if (fr >= d) inc += t; }
        const float Fg = Fcarry + inc, a = li - Fg;
        float mx = a;
#pragma unroll
        for (int d = 1; d < 16; d <<= 1) { const float t = __shfl_up(mx, d, 16); if (fr >= d) mx = fmaxf(mx, t); }
        const float Mx = fmaxf(Mcarry, mx);
        const float Mend = __shfl(Mx, 15, 16), Ftot = __shfl(inc, 15, 16);
        float as_[4], Mxs[4], Fgs[4];
#pragma unroll
        for (int i = 0; i < 4; ++i) { as_[i] = __shfl(a, 4 * fq + i, 16); Mxs[i] = __shfl(Mx, 4 * fq + i, 16); Fgs[i] = __shfl(Fg, 4 * fq + i, 16); }
        f32x4 st = {0.f, 0.f, 0.f, 0.f};
#pragma unroll
        for (int ks = 0; ks < 4; ++ks) st = mfma16(mk8(kc[2 * ks], kc[2 * ks + 1]), mk8(qc[2 * ks], qc[2 * ks + 1]), st);
        f32x4 pt;
#pragma unroll
        for (int i = 0; i < 4; ++i) pt[i] = (4 * fq + i <= fr) ? st[i] * fexp(as_[i] - Mx) : 0.f;
        const s16x4 v4 = TR16(Vimg + (4 * fq + (fr >> 2)) * 32 + 8 * (fr & 3));
        const u32x2 z2 = {0u, 0u};
        f32x4 numI = mfma16(mk8(pack4(pt), z2), mk8(tr2(v4), z2), (f32x4){0.f, 0.f, 0.f, 0.f});
        f32x4 inter = {0.f, 0.f, 0.f, 0.f};
#pragma unroll
        for (int ks = 0; ks < 4; ++ks) inter = mfma16(mk8(qc[2 * ks], qc[2 * ks + 1]), mk8(pack4(C[2 * ks]), pack4(C[2 * ks + 1])), inter);
        f32x4 num;
#pragma unroll
        for (int i = 0; i < 4; ++i) num[i] = numI[i] + fexp(Mcarry - Mxs[i]) * inter[i];
        if (den) {
            if (fr == 0) {
#pragma unroll
                for (int i = 0; i < 4; ++i) { const size_t row = (size_t)(16 * c + 4 * fq + i); DEN[row * ldd] = num[i]; EMT[row * ldd] = fexp(-(Fgs[i] + Mxs[i])); }
            }
        } else {
#pragma unroll
            for (int i = 0; i < 4; ++i) NUM[(size_t)(16 * c + 4 * fq + i) * ldn + fr] = f2bf(num[i]);
        }
        const float wstate = fexp(Mcarry - Mend);
        f32x4 vw;
#pragma unroll
        for (int i = 0; i < 4; ++i) vw[i] = bf2f((unsigned short)v4[i]) * fexp(as_[i] - Mend);
        const bf16x8 vwb = mk8(pack4(vw), z2);
#pragma unroll
        for (int ci = 0; ci < 8; ++ci) {
            const s16x4 k4 = TR16(Kimg + (4 * fq + (fr >> 2)) * 256 + (16 * ci + 4 * (fr & 3)) * 2);
            C[ci] = mfma16(mk8(tr2(k4), z2), vwb, C[ci] * wstate);
        }
        Mcarry = Mend; Fcarry += Ftot;
        MEMFENCE();
    }
#undef ML_LOAD
}

struct RwkvPrepArgs {
    const GQ bf16_t *R, *K; int ld;
    const GQ bf16_t* LORA; int ldl;
    const GQ bf16_t *W2T, *A2T;
    const GQ float *w0, *a0, *k_k, *k_a, *r_k;
    GQ bf16_t *KT, *BT, *KK, *RT;
    GQ float* GL;
    GQ float* BONUS;
};
struct RwkvPrepIn { u32x4 lw[2], la[2]; u32x2 r2[4], k2[4]; };
DI void rwkv_prep_load(const RwkvPrepArgs& P, int chunk, int h, RwkvPrepIn& I) {
    const int lane = lane_id(), fr = lane & 15, fq = lane >> 4;
    const size_t row = (size_t)chunk * 16 + fr;
#pragma unroll
    for (int s = 0; s < 2; ++s) { I.lw[s] = ld16(P.LORA + row * P.ldl + 32 * s + 8 * fq); I.la[s] = ld16(P.LORA + row * P.ldl + 64 + 32 * s + 8 * fq); }
#pragma unroll
    for (int ti = 0; ti < 4; ++ti) { const int ch0 = 64 * h + 16 * ti + 4 * fq; I.r2[ti] = ld8(P.R + row * P.ld + ch0); I.k2[ti] = ld8(P.K + row * P.ld + ch0); }
}
DI void rwkv_prep_compute(const RwkvPrepArgs& P, int chunk, int h, const RwkvPrepIn& I) {
    const int lane = lane_id(), fr = lane & 15, fq = lane >> 4;
    const size_t row = (size_t)chunk * 16 + fr;
    bf16x8 bw[2], ba[2];
#pragma unroll
    for (int s = 0; s < 2; ++s) {
        u32x4 t;
#pragma unroll
        for (int j = 0; j < 4; ++j) { const unsigned w = I.lw[s][j]; t[j] = pk2(tanhf_(bf2f((unsigned short)(w & 0xffffu))), tanhf_(bf2f((unsigned short)(w >> 16)))); }
        bw[s] = __builtin_bit_cast(bf16x8, t);
        ba[s] = __builtin_bit_cast(bf16x8, I.la[s]);
    }
    float ss = 0.f, bon = 0.f;
    float kap[16], av[16], kp[16], rv[16], ld_[16];
#pragma unroll
    for (int ti = 0; ti < 4; ++ti) {
        const int chl = 16 * ti + fr;
        f32x4 dw = {0.f, 0.f, 0.f, 0.f}, da = {0.f, 0.f, 0.f, 0.f};
#pragma unroll
        for (int s = 0; s < 2; ++s) {
            dw = mfma16(__builtin_bit_cast(bf16x8, ld16(P.W2T + (size_t)(64 * h + chl) * 64 + 32 * s + 8 * fq)), bw[s], dw);
            da = mfma16(__builtin_bit_cast(bf16x8, ld16(P.A2T + (size_t)(64 * h + chl) * 64 + 32 * s + 8 * fq)), ba[s], da);
        }
        const int ch0 = 64 * h + 16 * ti + 4 * fq;
        const u32x2 r2 = I.r2[ti], k2 = I.k2[ti];
        const f32x4 w0v = *(const GQ f32x4*)(P.w0 + ch0), a0v = *(const GQ f32x4*)(P.a0 + ch0), kkv = *(const GQ f32x4*)(P.k_k + ch0), kav = *(const GQ f32x4*)(P.k_a + ch0), rkv = *(const GQ f32x4*)(P.r_k + ch0);
#pragma unroll
        for (int i = 0; i < 4; ++i) {
            const int e = 4 * ti + i;
            const float r = bf2f((unsigned short)((i & 1) ? (r2[i >> 1] >> 16) : (r2[i >> 1] & 0xffffu)));
            const float k = bf2f((unsigned short)((i & 1) ? (k2[i >> 1] >> 16) : (k2[i >> 1] & 0xffffu)));
            const float wl = w0v[i] + dw[i];
            const float logw = -softplusf(-wl) - 0.5f;
            ld_[e] = -fexp(logw);
            const float a = sigmoidf_(a0v[i] + da[i]);
            const float kkr = k * kkv[i];
            ss += kkr * kkr;
            const float k1 = k * (1.0f + (a - 1.0f) * kav[i]);
            bon += r * k1 * rkv[i];
            kap[e] = kkr; av[e] = a; kp[e] = k1; rv[e] = r;
        }
    }
    ss += __shfl_xor(ss, 16); ss += __shfl_xor(ss, 32);
    bon += __shfl_xor(bon, 16); bon += __shfl_xor(bon, 32);
    const float rn = __builtin_amdgcn_rsqf(fmaxf(ss, 1e-24f));
    if (fq == 0) P.BONUS[row * 16 + h] = bon;
#pragma unroll
    for (int ti = 0; ti < 4; ++ti) {
        const int ch0 = 64 * h + 16 * ti + 4 * fq;
        f32x4 okt, obt, okk, ort, ogl;
#pragma unroll
        for (int i = 0; i < 4; ++i) {
            const int e = 4 * ti + i;
            float cs = ld_[e];
            cs += ROW_SHR(cs, 1); cs += ROW_SHR(cs, 2); cs += ROW_SHR(cs, 4); cs += ROW_SHR(cs, 8);
            const float gi = fexp(cs), ginv = __builtin_amdgcn_rcpf(gi);
            float gx = ROW_SHR(gi, 1); if (fr == 0) gx = 1.0f;
            const float kappa = kap[e] * rn;
            okt[i] = kappa * gx; obt[i] = kappa * av[e] * ginv; okk[i] = kp[e] * ginv; ort[i] = rv[e] * gi; ogl[i] = gi;
        }
        *(GQ u32x2*)(P.KT + row * P.ld + ch0) = pack4(okt);
        *(GQ u32x2*)(P.BT + row * P.ld + ch0) = pack4(obt);
        *(GQ u32x2*)(P.KK + row * P.ld + ch0) = pack4(okk);
        *(GQ u32x2*)(P.RT + row * P.ld + ch0) = pack4(ort);
        if (fr == 15) *(GQ f32x4*)(P.GL + (size_t)chunk * 1024 + ch0) = ogl;
    }
}
DI void rwkv_prep_unit(const RwkvPrepArgs& P, int chunk, int h) { RwkvPrepIn I; rwkv_prep_load(P, chunk, h, I); rwkv_prep_compute(P, chunk, h, I); }
constexpr int RPP = 144, RPT = 16 * RPP, RPL = 272, RP_R = 0, RP_K = RPT, RP_L = 2 * RPT, RP_BYTES = 4 * RPT;
DI void rwkv_prep_loop(const RwkvPrepArgs& P, int first, int stride, int nunits, LDSQ unsigned char* scr) {
    if (first >= nunits) return;
    const int lane = lane_id(), fr = lane & 15, fq = lane >> 4, h = first & 15;
    const int lrow = lane >> 3, lpc = lane & 7, qrow = lane >> 4, qpc = lane & 15;
    bf16x8 wA[4][2];
#pragma unroll
    for (int ti = 0; ti < 4; ++ti)
#pragma unroll
        for (int s = 0; s < 2; ++s) wA[ti][s] = __builtin_bit_cast(bf16x8, ld16(P.W2T + (size_t)(64 * h + 16 * ti + fr) * 64 + 32 * s + 8 * fq));
    u32x4 tr_[2], tk_[2], tl_[4];
#define RP_LOAD(u_) do { const size_t r0_ = (size_t)((u_) >> 4) * 16; \
    _Pragma("unroll") for (int hf = 0; hf < 2; ++hf) { tr_[hf] = ld16(P.R + (r0_ + 8 * hf + lrow) * P.ld + 64 * h + 8 * lpc); tk_[hf] = ld16(P.K + (r0_ + 8 * hf + lrow) * P.ld + 64 * h + 8 * lpc); } \
    _Pragma("unroll") for (int g = 0; g < 4; ++g) tl_[g] = ld16(P.LORA + (r0_ + 4 * g + qrow) * P.ldl + 8 * qpc); } while (0)
#define RP_PARK() do { MEMFENCE(); \
    _Pragma("unroll") for (int hf = 0; hf < 2; ++hf) { *(LDSQ u32x4*)(scr + RP_R + (8 * hf + lrow) * RPP + lpc * 16) = tr_[hf]; *(LDSQ u32x4*)(scr + RP_K + (8 * hf + lrow) * RPP + lpc * 16) = tk_[hf]; } \
    _Pragma("unroll") for (int g = 0; g < 4; ++g) *(LDSQ u32x4*)(scr + RP_L + (4 * g + qrow) * RPL + qpc * 16) = tl_[g]; MEMFENCE(); WAVE_SYNC(); } while (0)
    RP_LOAD(first); RP_PARK();
    for (int u = first; u < nunits; u += stride) {
        const int chunk = u >> 4;
        const size_t row = (size_t)chunk * 16 + fr;
        if (u + stride < nunits) RP_LOAD(u + stride);
        bf16x8 bw[2], ba[2];
#pragma unroll
        for (int s = 0; s < 2; ++s) {
            bw[s] = __builtin_bit_cast(bf16x8, *(const LDSQ u32x4*)(scr + RP_L + fr * RPL + (32 * s + 8 * fq) * 2));
            ba[s] = __builtin_bit_cast(bf16x8, *(const LDSQ u32x4*)(scr + RP_L + fr * RPL + (64 + 32 * s + 8 * fq) * 2));
        }
        u32x2 r2a[4], k2a[4];
#pragma unroll
        for (int ti = 0; ti < 4; ++ti) { r2a[ti] = ldl8(scr + RP_R + fr * RPP + (16 * ti + 4 * fq) * 2); k2a[ti] = ldl8(scr + RP_K + fr * RPP + (16 * ti + 4 * fq) * 2); }
        MEMFENCE(); WAVE_SYNC();
        float ss = 0.f, bon = 0.f;
        float kap[16], av[16], kp[16], ld_[16];
#pragma unroll
        for (int ti = 0; ti < 4; ++ti) {
            f32x4 dw = {0.f, 0.f, 0.f, 0.f}, da = {0.f, 0.f, 0.f, 0.f};
#pragma unroll
            for (int s = 0; s < 2; ++s) { dw = mfma16(wA[ti][s], bw[s], dw); da = mfma16(__builtin_bit_cast(bf16x8, ld16(P.A2T + (size_t)(64 * h + 16 * ti + fr) * 64 + 32 * s + 8 * fq)), ba[s], da); }
            const int ch0 = 64 * h + 16 * ti + 4 * fq;
            const u32x2 r2 = r2a[ti], k2 = k2a[ti];
            const f32x4 w0v = *(const GQ f32x4*)(P.w0 + ch0), a0v = *(const GQ f32x4*)(P.a0 + ch0), kkv = *(const GQ f32x4*)(P.k_k + ch0), kav = *(const GQ f32x4*)(P.k_a + ch0), rkv = *(const GQ f32x4*)(P.r_k + ch0);
#pragma unroll
            for (int i = 0; i < 4; ++i) {
                const int e = 4 * ti + i;
                const float r = bf2f((unsigned short)((i & 1) ? (r2[i >> 1] >> 16) : (r2[i >> 1] & 0xffffu)));
                const float k = bf2f((unsigned short)((i & 1) ? (k2[i >> 1] >> 16) : (k2[i >> 1] & 0xffffu)));
                ld_[e] = -0.6065306597126334f * sigmoidf_(w0v[i] + dw[i]);
                const float a = sigmoidf_(a0v[i] + da[i]);
                const float kkr = k * kkv[i];
                ss += kkr * kkr;
                const float k1 = k * (1.0f + (a - 1.0f) * kav[i]);
                bon += r * k1 * rkv[i];
                kap[e] = kkr; av[e] = a; kp[e] = k1;
            }
        }
        ss += __shfl_xor(ss, 16); ss += __shfl_xor(ss, 32);
        bon += __shfl_xor(bon, 16); bon += __shfl_xor(bon, 32);
        const float rn = __builtin_amdgcn_rsqf(fmaxf(ss, 1e-24f));
        if (fq == 0) P.BONUS[row * 16 + h] = bon;
#pragma unroll
        for (int ti = 0; ti < 4; ++ti) {
            f32x4 okt, obt, okk, ort, ogl;
#pragma unroll
            for (int i = 0; i < 4; ++i) {
                const int e = 4 * ti + i;
                float cs = ld_[e];
                cs += ROW_SHR(cs, 1); cs += ROW_SHR(cs, 2); cs += ROW_SHR(cs, 4); cs += ROW_SHR(cs, 8);
                const float gi = fexp(cs), ginv = __builtin_amdgcn_rcpf(gi);
                float gx = ROW_SHR(gi, 1); if (fr == 0) gx = 1.0f;
                const float kappa = kap[e] * rn;
                const float rr_ = bf2f((unsigned short)((i & 1) ? (r2a[ti][i >> 1] >> 16) : (r2a[ti][i >> 1] & 0xffffu)));
                okt[i] = kappa * gx; obt[i] = kappa * av[e] * ginv; okk[i] = kp[e] * ginv; ort[i] = rr_ * gi; ogl[i] = gi;
            }
            const int o = fr * RPP + (16 * ti + 4 * fq) * 2;
            *(LDSQ u32x2*)(scr + 0 * RPT + o) = pack4(okt); *(LDSQ u32x2*)(scr + 1 * RPT + o) = pack4(obt); *(LDSQ u32x2*)(scr + 2 * RPT + o) = pack4(okk); *(LDSQ u32x2*)(scr + 3 * RPT + o) = pack4(ort);
            if (fr == 15) *(GQ f32x4*)(P.GL + (size_t)chunk * 1024 + 64 * h + 16 * ti + 4 * fq) = ogl;
        }
        MEMFENCE(); WAVE_SYNC();
#pragma unroll
        for (int hf = 0; hf < 2; ++hf) {
            const size_t go = ((size_t)chunk * 16 + 8 * hf + lrow) * P.ld + 64 * h + 8 * lpc; const int lo = (8 * hf + lrow) * RPP + lpc * 16;
            *(GQ u32x4*)(P.KT + go) = *(const LDSQ u32x4*)(scr + 0 * RPT + lo); *(GQ u32x4*)(P.BT + go) = *(const LDSQ u32x4*)(scr + 1 * RPT + lo);
            *(GQ u32x4*)(P.KK + go) = *(const LDSQ u32x4*)(scr + 2 * RPT + lo); *(GQ u32x4*)(P.RT + go) = *(const LDSQ u32x4*)(scr + 3 * RPT + lo);
        }
        MEMFENCE(); WAVE_SYNC();
        if (u + stride < nunits) RP_PARK();
    }
#undef RP_LOAD
#undef RP_PARK
}

DI void rwkv_post_loop(const GQ bf16_t* __restrict__ YRAW, const GQ bf16_t* __restrict__ V, const GQ bf16_t* __restrict__ LORA, const GQ bf16_t* __restrict__ G2T, const GQ float* __restrict__ BONUS,
                       const GQ float* __restrict__ ln_g, const GQ float* __restrict__ ln_b, GQ bf16_t* __restrict__ YG, int ld, int first, int stride, int nunits, LDSQ unsigned char* scr) {
    if (first >= nunits) return;
    const int lane = lane_id(), fr = lane & 15, fq = lane >> 4, h = first & 15;
    const int lrow = lane >> 3, lpc = lane & 7, qrow = lane >> 4, qpc = lane & 15;
    bf16x8 gA[2][4];
#pragma unroll
    for (int ti = 0; ti < 2; ++ti)
#pragma unroll
        for (int s = 0; s < 4; ++s) gA[ti][s] = __builtin_bit_cast(bf16x8, ld16(G2T + (size_t)(64 * h + 16 * ti + fr) * 128 + 32 * s + 8 * fq));
    u32x4 ty_[2], tv_[2], tl_[4]; float bonn = 0.f;
#define PO_LOAD(u_) do { const size_t r0_ = (size_t)((u_) >> 4) * 16; \
    _Pragma("unroll") for (int hf = 0; hf < 2; ++hf) { ty_[hf] = ld16(YRAW + (r0_ + 8 * hf + lrow) * ld + 64 * h + 8 * lpc); tv_[hf] = ld16(V + (r0_ + 8 * hf + lrow) * ld + 64 * h + 8 * lpc); } \
    _Pragma("unroll") for (int g = 0; g < 4; ++g) tl_[g] = ld16(LORA + (r0_ + 4 * g + qrow) * 256 + 128 + 8 * qpc); \
    bonn = BONUS[(r0_ + fr) * 16 + h]; } while (0)
#define PO_PARK() do { MEMFENCE(); \
    _Pragma("unroll") for (int hf = 0; hf < 2; ++hf) { *(LDSQ u32x4*)(scr + RP_R + (8 * hf + lrow) * RPP + lpc * 16) = ty_[hf]; *(LDSQ u32x4*)(scr + RP_K + (8 * hf + lrow) * RPP + lpc * 16) = tv_[hf]; } \
    _Pragma("unroll") for (int g = 0; g < 4; ++g) *(LDSQ u32x4*)(scr + RP_L + (4 * g + qrow) * RPL + qpc * 16) = tl_[g]; MEMFENCE(); WAVE_SYNC(); } while (0)
    PO_LOAD(first); PO_PARK();
    for (int u = first; u < nunits; u += stride) {
        const int chunk = u >> 4;
        const float bon = bonn;
        if (u + stride < nunits) PO_LOAD(u + stride);
        bf16x8 bg[4];
#pragma unroll
        for (int s = 0; s < 4; ++s) bg[s] = __builtin_bit_cast(bf16x8, *(const LDSQ u32x4*)(scr + RP_L + fr * RPL + (32 * s + 8 * fq) * 2));
        u32x2 y2a[4], v2a[4];
#pragma unroll
        for (int ti = 0; ti < 4; ++ti) { y2a[ti] = ldl8(scr + RP_R + fr * RPP + (16 * ti + 4 * fq) * 2); v2a[ti] = ldl8(scr + RP_K + fr * RPP + (16 * ti + 4 * fq) * 2); }
        MEMFENCE(); WAVE_SYNC();
        float yv[16], gt[16]; float sm = 0.f;
#pragma unroll
        for (int ti = 0; ti < 4; ++ti) {
            f32x4 g = {0.f, 0.f, 0.f, 0.f};
#pragma unroll
            for (int s = 0; s < 4; ++s) g = mfma16(ti < 2 ? gA[ti & 1][s] : __builtin_bit_cast(bf16x8, ld16(G2T + (size_t)(64 * h + 16 * ti + fr) * 128 + 32 * s + 8 * fq)), bg[s], g);
            const u32x2 y2 = y2a[ti];
            yv[4 * ti] = bf2f((unsigned short)(y2.x & 0xffffu)); yv[4 * ti + 1] = bf2f((unsigned short)(y2.x >> 16)); yv[4 * ti + 2] = bf2f((unsigned short)(y2.y & 0xffffu)); yv[4 * ti + 3] = bf2f((unsigned short)(y2.y >> 16));
#pragma unroll
            for (int i = 0; i < 4; ++i) { gt[4 * ti + i] = g[i]; sm += yv[4 * ti + i]; }
        }
        sm += __shfl_xor(sm, 16); sm += __shfl_xor(sm, 32);
        const float mean = sm * (1.0f / 64.0f); float vs = 0.f;
#pragma unroll
        for (int e2 = 0; e2 < 16; ++e2) { const float d = yv[e2] - mean; vs += d * d; }
        vs += __shfl_xor(vs, 16); vs += __shfl_xor(vs, 32);
        const float rstd = __builtin_amdgcn_rsqf(vs * (1.0f / 64.0f) + 64e-5f);
#pragma unroll
        for (int ti = 0; ti < 4; ++ti) {
            const int ch0 = 64 * h + 16 * ti + 4 * fq;
            const f32x4 lg = *(const GQ f32x4*)(ln_g + ch0), lb = *(const GQ f32x4*)(ln_b + ch0);
            const u32x2 v2 = v2a[ti];
            const float vv[4] = {bf2f((unsigned short)(v2.x & 0xffffu)), bf2f((unsigned short)(v2.x >> 16)), bf2f((unsigned short)(v2.y & 0xffffu)), bf2f((unsigned short)(v2.y >> 16))};
            f32x4 o;
#pragma unroll
            for (int i = 0; i < 4; ++i) o[i] = ((yv[4 * ti + i] - mean) * rstd * lg[i] + lb[i] + bon * vv[i]) * gt[4 * ti + i];
            *(LDSQ u32x2*)(scr + fr * RPP + (16 * ti + 4 * fq) * 2) = pack4(o);
        }
        MEMFENCE(); WAVE_SYNC();
#pragma unroll
        for (int hf = 0; hf < 2; ++hf) *(GQ u32x4*)(YG + ((size_t)chunk * 16 + 8 * hf + lrow) * ld + 64 * h + 8 * lpc) = *(const LDSQ u32x4*)(scr + (8 * hf + lrow) * RPP + lpc * 16);
        MEMFENCE(); WAVE_SYNC();
        if (u + stride < nunits) PO_PARK();
    }
#undef PO_LOAD
#undef PO_PARK
}

DI bf16x8 pk_lo(f32x4 v) { const u32x2 z2 = {0u, 0u}; return mk8(pack4(v), z2); }
DI f32x4 mm16(f32x4 accPT, f32x4 accQ) { return mfma16(pk_lo(accPT), pk_lo(accQ), (f32x4){0.f, 0.f, 0.f, 0.f}); }
DI void rwkv_scan_stream(const GQ bf16_t* __restrict__ KT, const GQ bf16_t* __restrict__ BT, const GQ bf16_t* __restrict__ KK, const GQ bf16_t* __restrict__ RT, const GQ bf16_t* __restrict__ V, int ld,
                         const GQ float* __restrict__ GL, int S, GQ bf16_t* __restrict__ Y, int ldy, LDSQ unsigned char* lds) {
    const int lane = lane_id(), fr = lane & 15, fq = lane >> 4;
    LDSQ unsigned char* BTimg = lds;
    LDSQ unsigned char* KKimg = lds + 2048;
    LDSQ unsigned char* Vimg = lds + 4096;
    f32x4 H[4];
#pragma unroll
    for (int ci = 0; ci < 4; ++ci) H[ci] = (f32x4){0.f, 0.f, 0.f, 0.f};
    const int NC = S / 16;
    u32x2 ktn[4], btn[4], kkn[4], rtn[4]; u32x4 vn = {0u, 0u, 0u, 0u}; f32x4 gln[4];
#define RW_LOAD(c_) do { const size_t row = (size_t)(16 * (c_) + fr); \
    _Pragma("unroll") for (int s = 0; s < 2; ++s) _Pragma("unroll") for (int q = 0; q < 2; ++q) { const size_t o = row * ld + 32 * s + 16 * q + 4 * fq; \
        ktn[2 * s + q] = ld8(KT + o); btn[2 * s + q] = ld8(BT + o); kkn[2 * s + q] = ld8(KK + o); rtn[2 * s + q] = ld8(RT + o); } \
    if (lane < 32) vn = ld16(V + (size_t)(16 * (c_) + (lane >> 1)) * ld + 8 * (lane & 1)); \
    _Pragma("unroll") for (int ci = 0; ci < 4; ++ci) gln[ci] = *(const GQ f32x4*)(GL + (size_t)(c_) * 1024 + 16 * ci + 4 * fq); } while (0)
    RW_LOAD(0);
    const bool dg[4] = {4 * fq + 0 == fr, 4 * fq + 1 == fr, 4 * fq + 2 == fr, 4 * fq + 3 == fr};
    for (int c = 0; c < NC; ++c) {
        u32x2 kt[4], bt[4], kk[4], rt[4]; const u32x4 vcur = vn; f32x4 gl[4];
#pragma unroll
        for (int i = 0; i < 4; ++i) { kt[i] = ktn[i]; bt[i] = btn[i]; kk[i] = kkn[i]; rt[i] = rtn[i]; gl[i] = gln[i]; }
        if (c + 1 < NC) RW_LOAD(c + 1);
        MEMFENCE();
#pragma unroll
        for (int s = 0; s < 2; ++s)
#pragma unroll
            for (int q = 0; q < 2; ++q) { const int off = fr * 128 + (32 * s + 16 * q + 4 * fq) * 2; *(LDSQ u32x2*)(BTimg + off) = bt[2 * s + q]; *(LDSQ u32x2*)(KKimg + off) = kk[2 * s + q]; }
        if (lane < 32) *(LDSQ u32x4*)(Vimg + (lane >> 1) * 32 + (lane & 1) * 16) = vcur;
        MEMFENCE();
        const f32x4 z4 = {0.f, 0.f, 0.f, 0.f};
        f32x4 x1 = z4, x2 = z4, akt = z4, arbt = z4, arkt = z4;
#pragma unroll
        for (int s = 0; s < 2; ++s) {
            const bf16x8 fkt = mk8(kt[2 * s], kt[2 * s + 1]), fbt = mk8(bt[2 * s], bt[2 * s + 1]), fkk = mk8(kk[2 * s], kk[2 * s + 1]), frt = mk8(rt[2 * s], rt[2 * s + 1]);
            x1 = mfma16(fbt, fkt, x1);
            x2 = mfma16(fkt, fbt, x2);
            akt = mfma16(fkk, fkt, akt);
            arbt = mfma16(fbt, frt, arbt);
            arkt = mfma16(fkk, frt, arkt);
        }
        f32x4 yT, y_;
#pragma unroll
        for (int i = 0; i < 4; ++i) {
            const int rr = 4 * fq + i;
            yT[i] = (rr < fr) ? -x1[i] : 0.f;
            y_[i] = (fr < rr) ? -x2[i] : 0.f;
            akt[i] = (rr < fr) ? akt[i] : 0.f;
            arbt[i] = (rr <= fr) ? arbt[i] : 0.f;
            arkt[i] = (rr <= fr) ? arkt[i] : 0.f;
        }
#define IA(x) ((f32x4){(x)[0] + (dg[0] ? 1.f : 0.f), (x)[1] + (dg[1] ? 1.f : 0.f), (x)[2] + (dg[2] ? 1.f : 0.f), (x)[3] + (dg[3] ? 1.f : 0.f)})
        const f32x4 y2 = mm16(yT, y_), y2T = mm16(y_, yT);
        const f32x4 y4 = mm16(y2T, y2), y4T = mm16(y2, y2T);
        const f32x4 y8T = mm16(y4, y4T);
        const f32x4 w1 = mm16(IA(y_), IA(y2T)), w1T = mm16(IA(yT), IA(y2));
        const f32x4 w2 = mm16(w1T, IA(y4T)), w2T = mm16(w1, IA(y4));
        const f32x4 tT = mm16(w2T, IA(y8T));
#undef IA
        const bf16x8 hb0 = mk8(pack4(H[0]), pack4(H[1])), hb1 = mk8(pack4(H[2]), pack4(H[3]));
        const s16x4 v4 = TR16(Vimg + (4 * fq + (fr >> 2)) * 32 + 8 * (fr & 3));
        const u32x2 z2 = {0u, 0u};
        f32x4 g = mfma16(mk8(kt[0], kt[1]), hb0, z4);
        g = mfma16(mk8(kt[2], kt[3]), hb1, g);
        g = mfma16(pk_lo(akt), mk8(tr2(v4), z2), g);
        const f32x4 tg = mfma16(pk_lo(tT), pk_lo(g), z4);
        const f32x4 u = -tg;
        f32x4 yo = mfma16(mk8(rt[0], rt[1]), hb0, z4);
        yo = mfma16(mk8(rt[2], rt[3]), hb1, yo);
        const bf16x8 uv = mk8(pack4(u), tr2(v4));
        yo = mfma16(mk8(pack4(arbt), pack4(arkt)), uv, yo);
#pragma unroll
        for (int i = 0; i < 4; ++i) Y[(size_t)(16 * c + 4 * fq + i) * ldy + fr] = f2bf(yo[i]);
#pragma unroll
        for (int ci = 0; ci < 4; ++ci) {
            const int off = (4 * fq + (fr >> 2)) * 128 + (16 * ci + 4 * (fr & 3)) * 2;
            const s16x4 b4 = TR16(BTimg + off), k4 = TR16(KKimg + off);
            H[ci] = mfma16(mk8(tr2(b4), tr2(k4)), uv, H[ci]) * gl[ci];
        }
        MEMFENCE();
    }
#undef RW_LOAD
}

#ifdef HOST_EMU
DI unsigned flag_ld(const LDSQ unsigned* p) { return __atomic_load_n(p, __ATOMIC_ACQUIRE); }
DI void flag_st(LDSQ unsigned* p, unsigned v) { emu_sync(); __atomic_store_n(p, v, __ATOMIC_RELEASE); }
DI void spin_pause() { std::this_thread::yield(); }
#else
DI unsigned flag_ld(const LDSQ unsigned* p) { unsigned v; asm volatile("ds_read_b32 %0, %1\n\ts_waitcnt lgkmcnt(0)" : "=v"(v) : "v"((unsigned)(size_t)p) : "memory"); return v; }
DI void flag_st(LDSQ unsigned* p, unsigned v) { asm volatile("ds_write_b32 %0, %1" :: "v"((unsigned)(size_t)p), "v"(v) : "memory"); }
DI void spin_pause() { asm volatile("s_nop 7"); }
#endif
#define COOP_SPIN_CAP (1u << 24)
#if defined(COOP_PROBE) && !defined(HOST_EMU)
DI void wait_ge_t(const LDSQ unsigned* p, unsigned want, LDSQ unsigned* acc) { const unsigned long long t0 = __builtin_amdgcn_s_memrealtime(); unsigned n = 0; while (flag_ld(p) < want) { spin_pause(); if (++n > COOP_SPIN_CAP) break; } MEMFENCE();
    const unsigned dt = (unsigned)(__builtin_amdgcn_s_memrealtime() - t0); if (lane_id() == 0) *acc += dt; }
#else
#define wait_ge_t(p, want, acc) wait_ge(p, want)
#endif
DI void wait_ge(const LDSQ unsigned* p, unsigned want) { unsigned n = 0; while (flag_ld(p) < want) { spin_pause(); if (++n > COOP_SPIN_CAP) break; } MEMFENCE(); }

#if defined(SEG_PROBE) && !defined(HOST_EMU)
#define SEG_STAMP(i) do { if (wave == 0) { const unsigned now_ = (unsigned)__builtin_amdgcn_s_memrealtime(); if (lane == 0) ready[40 + (i)] += now_ - seg_last_; seg_last_ = now_; } } while (0)
#else
#define SEG_STAMP(i) do {} while (0)
#endif
constexpr int RWP = 144, RWTS = 16 * RWP;
constexpr int RWT_KT = 0, RWT_BT = RWTS, RWT_KK = 2 * RWTS, RWT_RT = 3 * RWTS, RWT_V = 4 * RWTS, RWT_GL = 5 * RWTS, RWT_TT = RWT_GL + 256, RWT_AK = RWT_TT + 512, RWT_ARB = RWT_AK + 512, RWT_Y = RWT_ARB + 1024;
constexpr int RWS_SLOT = RWT_Y + RWTS, RWS_NSLOT = 8, RWS_FLAGS = RWS_SLOT * RWS_NSLOT, RWS_LDS = RWS_FLAGS + 256;
DI void rwkv_scan_coop(int wave, const GQ bf16_t* __restrict__ KT, const GQ bf16_t* __restrict__ BT, const GQ bf16_t* __restrict__ KK, const GQ bf16_t* __restrict__ RT, const GQ bf16_t* __restrict__ V, int ld,
                       const GQ float* __restrict__ GL, int S, GQ bf16_t* __restrict__ Y, int ldy, LDSQ unsigned char* lds) {
    const int lane = lane_id(), fr = lane & 15, fq = lane >> 4;
    const int NC = S / 16;
    LDSQ unsigned* ready = (LDSQ unsigned*)(lds + RWS_FLAGS);
    LDSQ unsigned* done = ready + 16;
    const u32x2 z2 = {0u, 0u};
    const f32x4 z4 = {0.f, 0.f, 0.f, 0.f};
    if (wave < 4) {
#ifndef HOST_EMU
        __builtin_amdgcn_s_setprio(3);
#endif
        f32x4 H[4];
#pragma unroll
        for (int ci = 0; ci < 4; ++ci) H[ci] = z4;
        for (int c = 0; c < NC; ++c) {
            LDSQ unsigned char* slot = lds + (c & (RWS_NSLOT - 1)) * RWS_SLOT;
            wait_ge_t(ready + (c & (RWS_NSLOT - 1)), (unsigned)c + 1u, ready + 32 + wave);
            u32x2 kt[4], rt[4];
#pragma unroll
            for (int s = 0; s < 2; ++s)
#pragma unroll
                for (int q = 0; q < 2; ++q) { const int o = fr * RWP + (32 * s + 16 * q + 4 * fq) * 2; kt[2 * s + q] = ldl8(slot + RWT_KT + o); rt[2 * s + q] = ldl8(slot + RWT_RT + o); }
            const u32x2 tT = ldl8(slot + RWT_TT + lane * 8), ak = ldl8(slot + RWT_AK + lane * 8);
            const u32x4 arbk = *(const LDSQ u32x4*)(slot + RWT_ARB + lane * 16);
            f32x4 gl[4];
#pragma unroll
            for (int ci = 0; ci < 4; ++ci) gl[ci] = *(const LDSQ f32x4*)(slot + RWT_GL + (16 * ci + 4 * fq) * 4);
            const s16x4 v4 = TR16(slot + RWT_V + (4 * fq + (fr >> 2)) * RWP + (16 * wave + 4 * (fr & 3)) * 2);
            s16x4 b4[4], k4[4];
#pragma unroll
            for (int ci = 0; ci < 4; ++ci) { const int off = (4 * fq + (fr >> 2)) * RWP + (16 * ci + 4 * (fr & 3)) * 2; b4[ci] = TR16(slot + RWT_BT + off); k4[ci] = TR16(slot + RWT_KK + off); }
            const bf16x8 hb0 = mk8(pack4(H[0]), pack4(H[1])), hb1 = mk8(pack4(H[2]), pack4(H[3]));
            f32x4 g = mfma16(mk8(kt[0], kt[1]), hb0, z4);
            g = mfma16(mk8(kt[2], kt[3]), hb1, g);
            g = mfma16(mk8(ak, z2), mk8(tr2(v4), z2), g);
            const f32x4 tg = mfma16(mk8(tT, z2), pk_lo(g), z4);
            const f32x4 u = -tg;
            f32x4 yo = mfma16(mk8(rt[0], rt[1]), hb0, z4);
            yo = mfma16(mk8(rt[2], rt[3]), hb1, yo);
            const bf16x8 uv = mk8(pack4(u), tr2(v4));
            yo = mfma16(__builtin_bit_cast(bf16x8, arbk), uv, yo);
#pragma unroll
            for (int i = 0; i < 4; ++i) *(LDSQ unsigned short*)(slot + RWT_Y + (4 * fq + i) * RWP + (16 * wave + fr) * 2) = f2bf(yo[i]);
#pragma unroll
            for (int ci = 0; ci < 4; ++ci) H[ci] = mfma16(mk8(tr2(b4[ci]), tr2(k4[ci])), uv, H[ci]) * gl[ci];
            flag_st(done + wave, (unsigned)c + 1u);
        }
    } else {
#ifndef HOST_EMU
        __builtin_amdgcn_s_setprio(0);
#endif
        const int p = wave - 4;
        const int lrow = lane >> 3, lpc = lane & 7;
        u32x4 tn[5][2]; float gln = 0.f;
#define RWP_LOAD(c_) do { _Pragma("unroll") for (int hf = 0; hf < 2; ++hf) { const size_t o = (size_t)(16 * (c_) + 8 * hf + lrow) * ld + 8 * lpc; \
        tn[0][hf] = ld16(KT + o); tn[1][hf] = ld16(BT + o); tn[2][hf] = ld16(KK + o); tn[3][hf] = ld16(RT + o); tn[4][hf] = ld16(V + o); } \
    gln = GL[(size_t)(c_) * 1024 + lane]; } while (0)
#define RWP_FLUSH(cc_) do { const u32x4 y0 = *(const LDSQ u32x4*)(slot + RWT_Y + lrow * RWP + lpc * 16), y1 = *(const LDSQ u32x4*)(slot + RWT_Y + (8 + lrow) * RWP + lpc * 16); \
    *(GQ u32x4*)(Y + (size_t)(16 * (cc_) + lrow) * ldy + 8 * lpc) = y0; *(GQ u32x4*)(Y + (size_t)(16 * (cc_) + 8 + lrow) * ldy + 8 * lpc) = y1; MEMFENCE(); } while (0)
        const bool dg[4] = {4 * fq + 0 == fr, 4 * fq + 1 == fr, 4 * fq + 2 == fr, 4 * fq + 3 == fr};
#define RWP_PARK(cc_) do { LDSQ unsigned char* ps_ = lds + ((cc_) & (RWS_NSLOT - 1)) * RWS_SLOT; \
        if ((cc_) >= RWS_NSLOT) { const unsigned want_ = (unsigned)((cc_) - RWS_NSLOT + 1); wait_ge(done + 0, want_); wait_ge(done + 1, want_); wait_ge(done + 2, want_); wait_ge(done + 3, want_); \
            { LDSQ unsigned char* slot = ps_; RWP_FLUSH((cc_) - RWS_NSLOT); } } \
        MEMFENCE(); \
        _Pragma("unroll") for (int a = 0; a < 5; ++a) _Pragma("unroll") for (int hf = 0; hf < 2; ++hf) *(LDSQ u32x4*)(ps_ + a * RWTS + (8 * hf + lrow) * RWP + lpc * 16) = tn[a][hf]; \
        *(LDSQ float*)(ps_ + RWT_GL + lane * 4) = gln; MEMFENCE(); WAVE_SYNC(); } while (0)
        if (p < NC) { RWP_LOAD(p); RWP_PARK(p); }
        for (int c = p; c < NC; c += 4) {
            if (c + 4 < NC) RWP_LOAD(c + 4);
            LDSQ unsigned char* slot = lds + (c & (RWS_NSLOT - 1)) * RWS_SLOT;
            u32x2 kt[4], bt[4], kk[4], rt[4];
#pragma unroll
            for (int s = 0; s < 2; ++s)
#pragma unroll
                for (int q = 0; q < 2; ++q) { const int o = fr * RWP + (32 * s + 16 * q + 4 * fq) * 2;
                    kt[2 * s + q] = ldl8(slot + RWT_KT + o); bt[2 * s + q] = ldl8(slot + RWT_BT + o); kk[2 * s + q] = ldl8(slot + RWT_KK + o); rt[2 * s + q] = ldl8(slot + RWT_RT + o); }
            f32x4 x1 = z4, x2 = z4, akt = z4, arbt = z4, arkt = z4;
#pragma unroll
            for (int s = 0; s < 2; ++s) {
                const bf16x8 fkt = mk8(kt[2 * s], kt[2 * s + 1]), fbt = mk8(bt[2 * s], bt[2 * s + 1]), fkk = mk8(kk[2 * s], kk[2 * s + 1]), frt = mk8(rt[2 * s], rt[2 * s + 1]);
                x1 = mfma16(fbt, fkt, x1); x2 = mfma16(fkt, fbt, x2); akt = mfma16(fkk, fkt, akt); arbt = mfma16(fbt, frt, arbt); arkt = mfma16(fkk, frt, arkt);
            }
            f32x4 yT, y_;
#pragma unroll
            for (int i = 0; i < 4; ++i) {
                const int rr = 4 * fq + i;
                yT[i] = (rr < fr) ? -x1[i] : 0.f; y_[i] = (fr < rr) ? -x2[i] : 0.f;
                akt[i] = (rr < fr) ? akt[i] : 0.f; arbt[i] = (rr <= fr) ? arbt[i] : 0.f; arkt[i] = (rr <= fr) ? arkt[i] : 0.f;
            }
#define IA(x) ((f32x4){(x)[0] + (dg[0] ? 1.f : 0.f), (x)[1] + (dg[1] ? 1.f : 0.f), (x)[2] + (dg[2] ? 1.f : 0.f), (x)[3] + (dg[3] ? 1.f : 0.f)})
            const f32x4 y2 = mm16(yT, y_), y2T = mm16(y_, yT);
            const f32x4 y4 = mm16(y2T, y2), y4T = mm16(y2, y2T);
            const f32x4 y8T = mm16(y4, y4T);
            const f32x4 w1 = mm16(IA(y_), IA(y2T)), w1T = mm16(IA(yT), IA(y2));
            const f32x4 w2 = mm16(w1T, IA(y4T)), w2T = mm16(w1, IA(y4));
            const f32x4 tT = mm16(w2T, IA(y8T));
#undef IA
            *(LDSQ u32x2*)(slot + RWT_TT + lane * 8) = pack4(tT);
            *(LDSQ u32x2*)(slot + RWT_AK + lane * 8) = pack4(akt);
            { const u32x2 a = pack4(arbt), b = pack4(arkt); *(LDSQ u32x4*)(slot + RWT_ARB + lane * 16) = (u32x4){a.x, a.y, b.x, b.y}; }
            flag_st(ready + (c & (RWS_NSLOT - 1)), (unsigned)c + 1u);
            if (c + 4 < NC) RWP_PARK(c + 4);
        }
#undef RWP_PARK
        for (int c = NC - RWS_NSLOT; c < NC; ++c) if (c >= 0 && (c & 3) == p) {
            LDSQ unsigned char* slot = lds + (c & (RWS_NSLOT - 1)) * RWS_SLOT; const unsigned want = (unsigned)c + 1u;
            wait_ge(done + 0, want); wait_ge(done + 1, want); wait_ge(done + 2, want); wait_ge(done + 3, want);
            RWP_FLUSH(c);
        }
#undef RWP_FLUSH
#undef RWP_LOAD
    }
}

DI void mlstm_gate_scan(const GQ float* __restrict__ G, int gi, int gf, int S, GQ float* __restrict__ SC_A, GQ float* __restrict__ SC_M, GQ float* __restrict__ SC_E) {
    const int lane = lane_id(), TPL = S / 64, t0 = lane * TPL;
    float tot = 0.f;
    for (int i = 0; i < TPL; ++i) tot += G[(size_t)(t0 + i) * 8 + gf];
    float inc = tot;
#pragma unroll
    for (int d = 1; d < 64; d <<= 1) { const float t = __shfl_up(inc, d, 64); if (lane >= d) inc += t; }
    const float Fbase = inc - tot;
    float run = Fbase, lmax = -3.0e38f;
    for (int i = 0; i < TPL; ++i) { run += G[(size_t)(t0 + i) * 8 + gf]; const float a = G[(size_t)(t0 + i) * 8 + gi] - run; SC_A[t0 + i] = a; lmax = fmaxf(lmax, a); }
    float mi = lmax;
#pragma unroll
    for (int d = 1; d < 64; d <<= 1) { const float t = __shfl_up(mi, d, 64); if (lane >= d) mi = fmaxf(mi, t); }
    float mprev = __shfl_up(mi, 1, 64); if (lane == 0) mprev = 0.f;
    float M = fmaxf(mprev, 0.f); run = Fbase;
    for (int i = 0; i < TPL; ++i) { run += G[(size_t)(t0 + i) * 8 + gf]; const float a = G[(size_t)(t0 + i) * 8 + gi] - run; M = fmaxf(M, a); SC_M[t0 + i] = M; SC_E[t0 + i] = fexp(-(run + M)); }
}


#ifdef HOST_EMU
#define WG_SYNC() emu_syncthreads()
#else
#define WG_SYNC() __syncthreads()
#endif
DI void mlstm_gate_scan_wg(int wave, const GQ float* __restrict__ G, int gi, int gf, int S, GQ float* __restrict__ SC_A, GQ float* __restrict__ SC_M, GQ float* __restrict__ SC_E, LDSQ float* red) {
    const int lane = lane_id(), TPW = S / 8, NG = TPW / 64, t0 = wave * TPW;
    float F[8], A[8];
    float run = 0.f;
    for (int g = 0; g < NG; ++g) {
        const size_t t = (size_t)(t0 + 64 * g + lane);
        float inc = G[t * 8 + gf]; A[g] = G[t * 8 + gi];
#pragma unroll
        for (int d = 1; d < 64; d <<= 1) { const float x = __shfl_up(inc, d, 64); if (lane >= d) inc += x; }
        F[g] = run + inc; run += __shfl(inc, 63, 64);
    }
    if (lane == 0) red[wave] = run;
    MEMFENCE(); WG_SYNC();
    float base = 0.f;
    for (int w = 0; w < wave; ++w) base += red[w];
    float mrun = -3.0e38f;
    for (int g = 0; g < NG; ++g) {
        F[g] += base; const float a = A[g] - F[g]; A[g] = a;
        SC_A[t0 + 64 * g + lane] = a;
        float mx = a;
#pragma unroll
        for (int d = 1; d < 64; d <<= 1) { const float x = __shfl_up(mx, d, 64); if (lane >= d) mx = fmaxf(mx, x); }
        const float gm = __shfl(mx, 63, 64);
        mx = fmaxf(mx, mrun); mrun = fmaxf(mrun, gm);
        A[g] = mx;
    }
    if (lane == 0) red[8 + wave] = mrun;
    MEMFENCE(); WG_SYNC();
    float mb = 0.f;
    for (int w = 0; w < wave; ++w) mb = fmaxf(mb, red[8 + w]);
    for (int g = 0; g < NG; ++g) { const float M = fmaxf(A[g], mb); SC_M[t0 + 64 * g + lane] = M; SC_E[t0 + 64 * g + lane] = fexp(-(F[g] + M)); }
}
constexpr int MLKP = 288;
constexpr int MLS_SLOT = 9472, MLS_NSLOT = 6, MLS_FLAGS = MLS_SLOT * MLS_NSLOT, MLS_VIMG = MLS_FLAGS + 256, MLS_LDS = MLS_VIMG + 4 * 1024;
DI void mlstm_coop(int wave, const GQ bf16_t* __restrict__ Qp, const GQ bf16_t* __restrict__ Kp, int ldqk, const GQ bf16_t* __restrict__ Vp, int ldv, const GQ float* __restrict__ SC_A, const GQ float* __restrict__ SC_M,
                   int S, GQ bf16_t* __restrict__ NUM, int ldn, GQ float* __restrict__ DEN, int ldd, LDSQ unsigned char* lds) {
    const int lane = lane_id(), fr = lane & 15, fq = lane >> 4;
    const int NC = S / 16;
    LDSQ unsigned* ready = (LDSQ unsigned*)(lds + MLS_FLAGS);
    LDSQ unsigned* done = ready + 16;
    const u32x2 z2 = {0u, 0u};
    const f32x4 z4 = {0.f, 0.f, 0.f, 0.f};
    if (wave < 5) {
        const bool isden = (wave == 4);
        LDSQ unsigned char* Vimg = lds + MLS_VIMG + (wave & 3) * 1024;
        f32x4 C[8][2];
#pragma unroll
        for (int ci = 0; ci < 8; ++ci) { C[ci][0] = z4; C[ci][1] = z4; }
        u32x4 vn = {0u, 0u, 0u, 0u};
#define MLC_LOAD(c_) do { if (!isden) vn = ld16(Vp + (size_t)(16 * (c_) + (lane >> 2)) * ldv + 32 * wave + 8 * (lane & 3)); } while (0)
        MLC_LOAD(0);
        for (int c = 0; c < NC; ++c) {
            const u32x4 vcur = vn;
            if (c + 1 < NC) MLC_LOAD(c + 1);
            MEMFENCE();
            if (!isden) *(LDSQ u32x4*)(Vimg + (lane >> 2) * 64 + (lane & 3) * 16) = vcur;
            MEMFENCE();
            const int sl = c % MLS_NSLOT;
            LDSQ unsigned char* slot = lds + sl * MLS_SLOT;
            wait_ge_t(ready + sl, (unsigned)c + 1u, ready + 32 + wave);
            const u32x2 pf = *(const LDSQ u32x2*)(slot + 4608 + lane * 8);
            u32x2 qc[8];
#pragma unroll
            for (int i = 0; i < 8; ++i) qc[i] = *(const LDSQ u32x2*)(slot + 5376 + i * 512 + lane * 8);
            const f32x4 wi = *(const LDSQ f32x4*)(slot + 5120 + fq * 16), wt = *(const LDSQ f32x4*)(slot + 5184 + fq * 16), rs4 = *(const LDSQ f32x4*)(slot + 5248 + fq * 16);
            const float wst = *(const LDSQ float*)(slot + 5312);
            s16x4 k4[8];
#pragma unroll
            for (int ci = 0; ci < 8; ++ci) k4[ci] = TR16(slot + (4 * fq + (fr >> 2)) * MLKP + (16 * ci + 4 * (fr & 3)) * 2);
            if (!isden) {
                bf16x8 vwb[2];
#pragma unroll
                for (int j = 0; j < 2; ++j) {
                    const s16x4 v4 = TR16(Vimg + (4 * fq + (fr >> 2)) * 64 + 32 * j + 8 * (fr & 3));
                    const f32x4 numI = mfma16(mk8(pf, z2), mk8(tr2(v4), z2), z4);
                    f32x4 inter = z4;
#pragma unroll
                    for (int ks = 0; ks < 4; ++ks) inter = mfma16(mk8(qc[2 * ks], qc[2 * ks + 1]), mk8(pack4(C[2 * ks][j]), pack4(C[2 * ks + 1][j])), inter);
#pragma unroll
                    for (int i = 0; i < 4; ++i) NUM[(size_t)(16 * c + 4 * fq + i) * ldn + 32 * wave + 16 * j + fr] = f2bf(numI[i] + wi[i] * inter[i]);
                    f32x4 vw;
#pragma unroll
                    for (int i = 0; i < 4; ++i) vw[i] = bf2f((unsigned short)v4[i]) * wt[i];
                    vwb[j] = mk8(pack4(vw), z2);
                }
#pragma unroll
                for (int ci = 0; ci < 8; ++ci) { const bf16x8 ka = mk8(tr2(k4[ci]), z2); C[ci][0] = mfma16(ka, vwb[0], C[ci][0] * wst); C[ci][1] = mfma16(ka, vwb[1], C[ci][1] * wst); }
            } else {
                f32x4 inter = z4;
#pragma unroll
                for (int ks = 0; ks < 4; ++ks) inter = mfma16(mk8(qc[2 * ks], qc[2 * ks + 1]), mk8(pack4(C[2 * ks][0]), pack4(C[2 * ks + 1][0])), inter);
                if (fr == 0) {
#pragma unroll
                    for (int i = 0; i < 4; ++i) DEN[(size_t)(16 * c + 4 * fq + i) * ldd] = rs4[i] + wi[i] * inter[i];
                }
                f32x4 vw;
#pragma unroll
                for (int i = 0; i < 4; ++i) vw[i] = (fr == 0) ? wt[i] : 0.f;
                const bf16x8 vwb = mk8(pack4(vw), z2);
#pragma unroll
                for (int ci = 0; ci < 8; ++ci) C[ci][0] = mfma16(mk8(tr2(k4[ci]), z2), vwb, C[ci][0] * wst);
            }
            flag_st(done + wave, (unsigned)c + 1u);
        }
#undef MLC_LOAD
    } else {
        const int p = wave - 5;
        u32x2 qn[8], kn[8]; float an = 0.f, mn = 0.f, mcn = 0.f;
#define MLP_LOAD(c_) do { const size_t row = (size_t)(16 * (c_) + fr); \
    _Pragma("unroll") for (int ks = 0; ks < 4; ++ks) { qn[2 * ks] = ld8(Qp + row * ldqk + 32 * ks + 4 * fq); qn[2 * ks + 1] = ld8(Qp + row * ldqk + 32 * ks + 16 + 4 * fq); \
        kn[2 * ks] = ld8(Kp + row * ldqk + 32 * ks + 4 * fq); kn[2 * ks + 1] = ld8(Kp + row * ldqk + 32 * ks + 16 + 4 * fq); } \
    an = SC_A[row]; mn = SC_M[row]; mcn = ((c_) > 0) ? SC_M[16 * (c_) - 1] : 0.f; } while (0)
        if (p < NC) MLP_LOAD(p);
        for (int c = p; c < NC; c += 3) {
            u32x2 qc[8], kc[8]; const float a = an, Mx = mn, Mcarry = mcn;
#pragma unroll
            for (int i = 0; i < 8; ++i) { qc[i] = qn[i]; kc[i] = kn[i]; }
            if (c + 3 < NC) MLP_LOAD(c + 3);
            const float Mend = __shfl(Mx, 15, 16);
            float as_[4];
#pragma unroll
            for (int i = 0; i < 4; ++i) as_[i] = __shfl(a, 4 * fq + i, 16);
            f32x4 st = z4;
#pragma unroll
            for (int ks = 0; ks < 4; ++ks) st = mfma16(mk8(kc[2 * ks], kc[2 * ks + 1]), mk8(qc[2 * ks], qc[2 * ks + 1]), st);
            f32x4 pt;
#pragma unroll
            for (int i = 0; i < 4; ++i) pt[i] = (4 * fq + i <= fr) ? st[i] * fexp(as_[i] - Mx) : 0.f;
            float rs = (pt[0] + pt[1]) + (pt[2] + pt[3]);
            rs += __shfl_xor(rs, 16); rs += __shfl_xor(rs, 32);
            const int sl = c % MLS_NSLOT;
            if (c >= MLS_NSLOT) { const unsigned want = (unsigned)(c - MLS_NSLOT + 1); wait_ge_t(done + 0, want, ready + 32 + wave); wait_ge(done + 1, want); wait_ge(done + 2, want); wait_ge(done + 3, want); wait_ge(done + 4, want); }
            LDSQ unsigned char* slot = lds + sl * MLS_SLOT;
            MEMFENCE();
#pragma unroll
            for (int ks = 0; ks < 4; ++ks) { *(LDSQ u32x2*)(slot + fr * MLKP + (32 * ks + 4 * fq) * 2) = kc[2 * ks]; *(LDSQ u32x2*)(slot + fr * MLKP + (32 * ks + 16 + 4 * fq) * 2) = kc[2 * ks + 1]; }
            *(LDSQ u32x2*)(slot + 4608 + lane * 8) = pack4(pt);
#pragma unroll
            for (int i = 0; i < 8; ++i) *(LDSQ u32x2*)(slot + 5376 + i * 512 + lane * 8) = qc[i];
            if (fq == 0) { *(LDSQ float*)(slot + 5120 + fr * 4) = fexp(Mcarry - Mx); *(LDSQ float*)(slot + 5184 + fr * 4) = fexp(a - Mend); *(LDSQ float*)(slot + 5248 + fr * 4) = rs; }
            if (lane == 0) *(LDSQ float*)(slot + 5312) = fexp(Mcarry - Mend);
            flag_st(ready + sl, (unsigned)c + 1u);
        }
#undef MLP_LOAD
    }
}

constexpr int M3P = 288, M3T = 32 * M3P;
constexpr int M3_K = 0, M3_Q = M3T, M3_V = 2 * M3T, M3_P = 3 * M3T, M3_WI = M3_P + 2048, M3_WT = M3_WI + 128, M3_RS = M3_WT + 128, M3_A = M3_RS + 128, M3_MX = M3_A + 128, M3_WS = M3_MX + 128;
constexpr int M3_SLOT = M3_P + 2048 + 1024;
template <int NJ, int NCONS, int ABL = 0> DI void mlstm_coop32(int wave, int cbase  , bool with_den, const GQ bf16_t* __restrict__ Qp, const GQ bf16_t* __restrict__ Kp, int ldqk, const GQ bf16_t* __restrict__ Vp, int ldv, const GQ float* __restrict__ SC_A, const GQ float* __restrict__ SC_M,
                     int S, GQ bf16_t* __restrict__ NUM, int ldn, GQ float* __restrict__ DEN, int ldd, LDSQ unsigned char* lds, LDSQ unsigned* flags) {
    constexpr int NTP = (16 * NJ * NCONS == 128) ? 272 : 144, M3_NT = M3_SLOT, M3_DN = M3_NT + 32 * NTP, M3_SLOTX = M3_DN + 128, M3_NSLOT = 3;
    const int lane = lane_id(), fr = lane & 15, fq = lane >> 4;
    const int NC = S / 32;
    LDSQ unsigned* ready = flags;
    LDSQ unsigned* done = flags + 16;
    LDSQ unsigned* flushed = flags + 24;
    const int lrow = lane >> 4, lpc = lane & 15;
#define M3_FLUSH(sp_, cc_) do { MEMFENCE(); \
        if (16 * NJ * NCONS == 128) { _Pragma("unroll") for (int g = 0; g < 8; ++g) { const int r_ = 4 * g + lrow; \
            *(GQ u32x4*)(NUM + (size_t)(32 * (cc_) + r_) * ldn + cbase + 8 * lpc) = *(const LDSQ u32x4*)((sp_) + M3_NT + r_ * NTP + lpc * 16); } } \
        else { _Pragma("unroll") for (int g = 0; g < 4; ++g) { const int r_ = 8 * g + (lane >> 3), pc_ = lane & 7; \
            *(GQ u32x4*)(NUM + (size_t)(32 * (cc_) + r_) * ldn + cbase + 8 * pc_) = *(const LDSQ u32x4*)((sp_) + M3_NT + r_ * NTP + pc_ * 16); } } \
        if (with_den && lane < 32) DEN[(size_t)(32 * (cc_) + lane) * ldd] = *(const LDSQ float*)((sp_) + M3_DN + lane * 4); \
        MEMFENCE(); } while (0)
    const u32x2 z2 = {0u, 0u};
    const f32x4 z4 = {0.f, 0.f, 0.f, 0.f};
    if (wave < 5) {
        if (wave >= NCONS && wave != 4) return;
        const bool isden = (wave == 4);
        f32x4 C[8][NJ];
#pragma unroll
        for (int ci = 0; ci < 8; ++ci)
#pragma unroll
            for (int j = 0; j < NJ; ++j) C[ci][j] = z4;
        const int cw = cbase + 16 * NJ * wave;
        for (int c = 0; c < NC; ++c) {
            const int sl = c % M3_NSLOT;
            LDSQ unsigned char* slot = lds + sl * M3_SLOTX;
            wait_ge_t(ready + sl, (unsigned)c + 1u, flags + 32 + wave);
            const float wst = *(const LDSQ float*)(slot + M3_WS);
            f32x4 wi[2], wt[2];
#pragma unroll
            for (int h = 0; h < 2; ++h) { wi[h] = *(const LDSQ f32x4*)(slot + M3_WI + (16 * h + 4 * fq) * 4); wt[h] = *(const LDSQ f32x4*)(slot + M3_WT + (16 * h + 4 * fq) * 4); }
#define M3_QF(tt_, ks_) mk8(ldl8(slot + M3_Q + (16 * (tt_) + fr) * M3P + (32 * (ks_) + 4 * fq) * 2), ldl8(slot + M3_Q + (16 * (tt_) + fr) * M3P + (32 * (ks_) + 4 * fq) * 2 + 32))
            if (isden && !with_den) { flag_st(done + wave, (unsigned)c + 1u); continue; }
            if (!isden) {
                const u32x4 pf0 = *(const LDSQ u32x4*)(slot + M3_P + lane * 16), pf1 = *(const LDSQ u32x4*)(slot + M3_P + 1024 + lane * 16);
                bf16x8 vwb[NJ];
#pragma unroll
                for (int j = 0; j < NJ; ++j) {
                    const int vo = (4 * fq + (fr >> 2)) * M3P + (cw + 16 * j + 4 * (fr & 3)) * 2;
                    s16x4 v0 = {0, 0, 0, 0}, v1 = {0, 0, 0, 0}; if (!(ABL & 4)) { v0 = TR16(slot + M3_V + vo); v1 = TR16(slot + M3_V + 16 * M3P + vo); }
                    const bf16x8 vb = mk8(tr2(v0), tr2(v1));
                    bf16x8 cb[4];
#pragma unroll
                    for (int ks = 0; ks < 4; ++ks) cb[ks] = mk8(pack4(C[2 * ks][j]), pack4(C[2 * ks + 1][j]));
#pragma unroll
                    for (int tt = 0; tt < 2; ++tt) {
                        f32x4 numI = z4; if (!(ABL & 4)) numI = mfma16(__builtin_bit_cast(bf16x8, tt ? pf1 : pf0), vb, z4);
                        f32x4 inter = z4;
                        if (!(ABL & 2)) {
#pragma unroll
                        for (int ks = 0; ks < 4; ++ks) inter = mfma16(M3_QF(tt, ks), cb[ks], inter); }
#pragma unroll
                        for (int i = 0; i < 4; ++i) *(LDSQ unsigned short*)(slot + M3_NT + (16 * tt + 4 * fq + i) * NTP + (16 * NJ * wave + 16 * j + fr) * 2) = f2bf(numI[i] + wi[tt][i] * inter[i]);
                    }
                    f32x4 w0, w1;
#pragma unroll
                    for (int i = 0; i < 4; ++i) { w0[i] = bf2f((unsigned short)v0[i]) * wt[0][i]; w1[i] = bf2f((unsigned short)v1[i]) * wt[1][i]; }
                    vwb[j] = mk8(pack4(w0), pack4(w1));
                }
#pragma unroll
                for (int ci = 0; ci < ((ABL & 1) ? 0 : 8); ++ci) {
                    const int ko = (4 * fq + (fr >> 2)) * M3P + (16 * ci + 4 * (fr & 3)) * 2;
                    const bf16x8 ka = mk8(tr2(TR16(slot + M3_K + ko)), tr2(TR16(slot + M3_K + 16 * M3P + ko)));
#pragma unroll
                    for (int j = 0; j < NJ; ++j) {
                        C[ci][j] *= wst;
#ifndef HOST_EMU
                        asm volatile("" : "+v"(C[ci][j]));
#endif
                        C[ci][j] = mfma16(ka, vwb[j], C[ci][j]); }
                }
                flag_st(done + wave, (unsigned)c + 1u);
            } else {
                const f32x4 rs0 = *(const LDSQ f32x4*)(slot + M3_RS + (4 * fq) * 4), rs1 = *(const LDSQ f32x4*)(slot + M3_RS + (16 + 4 * fq) * 4);
                bf16x8 cb[4];
#pragma unroll
                for (int ks = 0; ks < 4; ++ks) cb[ks] = mk8(pack4(C[2 * ks][0]), pack4(C[2 * ks + 1][0]));
#pragma unroll
                for (int tt = 0; tt < 2; ++tt) {
                    f32x4 inter = z4;
#pragma unroll
                    for (int ks = 0; ks < 4; ++ks) inter = mfma16(M3_QF(tt, ks), cb[ks], inter);
                    if (fr == 0) {
#pragma unroll
                        for (int i = 0; i < 4; ++i) *(LDSQ float*)(slot + M3_DN + (16 * tt + 4 * fq + i) * 4) = (tt ? rs1[i] : rs0[i]) + wi[tt][i] * inter[i];
                    }
                }
                f32x4 w0, w1;
#pragma unroll
                for (int i = 0; i < 4; ++i) { w0[i] = (fr == 0) ? wt[0][i] : 0.f; w1[i] = (fr == 0) ? wt[1][i] : 0.f; }
                const bf16x8 vwb = mk8(pack4(w0), pack4(w1));
#pragma unroll
                for (int ci = 0; ci < 8; ++ci) {
                    const int ko = (4 * fq + (fr >> 2)) * M3P + (16 * ci + 4 * (fr & 3)) * 2;
                    const bf16x8 ka = mk8(tr2(TR16(slot + M3_K + ko)), tr2(TR16(slot + M3_K + 16 * M3P + ko)));
                    C[ci][0] = mfma16(ka, vwb, C[ci][0] * wst);
                }
                flag_st(done + wave, (unsigned)c + 1u);
            }
        }
    } else {
        const int p = wave - 5;
        u32x4 tk[8], tq[8], tv[8]; float an = 0.f, mn = 0.f, mcn = 0.f;
#define M3_LOAD(c_) do { _Pragma("unroll") for (int g = 0; g < 8; ++g) { const size_t r = (size_t)(32 * (c_) + 4 * g + lrow); \
        tk[g] = ld16(Kp + r * ldqk + 8 * lpc); tq[g] = ld16(Qp + r * ldqk + 8 * lpc); tv[g] = ld16(Vp + r * ldv + 8 * lpc); } \
    an = SC_A[32 * (c_) + (lane & 31)]; mn = SC_M[32 * (c_) + (lane & 31)]; mcn = ((c_) > 0) ? SC_M[32 * (c_) - 1] : 0.f; } while (0)
#define M3_PARK(cc_) do { LDSQ unsigned char* ps_ = lds + ((cc_) % M3_NSLOT) * M3_SLOTX; \
        if ((cc_) >= M3_NSLOT) { const unsigned want_ = (unsigned)((cc_) - M3_NSLOT + 1); _Pragma("unroll") for (int w_ = 0; w_ < NCONS; ++w_) wait_ge_t(done + w_, want_, flags + 32 + wave); wait_ge_t(done + 4, want_, flags + 32 + wave); M3_FLUSH(ps_, (cc_) - M3_NSLOT); } \
        MEMFENCE(); \
        _Pragma("unroll") for (int g = 0; g < 8; ++g) { const int o_ = (4 * g + lrow) * M3P + lpc * 16; *(LDSQ u32x4*)(ps_ + M3_K + o_) = tk[g]; *(LDSQ u32x4*)(ps_ + M3_Q + o_) = tq[g]; *(LDSQ u32x4*)(ps_ + M3_V + o_) = tv[g]; } \
        { const float Mend_ = __shfl(mn, 31, 32); \
          if (lane < 32) { *(LDSQ float*)(ps_ + M3_A + lane * 4) = an; *(LDSQ float*)(ps_ + M3_MX + lane * 4) = mn; \
              *(LDSQ float*)(ps_ + M3_WI + lane * 4) = fexp(mcn - mn); *(LDSQ float*)(ps_ + M3_WT + lane * 4) = fexp(an - Mend_); } \
          if (lane == 0) *(LDSQ float*)(ps_ + M3_WS) = fexp(mcn - Mend_); } \
        MEMFENCE(); WAVE_SYNC(); } while (0)
        if (p < NC) { M3_LOAD(p); M3_PARK(p); }
        for (int c = p; c < NC; c += 3) {
            if (c + 3 < NC) M3_LOAD(c + 3);
            const int sl = c % M3_NSLOT;
            LDSQ unsigned char* slot = lds + sl * M3_SLOTX;
            f32x4 st00 = z4, st01 = z4, st11 = z4;
#pragma unroll
            for (int ks = 0; ks < 4; ++ks) {
                const int o = fr * M3P + (32 * ks + 4 * fq) * 2;
                const bf16x8 k0 = mk8(ldl8(slot + M3_K + o), ldl8(slot + M3_K + o + 32)), k1 = mk8(ldl8(slot + M3_K + 16 * M3P + o), ldl8(slot + M3_K + 16 * M3P + o + 32));
                const bf16x8 q0 = mk8(ldl8(slot + M3_Q + o), ldl8(slot + M3_Q + o + 32)), q1 = mk8(ldl8(slot + M3_Q + 16 * M3P + o), ldl8(slot + M3_Q + 16 * M3P + o + 32));
                st00 = mfma16(k0, q0, st00); st01 = mfma16(k0, q1, st01); st11 = mfma16(k1, q1, st11);
            }
            const f32x4 as0 = *(const LDSQ f32x4*)(slot + M3_A + (4 * fq) * 4), as1 = *(const LDSQ f32x4*)(slot + M3_A + (16 + 4 * fq) * 4);
            const float mx0 = *(const LDSQ float*)(slot + M3_MX + fr * 4), mx1 = *(const LDSQ float*)(slot + M3_MX + (16 + fr) * 4);
            f32x4 p00, p01, p11;
#pragma unroll
            for (int i = 0; i < 4; ++i) {
                p00[i] = (4 * fq + i <= fr) ? st00[i] * fexp(as0[i] - mx0) : 0.f;
                p01[i] = st01[i] * fexp(as0[i] - mx1);
                p11[i] = (4 * fq + i <= fr) ? st11[i] * fexp(as1[i] - mx1) : 0.f;
            }
            float r0 = (p00[0] + p00[1]) + (p00[2] + p00[3]);
            float r1 = ((p01[0] + p01[1]) + (p01[2] + p01[3])) + ((p11[0] + p11[1]) + (p11[2] + p11[3]));
            r0 += __shfl_xor(r0, 16); r0 += __shfl_xor(r0, 32); r1 += __shfl_xor(r1, 16); r1 += __shfl_xor(r1, 32);
            if (fq == 0) { *(LDSQ float*)(slot + M3_RS + fr * 4) = r0; *(LDSQ float*)(slot + M3_RS + (16 + fr) * 4) = r1; }
            { const u32x2 a0 = pack4(p00); *(LDSQ u32x4*)(slot + M3_P + lane * 16) = (u32x4){a0.x, a0.y, 0u, 0u};
              const u32x2 b0 = pack4(p01), b1 = pack4(p11); *(LDSQ u32x4*)(slot + M3_P + 1024 + lane * 16) = (u32x4){b0.x, b0.y, b1.x, b1.y}; }
            flag_st(ready + sl, (unsigned)c + 1u);
            if (c + 3 < NC) M3_PARK(c + 3);
        }
        for (int c = NC - M3_NSLOT; c < NC; ++c) if (c >= 0 && (c % 3) == p) {
            const unsigned want = (unsigned)c + 1u;
#pragma unroll
            for (int w_ = 0; w_ < NCONS; ++w_) wait_ge(done + w_, want);
            wait_ge(done + 4, want);
            LDSQ unsigned char* sp = lds + (c % M3_NSLOT) * M3_SLOTX; M3_FLUSH(sp, c);
        }
#undef M3_FLUSH
#undef M3_PARK
#undef M3_LOAD
    }
}
#define GAS __attribute__((address_space(1)))
#define LAS __attribute__((address_space(3)))
typedef GAS unsigned gu32;
#define RLX_AGENT __ATOMIC_RELAXED, __HIP_MEMORY_SCOPE_AGENT
#define LDS_WAIT() asm volatile("s_waitcnt lgkmcnt(0)" ::: "memory")
#define VM_WAIT() asm volatile("s_waitcnt vmcnt(0)" ::: "memory")

constexpr int CB = 8, CS = 4096, CD = 1024, CM = CB * CS;
constexpr int NPROJ = 3584, PITCH_WIN = 3592, FF = 4096;
constexpr float NORM_EPS = 1e-6f, GN_EPS = 64e-5f;
constexpr int NWAVES = 8;
constexpr size_t MiB = 1u << 20;
constexpr size_t WS_CTL = 0, CTL_ZERO_BYTES = 1 * MiB;
constexpr size_t WS_W = 1 * MiB;
constexpr size_t WS_GATES = 27 * MiB, WS_DEN = 28 * MiB, WS_EMT = 28 * MiB + 512 * 1024, WS_BONUS = 29 * MiB;
constexpr size_t WS_SCA = 31 * MiB, WS_SCM = 31 * MiB + 512 * 1024;
constexpr size_t WS_U = 32 * MiB;
constexpr size_t WS_BIG = 97 * MiB;
constexpr size_t WS_PROJ = WS_BIG, WS_QKC = 321 * MiB, WS_VT = 385 * MiB, WS_NUM = 417 * MiB;
constexpr size_t WS_MIX = WS_BIG;
constexpr size_t WS_HID = WS_BIG, WS_FFO = 353 * MiB;
constexpr size_t WS_XR = 97 * MiB, WS_XK = 161 * MiB, WS_XV = 225 * MiB, WS_RO = 289 * MiB, WS_KO = 353 * MiB, WS_VO = 417 * MiB, WS_LORA = 481 * MiB, WS_GL = 497 * MiB;
constexpr size_t WS_KT = WS_XR, WS_BT = WS_XK, WS_KK = WS_XV, WS_RT = WS_U, WS_YRAW = WS_RO, WS_YG = WS_KO;
constexpr size_t WS_END = 505 * MiB;
constexpr size_t W_IN = 0, W_OUTE = 3670016, W_UP = 5242880, W_DN = 9437184;
constexpr size_t W_RKV = 0, W_LB1 = 3145728, W_LB2 = 3407872, W_W2T = 3670016, W_A2T = 3735552, W_G2T = 3801088, W_OUTO = 3932160;
constexpr int CW_BAR = 4096;

constexpr int RING_BYTES = 131072, LDSCTL_OFF = RING_BYTES, MISC_OFF = LDSCTL_OFF + 320, LDS_BYTES = 147456;

#define XB_TMO      128
#define XB_XCNT(j)  (256  + 64 * (j))
#define XB_XSUB(j)  (1280 + 64 * (j))
#define XB_XGEN(j)  (2304 + 64 * (j))
#define XB_TOP      3328
#define XB_TOPGEN   3392
#define XCD_BAR_WORDS 3456
#define XB_SPIN_CAP (1u << 18)
__device__ __forceinline__ unsigned xb_ld(unsigned* p)              { return __hip_atomic_load(p, __ATOMIC_RELAXED, __HIP_MEMORY_SCOPE_AGENT); }
__device__ __forceinline__ unsigned xb_add(unsigned* p, unsigned v) { return __hip_atomic_fetch_add(p, v, __ATOMIC_RELAXED, __HIP_MEMORY_SCOPE_AGENT); }
__device__ __forceinline__ unsigned xb_xcc_id() { return (unsigned)__builtin_amdgcn_s_getreg((3 << 11) | 20) & 0xFu; }
#define XB_SPIN(cond, bar) do { unsigned _sp = 0; while (cond) { __builtin_amdgcn_s_sleep(1); \
    if ((++_sp & 255u) == 0u) { if (xb_ld(&(bar)[XB_TMO])) break; if (_sp > XB_SPIN_CAP) { atomicAdd(&(bar)[XB_TMO], 1u); break; } } } } while (0)
struct XcdBarrier { unsigned* bar; unsigned x; volatile LAS unsigned* st; };
__device__ __forceinline__ XcdBarrier xcd_barrier_post(unsigned* bar, volatile LAS unsigned* st, bool t0) {
    XcdBarrier b; b.bar = bar; b.x = xb_xcc_id(); b.st = st;
    if (t0) (void)xb_add(&bar[XB_XCNT(b.x)], 1u);
    return b;
}
__device__ __forceinline__ void xcd_barrier_complete(unsigned* bar, unsigned x, unsigned& nloc, unsigned& nx) {
    const unsigned G = gridDim.x * gridDim.y * gridDim.z;
    unsigned sum, cnt, mine, sp = 0u;
    for (;;) {
        sum = 0u; cnt = 0u; mine = 0u;
#pragma unroll
        for (unsigned j = 0; j < 16; ++j) { const unsigned c = xb_ld(&bar[XB_XCNT(j)]); sum += c; cnt += (c > 0u) ? 1u : 0u; mine = (j == x) ? c : mine; }
        if (sum == G) break;
        __builtin_amdgcn_s_sleep(1);
        if ((++sp & 255u) == 0u) { if (xb_ld(&bar[XB_TMO])) break; if (sp > XB_SPIN_CAP) { atomicAdd(&bar[XB_TMO], 1u); break; } }
    }
    nloc = mine > 0u ? mine : 1u; nx = cnt > 0u ? cnt : 1u;
}
__device__ __forceinline__ void xcd_barrier(const XcdBarrier& b, bool t0) {
    asm volatile("s_waitcnt vmcnt(0)" ::: "memory");
    __syncthreads();
    if (t0) {
        unsigned* bar = b.bar;
        __builtin_amdgcn_s_waitcnt(0);
        unsigned nloc = b.st[0], nx = b.st[1];
        if (nloc == 0u) { xcd_barrier_complete(bar, b.x, nloc, nx); b.st[0] = nloc; b.st[1] = nx; }
        const unsigned old = xb_add(&bar[XB_XSUB(b.x)], 1u);
        const unsigned gen = old / nloc;
        if (old + 1u == (gen + 1u) * nloc) {
            __builtin_amdgcn_fence(__ATOMIC_RELEASE, "agent");
            asm volatile("s_waitcnt vmcnt(0)" ::: "memory");
            const unsigned og = xb_add(&bar[XB_TOP], 1u);
            const unsigned tg = og / nx;
            if (og + 1u == (tg + 1u) * nx) xb_add(&bar[XB_TOPGEN], 1u);
            else XB_SPIN(xb_ld(&bar[XB_TOPGEN]) == tg, bar);
            __builtin_amdgcn_fence(__ATOMIC_ACQUIRE, "agent");
            xb_add(&bar[XB_XGEN(b.x)], 1u);
            asm volatile("s_waitcnt vmcnt(0)" ::: "memory");
        } else {
            XB_SPIN(xb_ld(&bar[XB_XGEN(b.x)]) == gen, bar);
            __builtin_amdgcn_fence(__ATOMIC_ACQUIRE, "agent");
            asm volatile("s_waitcnt vmcnt(0)" ::: "memory");
        }
    }
    __syncthreads();
}

namespace pg8 {
constexpr int BM = 256, BK = 64, HALF = 128, HTB = HALF * BK * 2, STAGE_BYTES = 8 * HTB, NXCD = 8, WGM = 8;
__host__ __device__ __forceinline__ int lds_byte(int r, int c) { const int st = (r >> 4) * 2 + (c >> 5), rr = r & 15, cc = c & 31, ob = rr * 64 + cc * 2; return st * 1024 + (ob ^ (((ob >> 9) & 1) << 5)); }
__host__ __device__ __forceinline__ void stage_rc(int b, int& R, int& C) { const int st = b / 1024, sb = b % 1024, swz = sb ^ (((sb >> 9) & 1) << 5); R = (st >> 1) * 16 + swz / 64; C = (st & 1) * 32 + (swz % 64) / 2; }
__host__ __device__ __forceinline__ int perm32(int rho) { const int n = rho >> 4, i = rho & 15; return 8 * (i >> 2) + 4 * n + (i & 3); }
struct Unit { int pm, pn; };
struct UnitPtrs { const GAS char* A; const GAS char* B; int two; };
struct StaticOrder {
    int nM, nN, nwg, G, c;
    __device__ void init(int M, int N, int G_, int c_) { nM = M / BM; nN = N / BM; nwg = nM * nN; G = G_; c = c_; }
    __device__ bool next(int i, Unit& u) const {
        const long L = (long)i * G + c; if (L >= nwg) return false;
        int wgid = (int)L; { const int q = nwg / NXCD, r = nwg % NXCD, xcd = wgid % NXCD, off = wgid / NXCD; wgid = (xcd < r ? xcd * (q + 1) : r * (q + 1) + (xcd - r) * q) + off; }
        const int nig = WGM * nN, gid = wgid / nig, fm = gid * WGM, gsz = (nM - fm) < WGM ? (nM - fm) : WGM;
        u.pm = fm + ((wgid % nig) % gsz); u.pn = (wgid % nig) / gsz; return true;
    }
};
__device__ __forceinline__ unsigned cvt_pk_bf16(float lo, float hi) { unsigned r; asm volatile("v_cvt_pk_bf16_f32 %0, %1, %2" : "=v"(r) : "v"(lo), "v"(hi)); return r; }

template <int LDA, int LDB, int NT> struct ProbPlain {
    const GAS bf16_t* A; const GAS bf16_t* Bt;
    static constexpr long lda = LDA, ldb = LDB; static constexpr bool TWO_SRC = false; static constexpr int NTC = NT;
    __device__ __forceinline__ void ptrs(const Unit& u, UnitPtrs& p) const {
        p.A = (const GAS char*)(A + (size_t)u.pm * BM * lda); p.B = (const GAS char*)(Bt + (size_t)u.pn * BM * ldb);
    }
};
struct ProbRkv {
    const GAS bf16_t* X; size_t xstride; const GAS bf16_t* Wt; const GAS bf16_t* Upad; const GAS bf16_t* LB1; long lb2d;
    static constexpr long lda = 1024, ldb = 1024; static constexpr bool TWO_SRC = true; static constexpr int NTC = 16;
    __device__ __forceinline__ void ptrs(const Unit& u, UnitPtrs& p) const {
        if (u.pn < 12) { p.A = (const GAS char*)(X + (size_t)(u.pn >> 2) * xstride + (size_t)u.pm * BM * 1024); p.B = (const GAS char*)(Wt + (size_t)u.pn * BM * 1024); p.two = 0; }
        else { const size_t arow = (size_t)u.pm * BM + (size_t)(u.pm >> 4) + 1; p.A = (const GAS char*)(Upad + arow * 1024); p.B = (const GAS char*)LB1; p.two = 1; }
    }
};
struct RkvOrder {
    int c;
    __device__ bool next(int i, Unit& u) const { const int half = c & 1; if (i >= (half ? 6 : 7)) return false; u.pm = c >> 1; u.pn = half ? 7 + i : i; return true; }
};
struct EpiStore {
    GAS bf16_t* O; int ldc; int act; int rkv; size_t gstride; GAS bf16_t* Ol;
    static constexpr bool PERM = true;
    __device__ __forceinline__ void operator()(const f32x4 (&acc)[2][2][4][2], const Unit& u, int wr, int wc, int fr, int fq) const {
        GAS bf16_t* base = O; int ld = ldc, colt = u.pn * BM;
        if (rkv) { if (u.pn < 12) { base = O + (size_t)(u.pn >> 2) * gstride; colt = (u.pn & 3) * BM; } else { base = Ol; ld = 256; colt = 0; } }
        const int row0 = u.pm * BM + wr * 64 + fr, col0 = colt + wc * 32 + 8 * fq;
#pragma unroll
        for (int ai = 0; ai < 2; ++ai)
#pragma unroll
            for (int m = 0; m < 4; ++m) { GAS bf16_t* rowp = base + (size_t)(row0 + ai * HALF + m * 16) * ld + col0;
#pragma unroll
                for (int bj = 0; bj < 2; ++bj) { f32x4 v0 = acc[ai][bj][m][0], v1 = acc[ai][bj][m][1];
                    if (rkv && u.pn == 12) {
                        if (bj == 1) {
#pragma unroll
                            for (int q = 0; q < 4; ++q) { v0[q] = sigmoidf_(v0[q]); v1[q] = sigmoidf_(v1[q]); }
                        } else if (wc < 2) {
#pragma unroll
                            for (int q = 0; q < 4; ++q) { v0[q] = tanhf_(v0[q]); v1[q] = tanhf_(v1[q]); }
                        }
                    }
                    if (act == 1) {
#pragma unroll
                        for (int q = 0; q < 4; ++q) { const float a = fmaxf(v0[q], 0.f), b = fmaxf(v1[q], 0.f); v0[q] = a * a; v1[q] = b * b; } }
                    u32x4 w; w.x = cvt_pk_bf16(v0[0], v0[1]); w.y = cvt_pk_bf16(v0[2], v0[3]); w.z = cvt_pk_bf16(v1[0], v1[1]); w.w = cvt_pk_bf16(v1[2], v1[3]);
                    *(GAS u32x4*)(rowp + bj * HALF) = w; } }
    }
};

template <class Prob, class Epi, class Sched>
__device__ __forceinline__ void gemm_phase(LAS unsigned char* lds, int wave_in, const Prob& P, const Sched& S, const Epi& E) {
    const int wid = __builtin_amdgcn_readfirstlane(wave_in); const int lane = lane_id(); const int tid = wid * 64 + lane;
    const int wr = wid >> 2, wc = wid & 3, fr = lane & 15, fq = lane >> 4;
    constexpr long lda = Prob::lda, ldb = Prob::ldb; long lb2d = 0; if constexpr (Prob::TWO_SRC) lb2d = P.lb2d;
    unsigned voffA[2], voffB[2];
#pragma unroll
    for (int i = 0; i < 2; ++i) { int R, C; stage_rc(tid * 16 + i * 8192, R, C); const int Rb = Epi::PERM ? ((R & ~31) + perm32(R & 31)) : R;
        voffA[i] = (unsigned)(R * lda + C) * 2u; voffB[i] = (unsigned)(Rb * ldb + C) * 2u; }
    const long kstep = (long)(BK * 2);
    const long hstepA = (long)HALF * lda * 2, hstepB = (long)HALF * ldb * 2;
    const unsigned ldsw = (unsigned)wid * 1024u;
    const int aoff = lds_byte(wr * 64 + fr, fq * 8), boff = lds_byte(wc * 32 + fr, fq * 8);
#define PG8_SA(b, h) (((b) * 2 + (h)) * HTB)
#define PG8_SB(b, h) ((4 + (b) * 2 + (h)) * HTB)
#define PG8_STAGE(bufoff, gbase, voff) do { _Pragma("unroll") for (int _i = 0; _i < 2; ++_i) \
        __builtin_amdgcn_global_load_lds((const GAS unsigned*)((const GAS char*)(gbase) + (voff)[_i]), (LAS unsigned*)(lds + (bufoff) + ldsw + _i * 8192), 16, 0, 0); } while (0)
#define PG8_LDA(dst, b, h) do { _Pragma("unroll") for (int m = 0; m < 4; ++m) _Pragma("unroll") for (int k = 0; k < 2; ++k) dst[m][k] = *(const LAS bf16x8*)(lds + PG8_SA(b, h) + aoff + m * 2048 + k * 1024); } while (0)
#define PG8_LDB(dst, b, h) do { _Pragma("unroll") for (int n = 0; n < 2; ++n) _Pragma("unroll") for (int k = 0; k < 2; ++k) dst[n][k] = *(const LAS bf16x8*)(lds + PG8_SB(b, h) + boff + n * 2048 + k * 1024); } while (0)
#define PG8_MMA(ai, bj, At, Bt) do { __builtin_amdgcn_s_setprio(1); _Pragma("unroll") for (int m = 0; m < 4; ++m) _Pragma("unroll") for (int n = 0; n < 2; ++n) _Pragma("unroll") for (int k = 0; k < 2; ++k) \
        acc[ai][bj][m][n] = __builtin_amdgcn_mfma_f32_16x16x32_bf16(Bt[n][k], At[m][k], acc[ai][bj][m][n], 0, 0, 0); __builtin_amdgcn_s_setprio(0); } while (0)
#define PG8_WAIT_V(n) asm volatile("s_waitcnt vmcnt(" #n ")" ::: "memory")
#define PG8_WAIT_L(n) asm volatile("s_waitcnt lgkmcnt(" #n ")" ::: "memory")
#define PG8_BAR __builtin_amdgcn_s_barrier()
#define PG8_SCHED __builtin_amdgcn_sched_barrier(0)
#define PG8_KTA(p, tau) ((p).A + ((!Prob::TWO_SRC || (tau) < 16) ? (long)(tau) * kstep : (long)((tau) - 16) * kstep - 2048))
#define PG8_KTB(p, tau) ((p).B + ((!Prob::TWO_SRC || (tau) < 16) ? (long)(tau) * kstep : (long)((tau) - 16) * kstep + lb2d))
    Unit cur, nxt; int ui = 0;
    if (!S.next(0, cur)) return;
    UnitPtrs cp, np; P.ptrs(cur, cp);
    f32x4 acc[2][2][4][2];
#pragma unroll
    for (int a = 0; a < 2; ++a)
#pragma unroll
        for (int b = 0; b < 2; ++b)
#pragma unroll
            for (int m = 0; m < 4; ++m)
#pragma unroll
                for (int n = 0; n < 2; ++n) acc[a][b][m][n] = (f32x4){0.f, 0.f, 0.f, 0.f};
    bf16x8 At[4][2], B0[2][2], B1[2][2];
    {
        const GAS char* cA = cp.A; const GAS char* cB = cp.B;
        PG8_STAGE(PG8_SB(0, 0), cB, voffB); PG8_STAGE(PG8_SB(0, 1), cB + hstepB, voffB); PG8_STAGE(PG8_SA(0, 0), cA, voffA); PG8_STAGE(PG8_SA(0, 1), cA + hstepA, voffA);
        if (wr == 1) PG8_BAR;
        PG8_WAIT_V(2); PG8_BAR;
        PG8_STAGE(PG8_SB(1, 0), cB + kstep, voffB); PG8_STAGE(PG8_SA(1, 0), cA + kstep, voffA); PG8_STAGE(PG8_SB(1, 1), cB + hstepB + kstep, voffB);
        PG8_WAIT_V(6); PG8_BAR;
    }
    for (;;) {
        const bool has_next = S.next(ui + 1, nxt);
        if (has_next) P.ptrs(nxt, np); else np = cp;
        int nt = Prob::NTC; if constexpr (Prob::TWO_SRC) { if (cp.two) nt = 32; }
        for (int t = 0; t < nt; t += 2) {
            const bool last = (t == nt - 2);
            const GAS char* a1 = PG8_KTA(cp, t + 1);
            const GAS char* a2 = last ? np.A : PG8_KTA(cp, t + 2); const GAS char* b2 = last ? np.B : PG8_KTB(cp, t + 2);
            const GAS char* a3 = a2 + kstep; const GAS char* b3 = b2 + kstep;
            PG8_LDB(B0, 0, 0); PG8_LDB(B1, 0, 1); PG8_SCHED; PG8_LDA(At, 0, 0); PG8_STAGE(PG8_SA(1, 1), a1 + hstepA, voffA);
            PG8_WAIT_V(8); PG8_WAIT_L(0); PG8_BAR; PG8_MMA(0, 0, At, B0); PG8_MMA(0, 1, At, B1); PG8_BAR; PG8_SCHED;
            PG8_LDA(At, 0, 1); PG8_STAGE(PG8_SB(0, 0), b2, voffB); PG8_STAGE(PG8_SB(0, 1), b2 + hstepB, voffB); PG8_STAGE(PG8_SA(0, 0), a2, voffA);
            PG8_WAIT_V(8); PG8_WAIT_L(0); PG8_BAR; PG8_MMA(1, 0, At, B0); PG8_MMA(1, 1, At, B1); PG8_BAR; PG8_SCHED;
            PG8_LDB(B0, 1, 0); PG8_LDB(B1, 1, 1); PG8_SCHED; PG8_LDA(At, 1, 0); PG8_STAGE(PG8_SA(0, 1), a2 + hstepA, voffA);
            PG8_WAIT_V(8); PG8_WAIT_L(0); PG8_BAR; PG8_MMA(0, 0, At, B0); PG8_MMA(0, 1, At, B1); PG8_BAR; PG8_SCHED;
            PG8_LDA(At, 1, 1); PG8_STAGE(PG8_SB(1, 0), b3, voffB); PG8_STAGE(PG8_SB(1, 1), b3 + hstepB, voffB); PG8_STAGE(PG8_SA(1, 0), a3, voffA);
            PG8_WAIT_V(8); PG8_WAIT_L(0); PG8_BAR; PG8_MMA(1, 0, At, B0); PG8_MMA(1, 1, At, B1); PG8_BAR; PG8_SCHED;
        }
        if (wr == 0) PG8_BAR;
        E(acc, cur, wr, wc, fr, fq);
        if (!has_next) break;
#pragma unroll
        for (int a = 0; a < 2; ++a)
#pragma unroll
            for (int b = 0; b < 2; ++b)
#pragma unroll
                for (int m = 0; m < 4; ++m)
#pragma unroll
                    for (int n = 0; n < 2; ++n) acc[a][b][m][n] = (f32x4){0.f, 0.f, 0.f, 0.f};
        cur = nxt; cp = np; ++ui;
        if (wr == 1) PG8_BAR;
    }
    PG8_WAIT_V(0);
    PG8_BAR;
#undef PG8_SA
#undef PG8_SB
#undef PG8_STAGE
#undef PG8_LDA
#undef PG8_LDB
#undef PG8_MMA
#undef PG8_WAIT_V
#undef PG8_WAIT_L
#undef PG8_BAR
#undef PG8_SCHED
#undef PG8_KTA
#undef PG8_KTB
}
}

struct Frame {
    LAS unsigned char* lds;
    int tid, lane, wave, vcu, G, gw, NGW;
};
#define DPP_ADD(v, ctrl) v += __builtin_bit_cast(float, __builtin_amdgcn_update_dpp(0, __builtin_bit_cast(int, v), ctrl, 0xF, 0xF, true))
__device__ __forceinline__ float wave_sum(float v) {
    DPP_ADD(v, 0xB1); DPP_ADD(v, 0x4E); DPP_ADD(v, 0x141); DPP_ADD(v, 0x140);
    v += __shfl_xor(v, 16); v += __shfl_xor(v, 32);
    return v;
}
__device__ __forceinline__ void cvt_item(const GAS float* W, int ldw, GAS bf16_t* WT, int ldt, int k0, int n0, const GAS float* sc, int mode, LAS float* scr, int lane) {
#pragma unroll 8
    for (int i = 0; i < 32; ++i) { const int kk = 2 * i + (lane >> 5); float v = W[(size_t)(k0 + kk) * ldw + n0 + (lane & 31)];
        if (mode) { const float s = sc[k0 + kk]; v *= (mode == 1) ? s : (1.0f - s); }
        scr[kk * 33 + (lane & 31)] = v; }
    LDS_WAIT(); asm volatile("" ::: "memory");
    const int c = lane & 7;
#pragma unroll
    for (int j = 0; j < 4; ++j) { const int n = (lane >> 3) + 8 * j; const LAS float* s = scr + (8 * c) * 33 + n;
        u32x4 o; o.x = pk2(s[0 * 33], s[1 * 33]); o.y = pk2(s[2 * 33], s[3 * 33]); o.z = pk2(s[4 * 33], s[5 * 33]); o.w = pk2(s[6 * 33], s[7 * 33]);
        *(GAS u32x4*)(WT + (size_t)(n0 + n) * ldt + k0 + 8 * c) = o; }
    LDS_WAIT(); asm volatile("" ::: "memory");
}
__device__ __forceinline__ void cvt_matrix(const Frame& F, const GAS float* W, int ldw, int K, int N, GAS bf16_t* WT, int ldt, const GAS float* sc, int mode, int& cursor) {
    LAS float* scr = (LAS float*)(F.lds + F.wave * 16384);
    const int nnb = N / 32, nitems = (K / 64) * nnb;
    int first = (F.gw - cursor) % F.NGW; if (first < 0) first += F.NGW;
    for (int it = first; it < nitems; it += F.NGW) cvt_item(W, ldw, WT, ldt, 64 * (it / nnb), 32 * (it % nnb), sc, mode, scr, F.lane);
    cursor += nitems;
}
struct Inputs { const float* p[25]; };
#define INP(i) ((const GAS float*)in.p[i])
__device__ __forceinline__ void convert_layer(const Frame& F, const Inputs& in, GAS bf16_t* Wb, int L) {
    int cur = 0;
    if ((L & 1) == 0) {
        const int e = L >> 1;
        cvt_matrix(F, INP(2) + (size_t)e * 1024 * PITCH_WIN, PITCH_WIN, 1024, NPROJ, Wb + W_IN, 1024, nullptr, 0, cur);
        cvt_matrix(F, INP(6) + (size_t)e * 1024 * 1024, 1024, 1024, 1024, Wb + W_OUTE, 1024, nullptr, 0, cur);
    } else {
        const int o = L >> 1; const GAS float* mu = INP(7) + (size_t)o * 6 * 1024;
        for (int j = 0; j < 3; ++j) cvt_matrix(F, INP(8) + ((size_t)o * 3 + j) * 1024 * 1024, 1024, 1024, 1024, Wb + W_RKV + (size_t)j * 1024 * 1024, 1024, nullptr, 0, cur);
        for (int s = 0; s < 2; ++s) { GAS bf16_t* LB = Wb + (s ? W_LB2 : W_LB1); const int mode = s ? 1 : 2;
            cvt_matrix(F, INP(10) + (size_t)o * 1024 * 64, 64, 1024, 64, LB, 1024, mu + 1 * 1024, mode, cur);
            cvt_matrix(F, INP(13) + (size_t)o * 1024 * 64, 64, 1024, 64, LB + 64 * 1024, 1024, mu + 4 * 1024, mode, cur);
            cvt_matrix(F, INP(15) + (size_t)o * 1024 * 128, 128, 1024, 128, LB + 128 * 1024, 1024, mu + 5 * 1024, mode, cur); }
        cvt_matrix(F, INP(11) + (size_t)o * 64 * 1024, 1024, 64, 1024, Wb + W_W2T, 64, nullptr, 0, cur);
        cvt_matrix(F, INP(14) + (size_t)o * 64 * 1024, 1024, 64, 1024, Wb + W_A2T, 64, nullptr, 0, cur);
        cvt_matrix(F, INP(16) + (size_t)o * 128 * 1024, 1024, 128, 1024, Wb + W_G2T, 128, nullptr, 0, cur);
        cvt_matrix(F, INP(22) + (size_t)o * 1024 * 1024, 1024, 1024, 1024, Wb + W_OUTO, 1024, nullptr, 0, cur);
    }
    cvt_matrix(F, INP(23) + (size_t)L * 1024 * FF, FF, 1024, FF, Wb + W_UP, 1024, nullptr, 0, cur);
    cvt_matrix(F, INP(24) + (size_t)L * FF * 1024, 1024, FF, 1024, Wb + W_DN, FF, nullptr, 0, cur);
}

struct RowPassArgs {
    const GAS float* hsrc; const GAS bf16_t* y; const GAS float* gpost; GAS float* hdst;
    GAS bf16_t* udst; const GAS float* gpre; int upad;
    const GAS float* gate_w; const GAS float* gate_b; GAS float* gates;
};
template <int R>
__device__ __forceinline__ void row_pass(const Frame& F, const RowPassArgs& A) {
    LAS float* GWT = (LAS float*)(F.lds + 65536);
    if (A.gates) {
        for (int idx = F.tid; idx < 8192; idx += NWAVES * 64) { const int k = idx >> 3, j = idx & 7; GWT[j * 1024 + k] = A.gate_w[(size_t)k * PITCH_WIN + NPROJ + j]; }
        __syncthreads();
    }
    f32x4 gp[4], gq[4];
#pragma unroll
    for (int j = 0; j < 4; ++j) { gp[j] = A.gpost ? *(const GAS f32x4*)(A.gpost + 4 * F.lane + 256 * j) : (f32x4){0.f, 0.f, 0.f, 0.f}; gq[j] = A.gpre ? *(const GAS f32x4*)(A.gpre + 4 * F.lane + 256 * j) : (f32x4){0.f, 0.f, 0.f, 0.f}; }
    for (int base = F.gw * R; base < CM; base += F.NGW * R) {
        f32x4 hv[R][4]; u32x2 yw[R][4];
#pragma unroll
        for (int r = 0; r < R; ++r)
#pragma unroll
            for (int j = 0; j < 4; ++j) { hv[r][j] = *(const GAS f32x4*)(A.hsrc + (size_t)(base + r) * CD + 4 * F.lane + 256 * j); if (A.y) yw[r][j] = ld8(A.y + (size_t)(base + r) * CD + 4 * F.lane + 256 * j); }
        if (A.y) {
            f32x4 yf[R][4]; float ss[R];
#pragma unroll
            for (int r = 0; r < R; ++r) { ss[r] = 0.f;
#pragma unroll
                for (int j = 0; j < 4; ++j) { const u32x2 w = yw[r][j];
                    yf[r][j] = (f32x4){bf2f((unsigned short)(w.x & 0xffffu)), bf2f((unsigned short)(w.x >> 16)), bf2f((unsigned short)(w.y & 0xffffu)), bf2f((unsigned short)(w.y >> 16))};
                    ss[r] += (yf[r][j][0] * yf[r][j][0] + yf[r][j][1] * yf[r][j][1]) + (yf[r][j][2] * yf[r][j][2] + yf[r][j][3] * yf[r][j][3]); } }
#pragma unroll
            for (int r = 0; r < R; ++r) ss[r] = wave_sum(ss[r]);
#pragma unroll
            for (int r = 0; r < R; ++r) { const float rs = __builtin_amdgcn_rsqf(ss[r] * (1.0f / CD) + NORM_EPS);
#pragma unroll
                for (int j = 0; j < 4; ++j) { hv[r][j] += yf[r][j] * rs * gp[j]; *(GAS f32x4*)(A.hdst + (size_t)(base + r) * CD + 4 * F.lane + 256 * j) = hv[r][j]; } }
        }
        if (A.udst) {
            float ss[R];
#pragma unroll
            for (int r = 0; r < R; ++r) { ss[r] = 0.f;
#pragma unroll
                for (int j = 0; j < 4; ++j) ss[r] += (hv[r][j][0] * hv[r][j][0] + hv[r][j][1] * hv[r][j][1]) + (hv[r][j][2] * hv[r][j][2] + hv[r][j][3] * hv[r][j][3]); }
#pragma unroll
            for (int r = 0; r < R; ++r) ss[r] = wave_sum(ss[r]);
#pragma unroll
            for (int r = 0; r < R; ++r) {
                const int row = base + r;
                const float rs = __builtin_amdgcn_rsqf(ss[r] * (1.0f / CD) + NORM_EPS);
                const size_t urow = A.upad ? (size_t)row + (size_t)(row / CS) + 1 : (size_t)row;
                f32x4 uf[4];
#pragma unroll
                for (int j = 0; j < 4; ++j) { uf[j] = hv[r][j] * rs * gq[j]; *(GAS u32x2*)(A.udst + urow * CD + 4 * F.lane + 256 * j) = pack4(uf[j]); }
                if (A.upad && (row % CS) == 0) {
#pragma unroll
                    for (int j = 0; j < 4; ++j) *(GAS u32x2*)(A.udst + (urow - 1) * CD + 4 * F.lane + 256 * j) = (u32x2){0u, 0u};
                }
                if (A.gates) {
                    float v[8];
                    int goff = 4 * F.lane; asm volatile("" : "+v"(goff));
#pragma unroll
                    for (int g = 0; g < 8; ++g) { float s = 0.f;
#pragma unroll
                        for (int j = 0; j < 4; ++j) { const f32x4 w = *(const LAS f32x4*)(GWT + g * 1024 + goff + 256 * j); s += (uf[j][0] * w[0] + uf[j][1] * w[1]) + (uf[j][2] * w[2] + uf[j][3] * w[3]); }
                        v[g] = s; }
                    const bool b5 = (F.lane & 32) != 0, b4 = (F.lane & 16) != 0, b3 = (F.lane & 8) != 0;
                    float r4[4], r2[2];
#pragma unroll
                    for (int i = 0; i < 4; ++i) { const float snd = b5 ? v[i] : v[i + 4], kp = b5 ? v[i + 4] : v[i]; r4[i] = kp + __shfl_xor(snd, 32); }
#pragma unroll
                    for (int i = 0; i < 2; ++i) { const float snd = b4 ? r4[i] : r4[i + 2], kp = b4 ? r4[i + 2] : r4[i]; r2[i] = kp + __shfl_xor(snd, 16); }
                    float r1; { const float snd = b3 ? r2[0] : r2[1], kp = b3 ? r2[1] : r2[0]; r1 = kp + __shfl_xor(snd, 8); }
                    r1 += __shfl_xor(r1, 4); r1 += __shfl_xor(r1, 2); r1 += __shfl_xor(r1, 1);
                    if ((F.lane & 7) == 0) { const int o = F.lane >> 3; float g = r1 + A.gate_b[o]; if (o >= 4) g = -softplusf(-g); A.gates[(size_t)row * 8 + o] = g; }
                }
            }
        }
    }
}
__device__ __forceinline__ void mix_pass(const Frame& F, const GAS bf16_t* Upad, const GAS float* mu, GAS bf16_t* XR, GAS bf16_t* XK, GAS bf16_t* XV) {
    f32x4 m0[4], m2[4], m3[4];
#pragma unroll
    for (int j = 0; j < 4; ++j) { m0[j] = *(const GAS f32x4*)(mu + 0 * 1024 + 4 * F.lane + 256 * j); m2[j] = *(const GAS f32x4*)(mu + 2 * 1024 + 4 * F.lane + 256 * j); m3[j] = *(const GAS f32x4*)(mu + 3 * 1024 + 4 * F.lane + 256 * j); }
    constexpr int R = 4;
    for (int base = F.gw * R; base < CM; base += F.NGW * R) {
        u32x2 a[R][4], b[R][4];
#pragma unroll
        for (int r = 0; r < R; ++r) { const size_t urow = (size_t)(base + r) + (size_t)((base + r) / CS) + 1;
#pragma unroll
            for (int j = 0; j < 4; ++j) { const size_t c = 4 * F.lane + 256 * j; a[r][j] = ld8(Upad + urow * CD + c); b[r][j] = ld8(Upad + (urow - 1) * CD + c); } }
#pragma unroll
        for (int r = 0; r < R; ++r)
#pragma unroll
            for (int j = 0; j < 4; ++j) {
                const size_t c = 4 * F.lane + 256 * j;
                const f32x4 u = {bf2f((unsigned short)(a[r][j].x & 0xffffu)), bf2f((unsigned short)(a[r][j].x >> 16)), bf2f((unsigned short)(a[r][j].y & 0xffffu)), bf2f((unsigned short)(a[r][j].y >> 16))};
                const f32x4 p = {bf2f((unsigned short)(b[r][j].x & 0xffffu)), bf2f((unsigned short)(b[r][j].x >> 16)), bf2f((unsigned short)(b[r][j].y & 0xffffu)), bf2f((unsigned short)(b[r][j].y >> 16))};
                const f32x4 xx = p - u;
                *(GAS u32x2*)(XR + (size_t)(base + r) * CD + c) = pack4(u + xx * m0[j]);
                *(GAS u32x2*)(XK + (size_t)(base + r) * CD + c) = pack4(u + xx * m2[j]);
                *(GAS u32x2*)(XV + (size_t)(base + r) * CD + c) = pack4(u + xx * m3[j]);
            }
    }
}
__device__ __forceinline__ void conv_vt_pass(const Frame& F, const GAS bf16_t* PROJ, const GAS float* convw, GAS bf16_t* QKC, GAS bf16_t* VT, const GAS float* GATES, GAS float* SCA, GAS float* SCM, GAS float* SCE) {
    if (blockIdx.x < 32) { const int st = blockIdx.x, b = st >> 2, mh = st & 3; mlstm_gate_scan_wg(F.wave, GATES + (size_t)b * CS * 8, mh, 4 + mh, CS, SCA + (size_t)st * CS, SCM + (size_t)st * CS, SCE + (size_t)st * CS, (LAS float*)(F.lds + 80000)); }
    {
        const int cg = F.tid & 127, rs = F.tid >> 7, c0 = 8 * cg;
        float w[4][8];
#pragma unroll
        for (int j = 0; j < 4; ++j) { const f32x4 a = *(const GAS f32x4*)(convw + j * 1024 + c0), b = *(const GAS f32x4*)(convw + j * 1024 + c0 + 4);
#pragma unroll
            for (int q = 0; q < 4; ++q) { w[j][q] = a[q]; w[j][4 + q] = b[q]; } }
        const float osc = (c0 >= 512) ? 0.08838834764831845f : 1.0f;
        for (int ub = blockIdx.x; ub < CM / 64; ub += F.G) {
            const int r0 = ub * 64 + rs * 16;
            u32x4 x0, x1, x2;
            const int tin = r0 % CS;
            const u32x4 zz = {0u, 0u, 0u, 0u};
            x0 = (tin >= 3) ? ld16(PROJ + (size_t)(r0 - 3) * NPROJ + 1536 + c0) : zz;
            x1 = (tin >= 2) ? ld16(PROJ + (size_t)(r0 - 2) * NPROJ + 1536 + c0) : zz;
            x2 = (tin >= 1) ? ld16(PROJ + (size_t)(r0 - 1) * NPROJ + 1536 + c0) : zz;
#pragma unroll 4
            for (int i = 0; i < 16; ++i) {
                const u32x4 x3 = ld16(PROJ + (size_t)(r0 + i) * NPROJ + 1536 + c0);
                u32x4 o;
#pragma unroll
                for (int q = 0; q < 4; ++q) {
                    float acc0 = w[0][2 * q] * bf2f((unsigned short)(x0[q] & 0xffffu)) + w[1][2 * q] * bf2f((unsigned short)(x1[q] & 0xffffu)) + w[2][2 * q] * bf2f((unsigned short)(x2[q] & 0xffffu)) + w[3][2 * q] * bf2f((unsigned short)(x3[q] & 0xffffu));
                    float acc1 = w[0][2 * q + 1] * bf2f((unsigned short)(x0[q] >> 16)) + w[1][2 * q + 1] * bf2f((unsigned short)(x1[q] >> 16)) + w[2][2 * q + 1] * bf2f((unsigned short)(x2[q] >> 16)) + w[3][2 * q + 1] * bf2f((unsigned short)(x3[q] >> 16));
                    acc0 = acc0 * sigmoidf_(acc0) * osc; acc1 = acc1 * sigmoidf_(acc1) * osc;
                    o[q] = pk2(acc0, acc1);
                }
                *(GAS u32x4*)(QKC + (size_t)(r0 + i) * CD + c0) = o;
                x0 = x1; x1 = x2; x2 = x3;
            }
        }
    }
    {
        LAS unsigned char* tile = F.lds + F.wave * 9216;
        for (int it = F.gw; it < CB * 8 * (CS / 64); it += F.NGW) {
            const int bh = it / (CS / 64), tb = it % (CS / 64), b = bh >> 3, h = bh & 7;
            const size_t tok0 = (size_t)b * CS + (size_t)tb * 64;
#pragma unroll
            for (int i = 0; i < 8; ++i) { const int r = 8 * i + (F.lane >> 3), ch = F.lane & 7;
                *(LAS u32x4*)(tile + r * 144 + ch * 16) = ld16(PROJ + (tok0 + r) * NPROJ + 1024 + 64 * h + 8 * ch); }
            LDS_WAIT(); asm volatile("" ::: "memory");
#pragma unroll
            for (int i = 0; i < 8; ++i) { const int pidx = i * 64 + F.lane, d = pidx >> 3, tg = pidx & 7;
                unsigned short e[8];
#pragma unroll
                for (int q = 0; q < 8; ++q) e[q] = *(const LAS unsigned short*)(tile + (8 * tg + q) * 144 + d * 2);
                u32x4 o = {(unsigned)e[0] | ((unsigned)e[1] << 16), (unsigned)e[2] | ((unsigned)e[3] << 16), (unsigned)e[4] | ((unsigned)e[5] << 16), (unsigned)e[6] | ((unsigned)e[7] << 16)};
                *(GAS u32x4*)(VT + ((size_t)bh * 64 + d) * CS + (size_t)tb * 64 + 8 * tg) = o; }
            LDS_WAIT(); asm volatile("" ::: "memory");
        }
    }
}
#ifndef MLFORM
#define MLFORM 1
#endif
#if MLFORM == 4
#define MLWG 32
#else
#define MLWG 64
#endif
__device__ __forceinline__ void mixers_even_phase(const Frame& F, const GAS bf16_t* PROJ, const GAS bf16_t* QKC, const GAS bf16_t* VT, const GAS float* SCA, const GAS float* SCM, GAS bf16_t* MIXCAT, GAS bf16_t* NUM, GAS float* DEN) {
    const int wg = blockIdx.x;
#ifndef NO_ML
    if (wg < MLWG) {
        LAS unsigned* flags = (LAS unsigned*)(F.lds + LDSCTL_OFF);
        if (F.tid < 64) flags[F.tid] = 0u;
        __syncthreads();
#if MLFORM == 4
        const int st = wg, b = st >> 2, mh = st & 3; const size_t r0 = (size_t)b * CS;
        mlstm_coop32<4, 2>(F.wave, 0, true, QKC + r0 * CD + 128 * mh, QKC + r0 * CD + 512 + 128 * mh, CD, PROJ + r0 * NPROJ + 2560 + 128 * mh, NPROJ, SCA + (size_t)st * CS, SCM + (size_t)st * CS, CS,
                           NUM + r0 * 512 + 128 * mh, 512, DEN + r0 * 4 + mh, 4, F.lds, flags);
#else
        const int st = wg >> 1, half = wg & 1, b = st >> 2, mh = st & 3; const size_t r0 = (size_t)b * CS;
#ifdef ABL_PROBE
        { const unsigned long long t0 = __builtin_amdgcn_s_memrealtime();
          mlstm_coop32<1, 4, ABL_PROBE>(F.wave, 64 * half, half == 0, QKC + r0 * CD + 128 * mh, QKC + r0 * CD + 512 + 128 * mh, CD, PROJ + r0 * NPROJ + 2560 + 128 * mh, NPROJ, SCA + (size_t)st * CS, SCM + (size_t)st * CS, CS,
                           NUM + (size_t)17 * 1048576 + r0 * 512 + 128 * mh, 512, DEN + (size_t)115 * 1048576 + r0 * 4 + mh, 4, F.lds, flags);
          __syncthreads();
          if (blockIdx.x == 0 && F.tid == 0) ((volatile LAS unsigned long long*)(F.lds + MISC_OFF + 64))[1] += __builtin_amdgcn_s_memrealtime() - t0;
          if (F.tid < 64) flags[F.tid] = 0u;
          __syncthreads(); }
#endif
        mlstm_coop32<1, 4>(F.wave, 64 * half, half == 0, QKC + r0 * CD + 128 * mh, QKC + r0 * CD + 512 + 128 * mh, CD, PROJ + r0 * NPROJ + 2560 + 128 * mh, NPROJ, SCA + (size_t)st * CS, SCM + (size_t)st * CS, CS,
                           NUM + r0 * 512 + 128 * mh, 512, DEN + r0 * 4 + mh, 4, F.lds, flags);
#endif
        return;
    }
#endif
#ifndef NO_SB
    const int worker = (wg - MLWG) * NWAVES + F.wave;
    constexpr int NWORK = (256 - MLWG) * NWAVES, NUNIT = CB * 8 * (CS / 32);
    for (int u = worker; u < NUNIT; u += NWORK) {
        const int bh = u / (CS / 32), qb = u % (CS / 32), b = bh >> 3, h = bh & 7;
        const size_t r0 = (size_t)b * CS;
        sb_attn_unit(PROJ + r0 * NPROJ + 64 * h, PROJ + r0 * NPROJ + 512 + 64 * h, NPROJ, VT + (size_t)bh * 64 * CS, CS, MIXCAT + r0 * CD + 64 * h, CD, 32 * qb);
    }
#endif
}
__device__ __forceinline__ void mlstm_post_pass(const Frame& F, const GAS bf16_t* NUM, const GAS float* DEN, const GAS float* SCE, const GAS bf16_t* PROJ, const GAS float* head_g, GAS bf16_t* MIXCAT) {
    const int hd = F.lane >> 4;
    f32x4 g0 = *(const GAS f32x4*)(head_g + 8 * F.lane), g1 = *(const GAS f32x4*)(head_g + 8 * F.lane + 4);
    for (int row = F.gw; row < CM; row += F.NGW) {
        const u32x4 nv = ld16(NUM + (size_t)row * 512 + 8 * F.lane), ov = ld16(PROJ + (size_t)row * NPROJ + 3072 + 8 * F.lane);
        const float den = DEN[(size_t)row * 4 + hd], emt = SCE[(size_t)((row / CS) * 4 + hd) * CS + (row % CS)];
        const float inv = __builtin_amdgcn_rcpf(fmaxf(fabsf(den), emt));
        float hvv[8]; float ss = 0.f;
#pragma unroll
        for (int q = 0; q < 4; ++q) { hvv[2 * q] = bf2f((unsigned short)(nv[q] & 0xffffu)) * inv; hvv[2 * q + 1] = bf2f((unsigned short)(nv[q] >> 16)) * inv; ss += hvv[2 * q] * hvv[2 * q] + hvv[2 * q + 1] * hvv[2 * q + 1]; }
        ss += __shfl_xor(ss, 1); ss += __shfl_xor(ss, 2); ss += __shfl_xor(ss, 4); ss += __shfl_xor(ss, 8);
        const float rs = __builtin_amdgcn_rsqf(ss * (1.0f / 128.0f) + NORM_EPS);
        u32x4 o;
#pragma unroll
        for (int q = 0; q < 4; ++q) {
            const float ga = (q < 2) ? g0[2 * q] : g1[2 * q - 4], gb = (q < 2) ? g0[2 * q + 1] : g1[2 * q - 3];
            const float a = hvv[2 * q] * rs * ga * sigmoidf_(bf2f((unsigned short)(ov[q] & 0xffffu)));
            const float b = hvv[2 * q + 1] * rs * gb * sigmoidf_(bf2f((unsigned short)(ov[q] >> 16)));
            o[q] = pk2(a, b);
        }
        *(GAS u32x4*)(MIXCAT + (size_t)row * CD + 512 + 8 * F.lane) = o;
    }
}
#ifndef PH_MASK
#define PH_MASK 0xFFFFFFFFu
#endif
#define PH(k) ((PH_MASK >> (k)) & 1u)
#ifndef PROBE_MASK
#define PROBE_MASK 0u
#endif
#define REPS(k) (((PROBE_MASK >> (k)) & 1u) ? 2 : 1)
#ifndef PROBE_T
#define PROBE_T 0u
#endif
#define TWORDS ((volatile LAS unsigned long long*)((LAS unsigned char*)lds_raw + MISC_OFF + 64))
#ifndef PROBE_BLK
#define PROBE_BLK 0
#endif
#ifdef CLK_PHASE
#define CLKS(k) do { if ((k) == CLK_PHASE && blockIdx.x == PROBE_BLK && T0_()) TWORDS[2] = __builtin_amdgcn_s_memtime(); } while (0)
#define CLKE(k) do { if ((k) == CLK_PHASE && blockIdx.x == PROBE_BLK && T0_()) TWORDS[1] += (__builtin_amdgcn_s_memtime() - TWORDS[2]) / 100ull; } while (0)
#else
#define CLKS(k) do {} while (0)
#define CLKE(k) do {} while (0)
#endif
#define TSTART(k) do { if (((PROBE_T >> (k)) & 1u) && blockIdx.x == PROBE_BLK && T0_()) TWORDS[0] = __builtin_amdgcn_s_memrealtime(); } while (0)
#define TEND(k) do { if (((PROBE_T >> (k)) & 1u) && blockIdx.x == PROBE_BLK && T0_()) TWORDS[1] += __builtin_amdgcn_s_memrealtime() - TWORDS[0]; } while (0)
struct Args { Inputs in; float* out; unsigned char* ws; };
__device__ __forceinline__ Frame make_frame(LAS unsigned char* lds, int wave_s) {
    Frame F; int bx = blockIdx.x; asm volatile("" : "+s"(bx)); int wv = wave_s; asm volatile("" : "+s"(wv));
    F.lds = lds; F.lane = lane_id(); F.wave = wv; F.tid = wv * 64 + F.lane;
    F.G = gridDim.x; F.vcu = (F.G % 8 == 0) ? (bx % 8) * (F.G / 8) + bx / 8 : bx;
    F.gw = F.vcu * NWAVES + F.wave; F.NGW = F.G * NWAVES; return F;
}
#define PHASE_BEGIN Frame F = make_frame((LAS unsigned char*)lds_raw, wave_s_); unsigned char* wsg_ = args.ws; asm volatile("" : "+s"(wsg_)); GAS unsigned char* ws = (GAS unsigned char*)wsg_; (void)F; \
    GAS bf16_t* Wb = (GAS bf16_t*)(ws + WS_W); GAS bf16_t* U = (GAS bf16_t*)(ws + WS_U); (void)Wb; (void)U; GAS float* HOUT = (GAS float*)args.out; (void)HOUT;
#define T0_() (wave_s_ == 0 && lane_id() == 0)
#define GRID_BAR() do { unsigned char* wsb = args.ws; asm volatile("" : "+s"(wsb)); XcdBarrier bar; bar.bar = (unsigned*)(wsb + WS_CTL) + CW_BAR; bar.x = xb_xcc_id(); \
    bar.st = (volatile LAS unsigned*)((LAS unsigned char*)lds_raw + MISC_OFF) + 8; xcd_barrier(bar, T0_()); } while (0)
__global__ void __launch_bounds__(NWAVES * 64, 2) hybrid_fwd(Args args) {
    extern __shared__ __attribute__((aligned(16))) unsigned char lds_raw[];
    const int wave_s_ = __builtin_amdgcn_readfirstlane((int)(threadIdx.x >> 6));
    {
        LAS unsigned char* l3 = (LAS unsigned char*)lds_raw;
        for (int u = threadIdx.x; u < (LDS_BYTES - LDSCTL_OFF) / 4; u += NWAVES * 64) ((LAS unsigned*)(l3 + LDSCTL_OFF))[u] = 0u;
        __syncthreads();
        (void)xcd_barrier_post((unsigned*)(args.ws + WS_CTL) + CW_BAR, (volatile LAS unsigned*)(l3 + MISC_OFF) + 8, T0_());
    }
    const Inputs& in = args.in;
    {
        PHASE_BEGIN
        if (PH(0)) { convert_layer(F, in, Wb, 0); }
        __syncthreads();
        if (PH(1)) { RowPassArgs A{INP(0), nullptr, nullptr, nullptr, U, INP(1) + 0, 0, INP(2), INP(3), (GAS float*)(ws + WS_GATES)}; row_pass<2>(F, A); }
    }
    GRID_BAR();

    for (int L = 0; L < 4; ++L) {
        if ((L & 1) == 0) {
            const int e = L >> 1;
            TSTART(2); CLKS(2);
            if (PH(2)) {
                PHASE_BEGIN
                pg8::ProbPlain<1024, 1024, 16> P{U, Wb + W_IN}; pg8::StaticOrder S; S.init(CM, NPROJ, F.G, (int)blockIdx.x);
                pg8::EpiStore E{(GAS bf16_t*)(ws + WS_PROJ), NPROJ, 0, 0, 0, nullptr};
                pg8::gemm_phase(F.lds, F.wave, P, S, E);
            }
            GRID_BAR();
            CLKE(2); TEND(2);
            TSTART(3); CLKS(3);
            if (PH(3)) { PHASE_BEGIN conv_vt_pass(F, (const GAS bf16_t*)(ws + WS_PROJ), INP(4) + (size_t)e * 4 * 1024, (GAS bf16_t*)(ws + WS_QKC), (GAS bf16_t*)(ws + WS_VT), (const GAS float*)(ws + WS_GATES), (GAS float*)(ws + WS_SCA), (GAS float*)(ws + WS_SCM), (GAS float*)(ws + WS_EMT)); }
            GRID_BAR();
            CLKE(3); TEND(3);
            TSTART(4); CLKS(4);
            if (PH(4)) { PHASE_BEGIN mixers_even_phase(F, (const GAS bf16_t*)(ws + WS_PROJ), (const GAS bf16_t*)(ws + WS_QKC), (const GAS bf16_t*)(ws + WS_VT), (const GAS float*)(ws + WS_SCA), (const GAS float*)(ws + WS_SCM), U  , (GAS bf16_t*)(ws + WS_NUM), (GAS float*)(ws + WS_DEN)); }
#ifdef E3_PRE
            __syncthreads(); CLKE(4); TEND(4);
#endif
            GRID_BAR();
#ifndef E3_PRE
            CLKE(4); TEND(4);
#endif
            TSTART(5); CLKS(5);
            if (PH(5)) { PHASE_BEGIN mlstm_post_pass(F, (const GAS bf16_t*)(ws + WS_NUM), (const GAS float*)(ws + WS_DEN), (const GAS float*)(ws + WS_EMT), (const GAS bf16_t*)(ws + WS_PROJ), INP(5) + (size_t)e * 512, U); }
            GRID_BAR();
            CLKE(5); TEND(5);
        } else {
            const int o = L >> 1;
            TSTART(6); CLKS(6);
            if (PH(6)) { PHASE_BEGIN mix_pass(F, U, INP(7) + (size_t)o * 6 * 1024, (GAS bf16_t*)(ws + WS_XR), (GAS bf16_t*)(ws + WS_XK), (GAS bf16_t*)(ws + WS_XV)); }
            GRID_BAR();
            CLKE(6); TEND(6);
            TSTART(7); CLKS(7);
            if (PH(7)) {
                PHASE_BEGIN
                pg8::ProbRkv P{(const GAS bf16_t*)(ws + WS_XR), (size_t)(WS_XK - WS_XR) / 2, Wb + W_RKV, U, Wb + W_LB1, (long)(W_LB2 - W_LB1) * 2};
                pg8::RkvOrder S{F.vcu};
                pg8::EpiStore E{(GAS bf16_t*)(ws + WS_RO), 1024, 0, 1, (size_t)(WS_KO - WS_RO) / 2, (GAS bf16_t*)(ws + WS_LORA)};
                pg8::gemm_phase(F.lds, F.wave, P, S, E);
            }
            GRID_BAR();
            CLKE(7); TEND(7);
            TSTART(8); CLKS(8);
            if (PH(8)) {
                PHASE_BEGIN
                RwkvPrepArgs P{(const GAS bf16_t*)(ws + WS_RO), (const GAS bf16_t*)(ws + WS_KO), CD, (const GAS bf16_t*)(ws + WS_LORA), 256, Wb + W_W2T, Wb + W_A2T, INP(9) + (size_t)o * 1024, INP(12) + (size_t)o * 1024, INP(17) + (size_t)o * 1024, INP(18) + (size_t)o * 1024,
                               INP(19) + (size_t)o * 1024, (GAS bf16_t*)(ws + WS_KT), (GAS bf16_t*)(ws + WS_BT), (GAS bf16_t*)(ws + WS_KK), (GAS bf16_t*)(ws + WS_RT), (GAS float*)(ws + WS_GL), (GAS float*)(ws + WS_BONUS)};
                rwkv_prep_loop(P, F.gw, F.NGW, (CM / 16) * 16, F.lds + F.wave * 10240);
            }
            GRID_BAR();
            CLKE(8); TEND(8);
            TSTART(9); CLKS(9);
            if (PH(9)) {
                PHASE_BEGIN
#ifdef LAT_PROBE
                if (blockIdx.x == LAT_PROBE && T0_()) {
                    const GAS unsigned* base = (const GAS unsigned*)(ws + WS_KT) + (size_t)(blockIdx.x >> 4) * CS * 512 + (blockIdx.x & 15) * 32; unsigned x = 0;
                    const unsigned long long t0 = __builtin_amdgcn_s_memrealtime();
                    for (int i = 0; i < 256; ++i) { x = base[(size_t)(i * 16 + (x & 1u)) * 512]; }
                    const unsigned long long t1 = __builtin_amdgcn_s_memrealtime();
                    TWORDS[1] += (t1 - t0) + (x == 0x12345u ? 1 : 0);
                }
#endif
#ifdef CLK_PROBE
                if (blockIdx.x == 0 && T0_()) TWORDS[2] = __builtin_amdgcn_s_memtime();
#endif
                if (blockIdx.x < 128) {
                    if (F.tid < 64) ((LAS unsigned*)(F.lds + RWS_FLAGS))[F.tid] = 0u;
                    __syncthreads();
                    const int bh = blockIdx.x, b = bh >> 4, h = bh & 15;
                    const size_t r0 = (size_t)b * CS, co = 64 * h;
                    rwkv_scan_coop(F.wave, (const GAS bf16_t*)(ws + WS_KT) + r0 * CD + co, (const GAS bf16_t*)(ws + WS_BT) + r0 * CD + co, (const GAS bf16_t*)(ws + WS_KK) + r0 * CD + co, (const GAS bf16_t*)(ws + WS_RT) + r0 * CD + co,
                                   (const GAS bf16_t*)(ws + WS_VO) + r0 * CD + co, CD, (const GAS float*)(ws + WS_GL) + (r0 / 16) * 1024 + co, CS, (GAS bf16_t*)(ws + WS_YRAW) + r0 * CD + co, CD, F.lds);
#ifdef COOP_PROBE
                    __syncthreads(); if (blockIdx.x == 0 && T0_()) TWORDS[1] += ((LAS unsigned*)(F.lds + RWS_FLAGS))[32 + COOP_PROBE];
#endif
#ifdef CLK_PROBE
                    if (blockIdx.x == 0 && T0_()) TWORDS[1] += (__builtin_amdgcn_s_memtime() - TWORDS[2]) / 100ull;
#endif
                }
            }
#ifdef R9_PRE
            __syncthreads(); CLKE(9); TEND(9);
#endif
            GRID_BAR();
#ifndef R9_PRE
            CLKE(9); TEND(9);
#endif
            TSTART(10); CLKS(10);
            if (PH(10)) {
                PHASE_BEGIN
                rwkv_post_loop((const GAS bf16_t*)(ws + WS_YRAW), (const GAS bf16_t*)(ws + WS_VO), (const GAS bf16_t*)(ws + WS_LORA), Wb + W_G2T, (const GAS float*)(ws + WS_BONUS), INP(20) + (size_t)o * 1024, INP(21) + (size_t)o * 1024, (GAS bf16_t*)(ws + WS_YG), CD, F.gw, F.NGW, (CM / 16) * 16, F.lds + F.wave * 10240);
            }
            GRID_BAR();
            CLKE(10); TEND(10);
        }
        TSTART(11); CLKS(11);
        if (PH(11)) {
            PHASE_BEGIN
            const bool odd = (L & 1) != 0;
            pg8::ProbPlain<1024, 1024, 16> P{odd ? (const GAS bf16_t*)(ws + WS_YG) : (const GAS bf16_t*)U, Wb + (odd ? W_OUTO : W_OUTE)}; pg8::StaticOrder S; S.init(CM, CD, F.G, (int)blockIdx.x);
            pg8::EpiStore E{(GAS bf16_t*)(ws + WS_MIX), CD, 0, 0, 0, nullptr};
            pg8::gemm_phase(F.lds, F.wave, P, S, E);
        }
        GRID_BAR();
        CLKE(11); TEND(11);
        TSTART(12); CLKS(12);
        if (PH(12)) { PHASE_BEGIN const GAS float* ng = INP(1) + (size_t)L * 4 * 1024; RowPassArgs A{L == 0 ? INP(0) : HOUT, (const GAS bf16_t*)(ws + WS_MIX), ng + 1 * 1024, HOUT, U, ng + 2 * 1024, 0, nullptr, nullptr, nullptr}; row_pass<4>(F, A); }
        GRID_BAR();
        CLKE(12); TEND(12);
#ifdef CLK_PROBE2
        if (blockIdx.x == 0 && T0_()) TWORDS[2] = __builtin_amdgcn_s_memtime();
#endif
        TSTART(13); CLKS(13);
        if (PH(13)) {
            PHASE_BEGIN
            pg8::ProbPlain<1024, 1024, 16> P{U, Wb + W_UP}; pg8::StaticOrder S; S.init(CM, FF, F.G, (int)blockIdx.x);
            pg8::EpiStore E{(GAS bf16_t*)(ws + WS_HID), FF, 1, 0, 0, nullptr};
            pg8::gemm_phase(F.lds, F.wave, P, S, E);
        }
        GRID_BAR();
#ifdef CLK_PROBE2
        if (blockIdx.x == 0 && T0_()) TWORDS[1] += (__builtin_amdgcn_s_memtime() - TWORDS[2]) / 100ull;
#endif
        CLKE(13); TEND(13);
        TSTART(14); CLKS(14);
        if (PH(14)) {
            PHASE_BEGIN
            pg8::ProbPlain<FF, FF, 64> P{(const GAS bf16_t*)(ws + WS_HID), Wb + W_DN}; pg8::StaticOrder S; S.init(CM, CD, F.G, (int)blockIdx.x);
            pg8::EpiStore E{(GAS bf16_t*)(ws + WS_FFO), CD, 0, 0, 0, nullptr};
            pg8::gemm_phase(F.lds, F.wave, P, S, E);
        }
        GRID_BAR();
        CLKE(14); TEND(14);
        TSTART(15); CLKS(15);
        if (PH(15)) {
            PHASE_BEGIN
            const GAS float* ng = INP(1) + (size_t)L * 4 * 1024;
            const bool lastL = (L == 3); const bool next_even = ((L + 1) & 1) == 0;
            if (!lastL) { convert_layer(F, in, Wb, L + 1); }
            __syncthreads();
            const GAS float* ngn = INP(1) + (size_t)(L + 1) * 4 * 1024;
            const bool gts = !lastL && next_even;
            RowPassArgs A{HOUT, (const GAS bf16_t*)(ws + WS_FFO), ng + 3 * 1024, HOUT, lastL ? nullptr : U, lastL ? nullptr : ngn, next_even ? 0 : 1,
                          gts ? INP(2) + (size_t)((L + 1) >> 1) * 1024 * PITCH_WIN : nullptr, gts ? INP(3) + (size_t)((L + 1) >> 1) * 8 : nullptr, gts ? (GAS float*)(ws + WS_GATES) : nullptr};
            row_pass<2>(F, A);
        }
        if (L < 3) GRID_BAR();
        CLKE(15); TEND(15);
    }
#ifdef BAR_PROBE
    for (int i = 0; i < BAR_PROBE; ++i) GRID_BAR();
#endif
    if (PROBE_T != 0u && blockIdx.x == PROBE_BLK && T0_()) {
        const unsigned long long te = __builtin_amdgcn_s_memrealtime() + 4ull * TWORDS[1];
        while (__builtin_amdgcn_s_memrealtime() < te) __builtin_amdgcn_s_sleep(8);
    }
}

extern "C" void kernel_launch(void* const* d_in, const int* in_sizes, int n_in, void* d_out, int out_size, void* d_ws, size_t ws_size, hipStream_t stream) {
    static int grid = 0;
    if (grid == 0) {
        if (n_in != 25 || out_size != CM * CD || ws_size < WS_END) { fprintf(stderr, "kernel_launch: unexpected shapes (n_in %d, out %d, ws %zu)\n", n_in, out_size, ws_size); grid = -1; return; }
        int dev = 0, cus = 0, per_cu = 0;
        if (hipGetDevice(&dev) != hipSuccess || hipDeviceGetAttribute(&cus, hipDeviceAttributeMultiprocessorCount, dev) != hipSuccess) { grid = -1; return; }
        if (hipFuncSetAttribute((const void*)hybrid_fwd, hipFuncAttributeMaxDynamicSharedMemorySize, LDS_BYTES) != hipSuccess) { grid = -1; return; }
        if (hipOccupancyMaxActiveBlocksPerMultiprocessor(&per_cu, (const void*)hybrid_fwd, NWAVES * 64, LDS_BYTES) != hipSuccess || per_cu < 1) fprintf(stderr, "kernel_launch: occupancy query reports %d\n", per_cu);
        (void)hipGetLastError();
        grid = cus;
        if (grid != 256) fprintf(stderr, "kernel_launch: %d CUs (the phase deals assume 256)\n", grid);
    }
    if (grid < 0) return;
    if (hipMemsetAsync((char*)d_ws + WS_CTL, 0, CTL_ZERO_BYTES, stream) != hipSuccess) return;
    Args a{};
    for (int i = 0; i < 25; ++i) a.in.p[i] = (const float*)d_in[i];
    a.out = (float*)d_out; a.ws = (unsigned char*)d_ws;
    hipLaunchKernelGGL(hybrid_fwd, dim3(grid), dim3(NWAVES * 64), LDS_BYTES, stream, a);
}
```

```cpp
#include <hip/hip_runtime.h>
#include <cstdio>
#include <cstdint>
typedef short bf16x8 __attribute__((ext_vector_type(8)));
typedef short s16x4 __attribute__((ext_vector_type(4)));
typedef float f32x4 __attribute__((ext_vector_type(4)));
typedef float f32x16 __attribute__((ext_vector_type(16)));
typedef unsigned u32x4 __attribute__((ext_vector_type(4)));
typedef unsigned u32x2 __attribute__((ext_vector_type(2)));
#ifdef HOST_EMU
#define GQ
#define LDSQ
#define DI inline
DI int lane_id() { return emu_lane(); }
DI s16x4 TR16(const LDSQ void* p) { return emu_tr16(p); }
DI unsigned short f2bf(float f) { return (unsigned short)emu_f2bf(f); }
#define MEMFENCE() do {} while (0)
#define WAVE_SYNC() emu_sync()
#else
#define LDSQ __attribute__((address_space(3)))
#define GQ __attribute__((address_space(1)))
#define DI __device__ __forceinline__
typedef short v4i16_t __attribute__((ext_vector_type(4)));
typedef __bf16 bf16x2_t __attribute__((ext_vector_type(2)));
typedef float f32x2_t __attribute__((ext_vector_type(2)));
DI int lane_id() { int l = (int)__builtin_amdgcn_mbcnt_hi(~0u, __builtin_amdgcn_mbcnt_lo(~0u, 0u)); asm volatile("" : "+v"(l)); return l; }
DI s16x4 TR16(const LDSQ void* p) { return __builtin_bit_cast(s16x4, __builtin_amdgcn_ds_read_tr16_b64_v4i16((LDSQ v4i16_t*)p)); }
DI unsigned short f2bf(float f) { f32x2_t v = {f, 0.f}; bf16x2_t b = __builtin_convertvector(v, bf16x2_t); return (unsigned short)(__builtin_bit_cast(unsigned, b) & 0xffffu); }
#define MEMFENCE() asm volatile("" ::: "memory")
#define WAVE_SYNC() do {} while (0)
#endif
typedef unsigned short bf16_t;
#ifdef HOST_EMU
#define ROW_SHR(v, d) ((lane_id() & 15) >= (d) ? __shfl_up((v), (d), 16) : (__shfl_up((v), (d), 16), 0.f))
#else
#define ROW_SHR(v, d) __builtin_bit_cast(float, __builtin_amdgcn_update_dpp(0, __builtin_bit_cast(int, (v)), 0x110 + (d), 0xF, 0xF, true))
#endif
DI float bf2f(unsigned short s) { unsigned u = ((unsigned)s) << 16; return __builtin_bit_cast(float, u); }
DI unsigned pk2(float lo, float hi) {
#ifdef HOST_EMU
    return (unsigned)f2bf(lo) | ((unsigned)f2bf(hi) << 16);
#else
    f32x2_t v = {lo, hi}; bf16x2_t b = __builtin_convertvector(v, bf16x2_t); return __builtin_bit_cast(unsigned, b);
#endif
}
DI f32x4 mfma16(bf16x8 a, bf16x8 b, f32x4 c) { return __builtin_amdgcn_mfma_f32_16x16x32_bf16(a, b, c, 0, 0, 0); }
DI f32x16 mfma32(bf16x8 a, bf16x8 b, f32x16 c) { return __builtin_amdgcn_mfma_f32_32x32x16_bf16(a, b, c, 0, 0, 0); }
DI bf16x8 mk8(u32x2 lo, u32x2 hi) { u32x4 v = {lo.x, lo.y, hi.x, hi.y}; return __builtin_bit_cast(bf16x8, v); }
DI u32x2 pack4(f32x4 v) { u32x2 r = {pk2(v[0], v[1]), pk2(v[2], v[3])}; return r; }
DI u32x2 ld8(const GQ bf16_t* p) { return *(const GQ u32x2*)p; }
DI u32x4 ld16(const GQ bf16_t* p) { return *(const GQ u32x4*)p; }
DI u32x2 tr2(s16x4 v) { return __builtin_bit_cast(u32x2, v); }
DI u32x2 ldl8(const LDSQ unsigned char* p) { return *(const LDSQ u32x2*)p; }
DI float fexp(float x) { return __builtin_amdgcn_exp2f(x * 1.4426950408889634f); }
DI float flog(float x) { return __builtin_amdgcn_logf(x) * 0.6931471805599453f; }
DI float softplusf(float x) { return fmaxf(x, 0.f) + flog(1.0f + fexp(-fabsf(x))); }
DI float sigmoidf_(float x) { return __builtin_amdgcn_rcpf(1.0f + fexp(-x)); }
DI float tanhf_(float x) { const float xc = fminf(fmaxf(x, -15.f), 15.f); const float e = fexp(2.f * xc); return (e - 1.f) * __builtin_amdgcn_rcpf(e + 1.f); }

#define SB_STOP 36.0f
DI int crow32(int i, int h) { return (i & 3) + 8 * (i >> 2) + 4 * h; }
DI void sb_attn_unit(const GQ bf16_t* __restrict__ Q, const GQ bf16_t* __restrict__ K, int ldqk, const GQ bf16_t* __restrict__ VT, int S, GQ bf16_t* __restrict__ O, int ldo, int t0  ) {
    const int lane = lane_id(), r = lane & 31, hi = lane >> 5;
    bf16x8 qf[4];
#pragma unroll
    for (int s = 0; s < 4; ++s) qf[s] = __builtin_bit_cast(bf16x8, ld16(Q + (size_t)(t0 + r) * ldqk + 16 * s + 8 * hi));
    f32x16 o0, o1;
#pragma unroll
    for (int i = 0; i < 16; ++i) { o0[i] = 0.f; o1[i] = 0.f; }
    float carry = 0.f;
    const int tq = t0 + r;
    u32x4 kn[4]; u32x2 vn[8];
    int s0 = t0;
#define SB_LOAD(kd, vd, s0_) do { \
    _Pragma("unroll") for (int s = 0; s < 4; ++s) kd[s] = ld16(K + (size_t)((s0_) + r) * ldqk + 16 * s + 8 * hi); \
    _Pragma("unroll") for (int db = 0; db < 2; ++db) _Pragma("unroll") for (int s = 0; s < 2; ++s) { \
        const GQ bf16_t* vp = VT + (size_t)(32 * db + r) * S + (s0_) + 16 * s + 4 * hi; vd[(db * 2 + s) * 2] = ld8(vp); vd[(db * 2 + s) * 2 + 1] = ld8(vp + 8); } } while (0)
    SB_LOAD(kn, vn, s0);
    for (;;) {
        u32x4 kc[4]; u32x2 vc[8];
#pragma unroll
        for (int s = 0; s < 4; ++s) kc[s] = kn[s];
#pragma unroll
        for (int s = 0; s < 8; ++s) vc[s] = vn[s];
        const int sn = s0 - 32;
        if (sn >= 0) SB_LOAD(kn, vn, sn);
        f32x16 z;
#pragma unroll
        for (int i = 0; i < 16; ++i) z[i] = 0.f;
#pragma unroll
        for (int s = 0; s < 4; ++s) z = mfma32(__builtin_bit_cast(bf16x8, kc[s]), qf[s], z);
        float sp[16];
        const bool diag = (s0 == t0);
#pragma unroll
        for (int i = 0; i < 16; ++i) { z[i] *= 0.125f; const bool valid = !diag || (s0 + crow32(i, hi) < tq); sp[i] = valid ? softplusf(z[i]) : 0.f; if (!valid) z[i] = -1e30f; }
        float gs[4], pg[4];
#pragma unroll
        for (int g = 0; g < 4; ++g) gs[g] = (sp[4 * g] + sp[4 * g + 1]) + (sp[4 * g + 2] + sp[4 * g + 3]);
#pragma unroll
        for (int g = 0; g < 4; ++g) pg[g] = __shfl_xor(gs[g], 32);
        float after[4];
        {
            const float o3 = 0.f, o2 = gs[3], o1_ = gs[3] + gs[2], o0_ = o1_ + gs[1];
            const float p3i = pg[3], p2i = pg[3] + pg[2], p1i = p2i + pg[1], p0i = p1i + pg[0];
            const float pe3 = 0.f, pe2 = p3i, pe1 = p2i, pe0 = p1i;
            after[0] = o0_ + (hi ? pe0 : p0i); after[1] = o1_ + (hi ? pe1 : p1i); after[2] = o2 + (hi ? pe2 : p2i); after[3] = o3 + (hi ? pe3 : p3i);
        }
        const float tot = (gs[0] + gs[1]) + (gs[2] + gs[3]) + (pg[0] + pg[1]) + (pg[2] + pg[3]);
        f32x16 p;
#pragma unroll
        for (int g = 0; g < 4; ++g) {
            float c = carry + after[g];
#pragma unroll
            for (int j = 3; j >= 0; --j) { c += sp[4 * g + j]; p[4 * g + j] = fexp(z[4 * g + j] - c); }
        }
        carry += tot;
#pragma unroll
        for (int s = 0; s < 2; ++s) {
            u32x4 pb = {pk2(p[8 * s], p[8 * s + 1]), pk2(p[8 * s + 2], p[8 * s + 3]), pk2(p[8 * s + 4], p[8 * s + 5]), pk2(p[8 * s + 6], p[8 * s + 7])};
            const bf16x8 pbv = __builtin_bit_cast(bf16x8, pb);
            o0 = mfma32(mk8(vc[(0 * 2 + s) * 2], vc[(0 * 2 + s) * 2 + 1]), pbv, o0);
            o1 = mfma32(mk8(vc[(1 * 2 + s) * 2], vc[(1 * 2 + s) * 2 + 1]), pbv, o1);
        }
        if (sn < 0) break;
        if (__all(carry > SB_STOP)) break;
        s0 = sn;
    }
#undef SB_LOAD
#pragma unroll
    for (int g = 0; g < 4; ++g) {
        u32x2 w0 = {pk2(o0[4 * g], o0[4 * g + 1]), pk2(o0[4 * g + 2], o0[4 * g + 3])};
        u32x2 w1 = {pk2(o1[4 * g], o1[4 * g + 1]), pk2(o1[4 * g + 2], o1[4 * g + 3])};
        GQ bf16_t* op = O + (size_t)(t0 + r) * ldo + 8 * g + 4 * hi;
        *(GQ u32x2*)op = w0; *(GQ u32x2*)(op + 32) = w1;
    }
}

DI void mlstm_stream(const GQ bf16_t* __restrict__ Qp, const GQ bf16_t* __restrict__ Kp, int ldqk, const GQ bf16_t* __restrict__ Vp, int ldv, const GQ float* __restrict__ G, int gi, int gf,
                     int S, int den, GQ bf16_t* __restrict__ NUM, int ldn, GQ float* __restrict__ DEN, GQ float* __restrict__ EMT, int ldd, LDSQ unsigned char* lds) {
    const int lane = lane_id(), fr = lane & 15, fq = lane >> 4;
    LDSQ unsigned char* Kimg = lds;
    LDSQ unsigned char* Vimg = lds + 4096;
    f32x4 C[8];
#pragma unroll
    for (int ci = 0; ci < 8; ++ci) C[ci] = (f32x4){0.f, 0.f, 0.f, 0.f};
    float Fcarry = 0.f, Mcarry = 0.f;
    const int NC = S / 16;
    u32x2 qn[8], kn[8]; u32x4 vn = {0u, 0u, 0u, 0u}; float lin, lfn;
#define ML_LOAD(c_) do { const size_t row = (size_t)(16 * (c_) + fr); \
    _Pragma("unroll") for (int ks = 0; ks < 4; ++ks) { qn[2 * ks] = ld8(Qp + row * ldqk + 32 * ks + 4 * fq); qn[2 * ks + 1] = ld8(Qp + row * ldqk + 32 * ks + 16 + 4 * fq); \
        kn[2 * ks] = ld8(Kp + row * ldqk + 32 * ks + 4 * fq); kn[2 * ks + 1] = ld8(Kp + row * ldqk + 32 * ks + 16 + 4 * fq); } \
    if (!den && lane < 32) vn = ld16(Vp + (size_t)(16 * (c_) + (lane >> 1)) * ldv + 8 * (lane & 1)); \
    lin = G[row * 8 + gi]; lfn = G[row * 8 + gf]; } while (0)
    ML_LOAD(0);
    for (int c = 0; c < NC; ++c) {
        u32x2 qc[8], kc[8]; u32x4 vcur = vn; const float li = lin, lf = lfn;
#pragma unroll
        for (int i = 0; i < 8; ++i) { qc[i] = qn[i]; kc[i] = kn[i]; }
        if (c + 1 < NC) ML_LOAD(c + 1);
        MEMFENCE();
#pragma unroll
        for (int ks = 0; ks < 4; ++ks) { *(LDSQ u32x2*)(Kimg + fr * 256 + (32 * ks + 4 * fq) * 2) = kc[2 * ks]; *(LDSQ u32x2*)(Kimg + fr * 256 + (32 * ks + 16 + 4 * fq) * 2) = kc[2 * ks + 1]; }
        if (den) { if (lane < 32) { u32x4 e0 = {(lane & 1) ? 0u : 0x3F80u, 0u, 0u, 0u}; *(LDSQ u32x4*)(Vimg + (lane >> 1) * 32 + (lane & 1) * 16) = e0; } }
        else { if (lane < 32) *(LDSQ u32x4*)(Vimg + (lane >> 1) * 32 + (lane & 1) * 16) = vcur; }
        MEMFENCE();
        float inc = lf;
#pragma unroll
        for (int d = 1; d < 16; d <<= 1) { const float t = __shfl_up(inc, d, 16); if (fr >= d) inc += t; }
        const float Fg = Fcarry + inc, a = li - Fg;
        float mx = a;
#pragma unroll
        for (int d = 1; d < 16; d <<= 1) { const float t = __shfl_up(mx, d, 16); if (fr >= d) mx = fmaxf(mx, t); }
        const float Mx = fmaxf(Mcarry, mx);
        const float Mend = __shfl(Mx, 15, 16), Ftot = __shfl(inc, 15, 16);
        float as_[4], Mxs[4], Fgs[4];
#pragma unroll
        for (int i = 0; i < 4; ++i) { as_[i] = __shfl(a, 4 * fq + i, 16); Mxs[i] = __shfl(Mx, 4 * fq + i, 16); Fgs[i] = __shfl(Fg, 4 * fq + i, 16); }
        f32x4 st = {0.f, 0.f, 0.f, 0.f};
#pragma unroll
        for (int ks = 0; ks < 4; ++ks) st = mfma16(mk8(kc[2 * ks], kc[2 * ks + 1]), mk8(qc[2 * ks], qc[2 * ks + 1]), st);
        f32x4 pt;
#pragma unroll
        for (int i = 0; i < 4; ++i) pt[i] = (4 * fq + i <= fr) ? st[i] * fexp(as_[i] - Mx) : 0.f;
        const s16x4 v4 = TR16(Vimg + (4 * fq + (fr >> 2)) * 32 + 8 * (fr & 3));
        const u32x2 z2 = {0u, 0u};
        f32x4 numI = mfma16(mk8(pack4(pt), z2), mk8(tr2(v4), z2), (f32x4){0.f, 0.f, 0.f, 0.f});
        f32x4 inter = {0.f, 0.f, 0.f, 0.f};
#pragma unroll
        for (int ks = 0; ks < 4; ++ks) inter = mfma16(mk8(qc[2 * ks], qc[2 * ks + 1]), mk8(pack4(C[2 * ks]), pack4(C[2 * ks + 1])), inter);
        f32x4 num;
#pragma unroll
        for (int i = 0; i < 4; ++i) num[i] = numI[i] + fexp(Mcarry - Mxs[i]) * inter[i];
        if (den) {
            if (fr == 0) {
#pragma unroll
                for (int i = 0; i < 4; ++i) { const size_t row = (size_t)(16 * c + 4 * fq + i); DEN[row * ldd] = num[i]; EMT[row * ldd] = fexp(-(Fgs[i] + Mxs[i])); }
            }
        } else {
#pragma unroll
            for (int i = 0; i < 4; ++i) NUM[(size_t)(16 * c + 4 * fq + i) * ldn + fr] = f2bf(num[i]);
        }
        const float wstate = fexp(Mcarry - Mend);
        f32x4 vw;
#pragma unroll
        for (int i = 0; i < 4; ++i) vw[i] = bf2f((unsigned short)v4[i]) * fexp(as_[i] - Mend);
        const bf16x8 vwb = mk8(pack4(vw), z2);
#pragma unroll
        for (int ci = 0; ci < 8; ++ci) {
            const s16x4 k4 = TR16(Kimg + (4 * fq + (fr >> 2)) * 256 + (16 * ci + 4 * (fr & 3)) * 2);
            C[ci] = mfma16(mk8(tr2(k4), z2), vwb, C[ci] * wstate);
        }
        Mcarry = Mend; Fcarry += Ftot;
        MEMFENCE();
    }
#undef ML_LOAD
}

struct RwkvPrepArgs {
    const GQ bf16_t *R, *K; int ld;
    const GQ bf16_t* LORA; int ldl;
    const GQ bf16_t *W2T, *A2T;
    const GQ float *w0, *a0, *k_k, *k_a, *r_k;
    GQ bf16_t *KT, *BT, *KK, *RT;
    GQ float* GL;
    GQ float* BONUS;
};
struct RwkvPrepIn { u32x4 lw[2], la[2]; u32x2 r2[4], k2[4]; };
DI void rwkv_prep_load(const RwkvPrepArgs& P, int chunk, int h, RwkvPrepIn& I) {
    const int lane = lane_id(), fr = lane & 15, fq = lane >> 4;
    const size_t row = (size_t)chunk * 16 + fr;
#pragma unroll
    for (int s = 0; s < 2; ++s) { I.lw[s] = ld16(P.LORA + row * P.ldl + 32 * s + 8 * fq); I.la[s] = ld16(P.LORA + row * P.ldl + 64 + 32 * s + 8 * fq); }
#pragma unroll
    for (int ti = 0; ti < 4; ++ti) { const int ch0 = 64 * h + 16 * ti + 4 * fq; I.r2[ti] = ld8(P.R + row * P.ld + ch0); I.k2[ti] = ld8(P.K + row * P.ld + ch0); }
}
DI void rwkv_prep_compute(const RwkvPrepArgs& P, int chunk, int h, const RwkvPrepIn& I) {
    const int lane = lane_id(), fr = lane & 15, fq = lane >> 4;
    const size_t row = (size_t)chunk * 16 + fr;
    bf16x8 bw[2], ba[2];
#pragma unroll
    for (int s = 0; s < 2; ++s) {
        u32x4 t;
#pragma unroll
        for (int j = 0; j < 4; ++j) { const unsigned w = I.lw[s][j]; t[j] = pk2(tanhf_(bf2f((unsigned short)(w & 0xffffu))), tanhf_(bf2f((unsigned short)(w >> 16)))); }
        bw[s] = __builtin_bit_cast(bf16x8, t);
        ba[s] = __builtin_bit_cast(bf16x8, I.la[s]);
    }
    float ss = 0.f, bon = 0.f;
    float kap[16], av[16], kp[16], rv[16], ld_[16];
#pragma unroll
    for (int ti = 0; ti < 4; ++ti) {
        const int chl = 16 * ti + fr;
        f32x4 dw = {0.f, 0.f, 0.f, 0.f}, da = {0.f, 0.f, 0.f, 0.f};
#pragma unroll
        for (int s = 0; s < 2; ++s) {
            dw = mfma16(__builtin_bit_cast(bf16x8, ld16(P.W2T + (size_t)(64 * h + chl) * 64 + 32 * s + 8 * fq)), bw[s], dw);
            da = mfma16(__builtin_bit_cast(bf16x8, ld16(P.A2T + (size_t)(64 * h + chl) * 64 + 32 * s + 8 * fq)), ba[s], da);
        }
        const int ch0 = 64 * h + 16 * ti + 4 * fq;
        const u32x2 r2 = I.r2[ti], k2 = I.k2[ti];
        const f32x4 w0v = *(const GQ f32x4*)(P.w0 + ch0), a0v = *(const GQ f32x4*)(P.a0 + ch0), kkv = *(const GQ f32x4*)(P.k_k + ch0), kav = *(const GQ f32x4*)(P.k_a + ch0), rkv = *(const GQ f32x4*)(P.r_k + ch0);
#pragma unroll
        for (int i = 0; i < 4; ++i) {
            const int e = 4 * ti + i;
            const float r = bf2f((unsigned short)((i & 1) ? (r2[i >> 1] >> 16) : (r2[i >> 1] & 0xffffu)));
            const float k = bf2f((unsigned short)((i & 1) ? (k2[i >> 1] >> 16) : (k2[i >> 1] & 0xffffu)));
            const float wl = w0v[i] + dw[i];
            const float logw = -softplusf(-wl) - 0.5f;
            ld_[e] = -fexp(logw);
            const float a = sigmoidf_(a0v[i] + da[i]);
            const float kkr = k * kkv[i];
            ss += kkr * kkr;
            const float k1 = k * (1.0f + (a - 1.0f) * kav[i]);
            bon += r * k1 * rkv[i];
            kap[e] = kkr; av[e] = a; kp[e] = k1; rv[e] = r;
        }
    }
    ss += __shfl_xor(ss, 16); ss += __shfl_xor(ss, 32);
    bon += __shfl_xor(bon, 16); bon += __shfl_xor(bon, 32);
    const float rn = __builtin_amdgcn_rsqf(fmaxf(ss, 1e-24f));
    if (fq == 0) P.BONUS[row * 16 + h] = bon;
#pragma unroll
    for (int ti = 0; ti < 4; ++ti) {
        const int ch0 = 64 * h + 16 * ti + 4 * fq;
        f32x4 okt, obt, okk, ort, ogl;
#pragma unroll
        for (int i = 0; i < 4; ++i) {
            const int e = 4 * ti + i;
            float cs = ld_[e];
            cs += ROW_SHR(cs, 1); cs += ROW_SHR(cs, 2); cs += ROW_SHR(cs, 4); cs += ROW_SHR(cs, 8);
            const float gi = fexp(cs), ginv = __builtin_amdgcn_rcpf(gi);
            float gx = ROW_SHR(gi, 1); if (fr == 0) gx = 1.0f;
            const float kappa = kap[e] * rn;
            okt[i] = kappa * gx; obt[i] = kappa * av[e] * ginv; okk[i] = kp[e] * ginv; ort[i] = rv[e] * gi; ogl[i] = gi;
        }
        *(GQ u32x2*)(P.KT + row * P.ld + ch0) = pack4(okt);
        *(GQ u32x2*)(P.BT + row * P.ld + ch0) = pack4(obt);
        *(GQ u32x2*)(P.KK + row * P.ld + ch0) = pack4(okk);
        *(GQ u32x2*)(P.RT + row * P.ld + ch0) = pack4(ort);
        if (fr == 15) *(GQ f32x4*)(P.GL + (size_t)chunk * 1024 + ch0) = ogl;
    }
}
DI void rwkv_prep_unit(const RwkvPrepArgs& P, int chunk, int h) { RwkvPrepIn I; rwkv_prep_load(P, chunk, h, I); rwkv_prep_compute(P, chunk, h, I); }
constexpr int RPP = 144, RPT = 16 * RPP, RPL = 272, RP_R = 0, RP_K = RPT, RP_L = 2 * RPT, RP_BYTES = 4 * RPT;
DI void rwkv_prep_loop(const RwkvPrepArgs& P, int first, int stride, int nunits, LDSQ unsigned char* scr) {
    if (first >= nunits) return;
    const int lane = lane_id(), fr = lane & 15, fq = lane >> 4, h = first & 15;
    const int lrow = lane >> 3, lpc = lane & 7, qrow = lane >> 4, qpc = lane & 15;
    bf16x8 wA[4][2], aA[4][2];
#pragma unroll
    for (int ti = 0; ti < 4; ++ti)
#pragma unroll
        for (int s = 0; s < 2; ++s) { wA[ti][s] = __builtin_bit_cast(bf16x8, ld16(P.W2T + (size_t)(64 * h + 16 * ti + fr) * 64 + 32 * s + 8 * fq)); aA[ti][s] = __builtin_bit_cast(bf16x8, ld16(P.A2T + (size_t)(64 * h + 16 * ti + fr) * 64 + 32 * s + 8 * fq)); }
    LDSQ float* vec = (LDSQ float*)(scr + RP_BYTES);
    vec[0 * 64 + lane] = P.w0[64 * h + lane]; vec[1 * 64 + lane] = P.a0[64 * h + lane]; vec[2 * 64 + lane] = P.k_k[64 * h + lane]; vec[3 * 64 + lane] = P.k_a[64 * h + lane]; vec[4 * 64 + lane] = P.r_k[64 * h + lane];
    MEMFENCE(); WAVE_SYNC();
    u32x4 tr_[2], tk_[2], tl_[4];
#define RP_LOAD(u_) do { const size_t r0_ = (size_t)((u_) >> 4) * 16; \
    _Pragma("unroll") for (int hf = 0; hf < 2; ++hf) { tr_[hf] = ld16(P.R + (r0_ + 8 * hf + lrow) * P.ld + 64 * h + 8 * lpc); tk_[hf] = ld16(P.K + (r0_ + 8 * hf + lrow) * P.ld + 64 * h + 8 * lpc); } \
    _Pragma("unroll") for (int g = 0; g < 4; ++g) tl_[g] = ld16(P.LORA + (r0_ + 4 * g + qrow) * P.ldl + 8 * qpc); } while (0)
#define RP_PARK() do { MEMFENCE(); \
    _Pragma("unroll") for (int hf = 0; hf < 2; ++hf) { *(LDSQ u32x4*)(scr + RP_R + (8 * hf + lrow) * RPP + lpc * 16) = tr_[hf]; *(LDSQ u32x4*)(scr + RP_K + (8 * hf + lrow) * RPP + lpc * 16) = tk_[hf]; } \
    _Pragma("unroll") for (int g = 0; g < 4; ++g) *(LDSQ u32x4*)(scr + RP_L + (4 * g + qrow) * RPL + qpc * 16) = tl_[g]; MEMFENCE(); WAVE_SYNC(); } while (0)
    RP_LOAD(first); RP_PARK();
    for (int u = first; u < nunits; u += stride) {
        const int chunk = u >> 4;
        const size_t row = (size_t)chunk * 16 + fr;
        if (u + stride < nunits) RP_LOAD(u + stride);
        bf16x8 bw[2], ba[2];
#pragma unroll
        for (int s = 0; s < 2; ++s) {
            bw[s] = __builtin_bit_cast(bf16x8, *(const LDSQ u32x4*)(scr + RP_L + fr * RPL + (32 * s + 8 * fq) * 2));
            ba[s] = __builtin_bit_cast(bf16x8, *(const LDSQ u32x4*)(scr + RP_L + fr * RPL + (64 + 32 * s + 8 * fq) * 2));
        }
        u32x2 r2a[4], k2a[4];
#pragma unroll
        for (int ti = 0; ti < 4; ++ti) { r2a[ti] = ldl8(scr + RP_R + fr * RPP + (16 * ti + 4 * fq) * 2); k2a[ti] = ldl8(scr + RP_K + fr * RPP + (16 * ti + 4 * fq) * 2); }
        MEMFENCE(); WAVE_SYNC();
        float ss = 0.f, bon = 0.f;
#pragma unroll
        for (int ti = 0; ti < 4; ++ti) {
            const f32x4 kkv = *(const LDSQ f32x4*)(vec + 128 + 16 * ti + 4 * fq); const u32x2 k2 = k2a[ti];
#pragma unroll
            for (int i = 0; i < 4; ++i) { const float kkr = bf2f((unsigned short)((i & 1) ? (k2[i >> 1] >> 16) : (k2[i >> 1] & 0xffffu))) * kkv[i]; ss += kkr * kkr; }
        }
        ss += __shfl_xor(ss, 16); ss += __shfl_xor(ss, 32);
        const float rn = __builtin_amdgcn_rsqf(fmaxf(ss, 1e-24f));
#pragma unroll
        for (int ti = 0; ti < 4; ++ti) {
            f32x4 dw = {0.f, 0.f, 0.f, 0.f}, da = {0.f, 0.f, 0.f, 0.f};
#pragma unroll
            for (int s = 0; s < 2; ++s) { dw = mfma16(wA[ti][s], bw[s], dw); da = mfma16(aA[ti][s], ba[s], da); }
            const u32x2 r2 = r2a[ti], k2 = k2a[ti];
            const int cl0 = 16 * ti + 4 * fq;
            const f32x4 w0v = *(const LDSQ f32x4*)(vec + cl0), a0v = *(const LDSQ f32x4*)(vec + 64 + cl0), kkv = *(const LDSQ f32x4*)(vec + 128 + cl0), kav = *(const LDSQ f32x4*)(vec + 192 + cl0), rkv = *(const LDSQ f32x4*)(vec + 256 + cl0);
            f32x4 okt, obt, okk, ort, ogl;
#pragma unroll
            for (int i = 0; i < 4; ++i) {
                const float r = bf2f((unsigned short)((i & 1) ? (r2[i >> 1] >> 16) : (r2[i >> 1] & 0xffffu)));
                const float k = bf2f((unsigned short)((i & 1) ? (k2[i >> 1] >> 16) : (k2[i >> 1] & 0xffffu)));
                const float ld = -0.6065306597126334f * sigmoidf_(w0v[i] + dw[i]);
                const float a = sigmoidf_(a0v[i] + da[i]);
                const float kappa = k * kkv[i] * rn;
                const float k1 = k * (1.0f + (a - 1.0f) * kav[i]);
                bon += r * k1 * rkv[i];
                float cs = ld;
                cs += ROW_SHR(cs, 1); cs += ROW_SHR(cs, 2); cs += ROW_SHR(cs, 4); cs += ROW_SHR(cs, 8);
                const float gi = fexp(cs), ginv = __builtin_amdgcn_rcpf(gi);
                float gx = ROW_SHR(gi, 1); if (fr == 0) gx = 1.0f;
                okt[i] = kappa * gx; obt[i] = kappa * a * ginv; okk[i] = k1 * ginv; ort[i] = r * gi; ogl[i] = gi;
            }
            const int o = fr * RPP + (16 * ti + 4 * fq) * 2;
            *(LDSQ u32x2*)(scr + 0 * RPT + o) = pack4(okt); *(LDSQ u32x2*)(scr + 1 * RPT + o) = pack4(obt); *(LDSQ u32x2*)(scr + 2 * RPT + o) = pack4(okk); *(LDSQ u32x2*)(scr + 3 * RPT + o) = pack4(ort);
            if (fr == 15) *(GQ f32x4*)(P.GL + (size_t)chunk * 1024 + 64 * h + 16 * ti + 4 * fq) = ogl;
            MEMFENCE();
        }
        bon += __shfl_xor(bon, 16); bon += __shfl_xor(bon, 32);
        if (fq == 0) P.BONUS[row * 16 + h] = bon;
        MEMFENCE(); WAVE_SYNC();
#pragma unroll
        for (int hf = 0; hf < 2; ++hf) {
            const size_t go = ((size_t)chunk * 16 + 8 * hf + lrow) * P.ld + 64 * h + 8 * lpc; const int lo = (8 * hf + lrow) * RPP + lpc * 16;
            *(GQ u32x4*)(P.KT + go) = *(const LDSQ u32x4*)(scr + 0 * RPT + lo); *(GQ u32x4*)(P.BT + go) = *(const LDSQ u32x4*)(scr + 1 * RPT + lo);
            *(GQ u32x4*)(P.KK + go) = *(const LDSQ u32x4*)(scr + 2 * RPT + lo); *(GQ u32x4*)(P.RT + go) = *(const LDSQ u32x4*)(scr + 3 * RPT + lo);
        }
        MEMFENCE(); WAVE_SYNC();
        if (u + stride < nunits) RP_PARK();
    }
#undef RP_LOAD
#undef RP_PARK
}

DI void rwkv_post_loop(const GQ bf16_t* __restrict__ YRAW, const GQ bf16_t* __restrict__ V, const GQ bf16_t* __restrict__ LORA, const GQ bf16_t* __restrict__ G2T, const GQ float* __restrict__ BONUS,
                       const GQ float* __restrict__ ln_g, const GQ float* __restrict__ ln_b, GQ bf16_t* __restrict__ YG, int ld, int first, int stride, int nunits, LDSQ unsigned char* scr) {
    if (first >= nunits) return;
    const int lane = lane_id(), fr = lane & 15, fq = lane >> 4, h = first & 15;
    const int lrow = lane >> 3, lpc = lane & 7, qrow = lane >> 4, qpc = lane & 15;
    bf16x8 gA[4][4];
#pragma unroll
    for (int ti = 0; ti < 4; ++ti)
#pragma unroll
        for (int s = 0; s < 4; ++s) gA[ti][s] = __builtin_bit_cast(bf16x8, ld16(G2T + (size_t)(64 * h + 16 * ti + fr) * 128 + 32 * s + 8 * fq));
    LDSQ float* vec = (LDSQ float*)(scr + RP_BYTES);
    vec[lane] = ln_g[64 * h + lane]; vec[64 + lane] = ln_b[64 * h + lane];
    MEMFENCE(); WAVE_SYNC();
    u32x4 ty_[2], tv_[2], tl_[4]; float bonn = 0.f;
#define PO_LOAD(u_) do { const size_t r0_ = (size_t)((u_) >> 4) * 16; \
    _Pragma("unroll") for (int hf = 0; hf < 2; ++hf) { ty_[hf] = ld16(YRAW + (r0_ + 8 * hf + lrow) * ld + 64 * h + 8 * lpc); tv_[hf] = ld16(V + (r0_ + 8 * hf + lrow) * ld + 64 * h + 8 * lpc); } \
    _Pragma("unroll") for (int g = 0; g < 4; ++g) tl_[g] = ld16(LORA + (r0_ + 4 * g + qrow) * 256 + 128 + 8 * qpc); \
    bonn = BONUS[(r0_ + fr) * 16 + h]; } while (0)
#define PO_PARK() do { MEMFENCE(); \
    _Pragma("unroll") for (int hf = 0; hf < 2; ++hf) { *(LDSQ u32x4*)(scr + RP_R + (8 * hf + lrow) * RPP + lpc * 16) = ty_[hf]; *(LDSQ u32x4*)(scr + RP_K + (8 * hf + lrow) * RPP + lpc * 16) = tv_[hf]; } \
    _Pragma("unroll") for (int g = 0; g < 4; ++g) *(LDSQ u32x4*)(scr + RP_L + (4 * g + qrow) * RPL + qpc * 16) = tl_[g]; MEMFENCE(); WAVE_SYNC(); } while (0)
    PO_LOAD(first); PO_PARK();
    for (int u = first; u < nunits; u += stride) {
        const int chunk = u >> 4;
        const float bon = bonn;
        if (u + stride < nunits) PO_LOAD(u + stride);
        bf16x8 bg[4];
#pragma unroll
        for (int s = 0; s < 4; ++s) bg[s] = __builtin_bit_cast(bf16x8, *(const LDSQ u32x4*)(scr + RP_L + fr * RPL + (32 * s + 8 * fq) * 2));
        u32x2 y2a[4], v2a[4];
#pragma unroll
        for (int ti = 0; ti < 4; ++ti) { y2a[ti] = ldl8(scr + RP_R + fr * RPP + (16 * ti + 4 * fq) * 2); v2a[ti] = ldl8(scr + RP_K + fr * RPP + (16 * ti + 4 * fq) * 2); }
        MEMFENCE(); WAVE_SYNC();
        float yv[16], gt[16]; float sm = 0.f;
#pragma unroll
        for (int ti = 0; ti < 4; ++ti) {
            f32x4 g = {0.f, 0.f, 0.f, 0.f};
#pragma unroll
            for (int s = 0; s < 4; ++s) g = mfma16(gA[ti][s], bg[s], g);
            const u32x2 y2 = y2a[ti];
            yv[4 * ti] = bf2f((unsigned short)(y2.x & 0xffffu)); yv[4 * ti + 1] = bf2f((unsigned short)(y2.x >> 16)); yv[4 * ti + 2] = bf2f((unsigned short)(y2.y & 0xffffu)); yv[4 * ti + 3] = bf2f((unsigned short)(y2.y >> 16));
#pragma unroll
            for (int i = 0; i < 4; ++i) { gt[4 * ti + i] = g[i]; sm += yv[4 * ti + i]; }
        }
        sm += __shfl_xor(sm, 16); sm += __shfl_xor(sm, 32);
        const float mean = sm * (1.0f / 64.0f); float vs = 0.f;
#pragma unroll
        for (int e2 = 0; e2 < 16; ++e2) { const float d = yv[e2] - mean; vs += d * d; }
        vs += __shfl_xor(vs, 16); vs += __shfl_xor(vs, 32);
        const float rstd = __builtin_amdgcn_rsqf(vs * (1.0f / 64.0f) + 64e-5f);
#pragma unroll
        for (int ti = 0; ti < 4; ++ti) {
            const int ch0 = 64 * h + 16 * ti + 4 * fq;
            const f32x4 lg = *(const LDSQ f32x4*)(vec + 16 * ti + 4 * fq), lb = *(const LDSQ f32x4*)(vec + 64 + 16 * ti + 4 * fq);
            const u32x2 v2 = v2a[ti];
            const float vv[4] = {bf2f((unsigned short)(v2.x & 0xffffu)), bf2f((unsigned short)(v2.x >> 16)), bf2f((unsigned short)(v2.y & 0xffffu)), bf2f((unsigned short)(v2.y >> 16))};
            f32x4 o;
#pragma unroll
            for (int i = 0; i < 4; ++i) o[i] = ((yv[4 * ti + i] - mean) * rstd * lg[i] + lb[i] + bon * vv[i]) * gt[4 * ti + i];
            *(LDSQ u32x2*)(scr + fr * RPP + (16 * ti + 4 * fq) * 2) = pack4(o);
        }
        MEMFENCE(); WAVE_SYNC();
#pragma unroll
        for (int hf = 0; hf < 2; ++hf) *(GQ u32x4*)(YG + ((size_t)chunk * 16 + 8 * hf + lrow) * ld + 64 * h + 8 * lpc) = *(const LDSQ u32x4*)(scr + (8 * hf + lrow) * RPP + lpc * 16);
        MEMFENCE(); WAVE_SYNC();
        if (u + stride < nunits) PO_PARK();
    }
#undef PO_LOAD
#undef PO_PARK
}

DI bf16x8 pk_lo(f32x4 v) { const u32x2 z2 = {0u, 0u}; return mk8(pack4(v), z2); }
DI f32x4 mm16(f32x4 accPT, f32x4 accQ) { return mfma16(pk_lo(accPT), pk_lo(accQ), (f32x4){0.f, 0.f, 0.f, 0.f}); }
DI void rwkv_scan_stream(const GQ bf16_t* __restrict__ KT, const GQ bf16_t* __restrict__ BT, const GQ bf16_t* __restrict__ KK, const GQ bf16_t* __restrict__ RT, const GQ bf16_t* __restrict__ V, int ld,
                         const GQ float* __restrict__ GL, int S, GQ bf16_t* __restrict__ Y, int ldy, LDSQ unsigned char* lds) {
    const int lane = lane_id(), fr = lane & 15, fq = lane >> 4;
    LDSQ unsigned char* BTimg = lds;
    LDSQ unsigned char* KKimg = lds + 2048;
    LDSQ unsigned char* Vimg = lds + 4096;
    f32x4 H[4];
#pragma unroll
    for (int ci = 0; ci < 4; ++ci) H[ci] = (f32x4){0.f, 0.f, 0.f, 0.f};
    const int NC = S / 16;
    u32x2 ktn[4], btn[4], kkn[4], rtn[4]; u32x4 vn = {0u, 0u, 0u, 0u}; f32x4 gln[4];
#define RW_LOAD(c_) do { const size_t row = (size_t)(16 * (c_) + fr); \
    _Pragma("unroll") for (int s = 0; s < 2; ++s) _Pragma("unroll") for (int q = 0; q < 2; ++q) { const size_t o = row * ld + 32 * s + 16 * q + 4 * fq; \
        ktn[2 * s + q] = ld8(KT + o); btn[2 * s + q] = ld8(BT + o); kkn[2 * s + q] = ld8(KK + o); rtn[2 * s + q] = ld8(RT + o); } \
    if (lane < 32) vn = ld16(V + (size_t)(16 * (c_) + (lane >> 1)) * ld + 8 * (lane & 1)); \
    _Pragma("unroll") for (int ci = 0; ci < 4; ++ci) gln[ci] = *(const GQ f32x4*)(GL + (size_t)(c_) * 1024 + 16 * ci + 4 * fq); } while (0)
    RW_LOAD(0);
    const bool dg[4] = {4 * fq + 0 == fr, 4 * fq + 1 == fr, 4 * fq + 2 == fr, 4 * fq + 3 == fr};
    for (int c = 0; c < NC; ++c) {
        u32x2 kt[4], bt[4], kk[4], rt[4]; const u32x4 vcur = vn; f32x4 gl[4];
#pragma unroll
        for (int i = 0; i < 4; ++i) { kt[i] = ktn[i]; bt[i] = btn[i]; kk[i] = kkn[i]; rt[i] = rtn[i]; gl[i] = gln[i]; }
        if (c + 1 < NC) RW_LOAD(c + 1);
        MEMFENCE();
#pragma unroll
        for (int s = 0; s < 2; ++s)
#pragma unroll
            for (int q = 0; q < 2; ++q) { const int off = fr * 128 + (32 * s + 16 * q + 4 * fq) * 2; *(LDSQ u32x2*)(BTimg + off) = bt[2 * s + q]; *(LDSQ u32x2*)(KKimg + off) = kk[2 * s + q]; }
        if (lane < 32) *(LDSQ u32x4*)(Vimg + (lane >> 1) * 32 + (lane & 1) * 16) = vcur;
        MEMFENCE();
        const f32x4 z4 = {0.f, 0.f, 0.f, 0.f};
        f32x4 x1 = z4, x2 = z4, akt = z4, arbt = z4, arkt = z4;
#pragma unroll
        for (int s = 0; s < 2; ++s) {
            const bf16x8 fkt = mk8(kt[2 * s], kt[2 * s + 1]), fbt = mk8(bt[2 * s], bt[2 * s + 1]), fkk = mk8(kk[2 * s], kk[2 * s + 1]), frt = mk8(rt[2 * s], rt[2 * s + 1]);
            x1 = mfma16(fbt, fkt, x1);
            x2 = mfma16(fkt, fbt, x2);
            akt = mfma16(fkk, fkt, akt);
            arbt = mfma16(fbt, frt, arbt);
            arkt = mfma16(fkk, frt, arkt);
        }
        f32x4 yT, y_;
#pragma unroll
        for (int i = 0; i < 4; ++i) {
            const int rr = 4 * fq + i;
            yT[i] = (rr < fr) ? -x1[i] : 0.f;
            y_[i] = (fr < rr) ? -x2[i] : 0.f;
            akt[i] = (rr < fr) ? akt[i] : 0.f;
            arbt[i] = (rr <= fr) ? arbt[i] : 0.f;
            arkt[i] = (rr <= fr) ? arkt[i] : 0.f;
        }
#define IA(x) ((f32x4){(x)[0] + (dg[0] ? 1.f : 0.f), (x)[1] + (dg[1] ? 1.f : 0.f), (x)[2] + (dg[2] ? 1.f : 0.f), (x)[3] + (dg[3] ? 1.f : 0.f)})
        const f32x4 y2 = mm16(yT, y_), y2T = mm16(y_, yT);
        const f32x4 y4 = mm16(y2T, y2), y4T = mm16(y2, y2T);
        const f32x4 y8T = mm16(y4, y4T);
        const f32x4 w1 = mm16(IA(y_), IA(y2T)), w1T = mm16(IA(yT), IA(y2));
        const f32x4 w2 = mm16(w1T, IA(y4T)), w2T = mm16(w1, IA(y4));
        const f32x4 tT = mm16(w2T, IA(y8T));
#undef IA
        const bf16x8 hb0 = mk8(pack4(H[0]), pack4(H[1])), hb1 = mk8(pack4(H[2]), pack4(H[3]));
        const s16x4 v4 = TR16(Vimg + (4 * fq + (fr >> 2)) * 32 + 8 * (fr & 3));
        const u32x2 z2 = {0u, 0u};
        f32x4 g = mfma16(mk8(kt[0], kt[1]), hb0, z4);
        g = mfma16(mk8(kt[2], kt[3]), hb1, g);
        g = mfma16(pk_lo(akt), mk8(tr2(v4), z2), g);
        const f32x4 tg = mfma16(pk_lo(tT), pk_lo(g), z4);
        const f32x4 u = -tg;
        f32x4 yo = mfma16(mk8(rt[0], rt[1]), hb0, z4);
        yo = mfma16(mk8(rt[2], rt[3]), hb1, yo);
        const bf16x8 uv = mk8(pack4(u), tr2(v4));
        yo = mfma16(mk8(pack4(arbt), pack4(arkt)), uv, yo);
#pragma unroll
        for (int i = 0; i < 4; ++i) Y[(size_t)(16 * c + 4 * fq + i) * ldy + fr] = f2bf(yo[i]);
#pragma unroll
        for (int ci = 0; ci < 4; ++ci) {
            const int off = (4 * fq + (fr >> 2)) * 128 + (16 * ci + 4 * (fr & 3)) * 2;
            const s16x4 b4 = TR16(BTimg + off), k4 = TR16(KKimg + off);
            H[ci] = mfma16(mk8(tr2(b4), tr2(k4)), uv, H[ci]) * gl[ci];
        }
        MEMFENCE();
    }
#undef RW_LOAD
}

#ifdef HOST_EMU
DI unsigned flag_ld(const LDSQ unsigned* p) { return __atomic_load_n(p, __ATOMIC_ACQUIRE); }
DI void flag_st(LDSQ unsigned* p, unsigned v) { emu_sync(); __atomic_store_n(p, v, __ATOMIC_RELEASE); }
DI void spin_pause() { std::this_thread::yield(); }
#else
DI unsigned flag_ld(const LDSQ unsigned* p) { unsigned v; asm volatile("ds_read_b32 %0, %1\n\ts_waitcnt lgkmcnt(0)" : "=v"(v) : "v"((unsigned)(size_t)p) : "memory"); return v; }
DI void flag_st(LDSQ unsigned* p, unsigned v) { asm volatile("ds_write_b32 %0, %1" :: "v"((unsigned)(size_t)p), "v"(v) : "memory"); }
DI void spin_pause() { asm volatile("s_nop 7"); }
#endif
#define COOP_SPIN_CAP (1u << 24)
#if defined(COOP_PROBE) && !defined(HOST_EMU)
DI void wait_ge_t(const LDSQ unsigned* p, unsigned want, LDSQ unsigned* acc) { const unsigned long long t0 = __builtin_amdgcn_s_memrealtime(); unsigned n = 0; while (flag_ld(p) < want) { spin_pause(); if (++n > COOP_SPIN_CAP) break; } MEMFENCE();
    const unsigned dt = (unsigned)(__builtin_amdgcn_s_memrealtime() - t0); if (lane_id() == 0) *acc += dt; }
#else
#define wait_ge_t(p, want, acc) wait_ge(p, want)
#endif
DI void wait_ge(const LDSQ unsigned* p, unsigned want) { unsigned n = 0; while (flag_ld(p) < want) { spin_pause(); if (++n > COOP_SPIN_CAP) break; } MEMFENCE(); }

#if defined(SEG_PROBE) && !defined(HOST_EMU)
#define SEG_STAMP(i) do { if (wave == 0) { const unsigned now_ = (unsigned)__builtin_amdgcn_s_memrealtime(); if (lane == 0) ready[40 + (i)] += now_ - seg_last_; seg_last_ = now_; } } while (0)
#else
#define SEG_STAMP(i) do {} while (0)
#endif
constexpr int RWP = 144, RWTS = 16 * RWP;
constexpr int RWT_KT = 0, RWT_BT = RWTS, RWT_KK = 2 * RWTS, RWT_RT = 3 * RWTS, RWT_V = 4 * RWTS, RWT_GL = 5 * RWTS, RWT_TT = RWT_GL + 256, RWT_AK = RWT_TT + 512, RWT_ARB = RWT_AK + 512, RWT_Y = RWT_ARB + 1024;
constexpr int RWS_SLOT = RWT_Y + RWTS, RWS_NSLOT = 8, RWS_FLAGS = RWS_SLOT * RWS_NSLOT, RWS_LDS = RWS_FLAGS + 256;
DI void rwkv_scan_coop(int wave, const GQ bf16_t* __restrict__ KT, const GQ bf16_t* __restrict__ BT, const GQ bf16_t* __restrict__ KK, const GQ bf16_t* __restrict__ RT, const GQ bf16_t* __restrict__ V, int ld,
                       const GQ float* __restrict__ GL, int S, GQ bf16_t* __restrict__ Y, int ldy, LDSQ unsigned char* lds) {
    const int lane = lane_id(), fr = lane & 15, fq = lane >> 4;
    const int NC = S / 16;
    LDSQ unsigned* ready = (LDSQ unsigned*)(lds + RWS_FLAGS);
    LDSQ unsigned* done = ready + 16;
    const u32x2 z2 = {0u, 0u};
    const f32x4 z4 = {0.f, 0.f, 0.f, 0.f};
    if (wave < 4) {
#ifndef HOST_EMU
        __builtin_amdgcn_s_setprio(3);
#endif
        f32x4 H[4];
#pragma unroll
        for (int ci = 0; ci < 4; ++ci) H[ci] = z4;
        for (int c = 0; c < NC; ++c) {
            LDSQ unsigned char* slot = lds + (c & (RWS_NSLOT - 1)) * RWS_SLOT;
            wait_ge_t(ready + (c & (RWS_NSLOT - 1)), (unsigned)c + 1u, ready + 32 + wave);
            u32x2 kt[4], rt[4];
#pragma unroll
            for (int s = 0; s < 2; ++s)
#pragma unroll
                for (int q = 0; q < 2; ++q) { const int o = fr * RWP + (32 * s + 16 * q + 4 * fq) * 2; kt[2 * s + q] = ldl8(slot + RWT_KT + o); rt[2 * s + q] = ldl8(slot + RWT_RT + o); }
            const u32x2 tT = ldl8(slot + RWT_TT + lane * 8), ak = ldl8(slot + RWT_AK + lane * 8);
            const u32x4 arbk = *(const LDSQ u32x4*)(slot + RWT_ARB + lane * 16);
            f32x4 gl[4];
#pragma unroll
            for (int ci = 0; ci < 4; ++ci) gl[ci] = *(const LDSQ f32x4*)(slot + RWT_GL + (16 * ci + 4 * fq) * 4);
            const s16x4 v4 = TR16(slot + RWT_V + (4 * fq + (fr >> 2)) * RWP + (16 * wave + 4 * (fr & 3)) * 2);
            s16x4 b4[4], k4[4];
#pragma unroll
            for (int ci = 0; ci < 4; ++ci) { const int off = (4 * fq + (fr >> 2)) * RWP + (16 * ci + 4 * (fr & 3)) * 2; b4[ci] = TR16(slot + RWT_BT + off); k4[ci] = TR16(slot + RWT_KK + off); }
            const bf16x8 hb0 = mk8(pack4(H[0]), pack4(H[1])), hb1 = mk8(pack4(H[2]), pack4(H[3]));
            f32x4 g = mfma16(mk8(kt[0], kt[1]), hb0, z4);
            g = mfma16(mk8(kt[2], kt[3]), hb1, g);
            g = mfma16(mk8(ak, z2), mk8(tr2(v4), z2), g);
            const f32x4 tg = mfma16(mk8(tT, z2), pk_lo(g), z4);
            const f32x4 u = -tg;
            f32x4 yo = mfma16(mk8(rt[0], rt[1]), hb0, z4);
            yo = mfma16(mk8(rt[2], rt[3]), hb1, yo);
            const bf16x8 uv = mk8(pack4(u), tr2(v4));
            yo = mfma16(__builtin_bit_cast(bf16x8, arbk), uv, yo);
#pragma unroll
            for (int i = 0; i < 4; ++i) *(LDSQ unsigned short*)(slot + RWT_Y + (4 * fq + i) * RWP + (16 * wave + fr) * 2) = f2bf(yo[i]);
#pragma unroll
            for (int ci = 0; ci < 4; ++ci) H[ci] = mfma16(mk8(tr2(b4[ci]), tr2(k4[ci])), uv, H[ci]) * gl[ci];
            flag_st(done + wave, (unsigned)c + 1u);
        }
    } else {
#ifndef HOST_EMU
        __builtin_amdgcn_s_setprio(0);
#endif
        const int p = wave - 4;
        const int lrow = lane >> 3, lpc = lane & 7;
        u32x4 tn[5][2]; float gln = 0.f;
#define RWP_LOAD(c_) do { _Pragma("unroll") for (int hf = 0; hf < 2; ++hf) { const size_t o = (size_t)(16 * (c_) + 8 * hf + lrow) * ld + 8 * lpc; \
        tn[0][hf] = ld16(KT + o); tn[1][hf] = ld16(BT + o); tn[2][hf] = ld16(KK + o); tn[3][hf] = ld16(RT + o); tn[4][hf] = ld16(V + o); } \
    gln = GL[(size_t)(c_) * 1024 + lane]; } while (0)
#define RWP_FLUSH(cc_) do { const u32x4 y0 = *(const LDSQ u32x4*)(slot + RWT_Y + lrow * RWP + lpc * 16), y1 = *(const LDSQ u32x4*)(slot + RWT_Y + (8 + lrow) * RWP + lpc * 16); \
    *(GQ u32x4*)(Y + (size_t)(16 * (cc_) + lrow) * ldy + 8 * lpc) = y0; *(GQ u32x4*)(Y + (size_t)(16 * (cc_) + 8 + lrow) * ldy + 8 * lpc) = y1; MEMFENCE(); } while (0)
        const bool dg[4] = {4 * fq + 0 == fr, 4 * fq + 1 == fr, 4 * fq + 2 == fr, 4 * fq + 3 == fr};
#define RWP_PARK(cc_) do { LDSQ unsigned char* ps_ = lds + ((cc_) & (RWS_NSLOT - 1)) * RWS_SLOT; \
        if ((cc_) >= RWS_NSLOT) { const unsigned want_ = (unsigned)((cc_) - RWS_NSLOT + 1); wait_ge(done + 0, want_); wait_ge(done + 1, want_); wait_ge(done + 2, want_); wait_ge(done + 3, want_); \
            { LDSQ unsigned char* slot = ps_; RWP_FLUSH((cc_) - RWS_NSLOT); } } \
        MEMFENCE(); \
        _Pragma("unroll") for (int a = 0; a < 5; ++a) _Pragma("unroll") for (int hf = 0; hf < 2; ++hf) *(LDSQ u32x4*)(ps_ + a * RWTS + (8 * hf + lrow) * RWP + lpc * 16) = tn[a][hf]; \
        *(LDSQ float*)(ps_ + RWT_GL + lane * 4) = gln; MEMFENCE(); WAVE_SYNC(); } while (0)
        if (p < NC) { RWP_LOAD(p); RWP_PARK(p); }
        for (int c = p; c < NC; c += 4) {
            if (c + 4 < NC) RWP_LOAD(c + 4);
            LDSQ unsigned char* slot = lds + (c & (RWS_NSLOT - 1)) * RWS_SLOT;
            u32x2 kt[4], bt[4], kk[4], rt[4];
#pragma unroll
            for (int s = 0; s < 2; ++s)
#pragma unroll
                for (int q = 0; q < 2; ++q) { const int o = fr * RWP + (32 * s + 16 * q + 4 * fq) * 2;
                    kt[2 * s + q] = ldl8(slot + RWT_KT + o); bt[2 * s + q] = ldl8(slot + RWT_BT + o); kk[2 * s + q] = ldl8(slot + RWT_KK + o); rt[2 * s + q] = ldl8(slot + RWT_RT + o); }
            f32x4 x1 = z4, x2 = z4, akt = z4, arbt = z4, arkt = z4;
#pragma unroll
            for (int s = 0; s < 2; ++s) {
                const bf16x8 fkt = mk8(kt[2 * s], kt[2 * s + 1]), fbt = mk8(bt[2 * s], bt[2 * s + 1]), fkk = mk8(kk[2 * s], kk[2 * s + 1]), frt = mk8(rt[2 * s], rt[2 * s + 1]);
                x1 = mfma16(fbt, fkt, x1); x2 = mfma16(fkt, fbt, x2); akt = mfma16(fkk, fkt, akt); arbt = mfma16(fbt, frt, arbt); arkt = mfma16(fkk, frt, arkt);
            }
            f32x4 yT, y_;
#pragma unroll
            for (int i = 0; i < 4; ++i) {
                const int rr = 4 * fq + i;
                yT[i] = (rr < fr) ? -x1[i] : 0.f; y_[i] = (fr < rr) ? -x2[i] : 0.f;
                akt[i] = (rr < fr) ? akt[i] : 0.f; arbt[i] = (rr <= fr) ? arbt[i] : 0.f; arkt[i] = (rr <= fr) ? arkt[i] : 0.f;
            }
#define IA(x) ((f32x4){(x)[0] + (dg[0] ? 1.f : 0.f), (x)[1] + (dg[1] ? 1.f : 0.f), (x)[2] + (dg[2] ? 1.f : 0.f), (x)[3] + (dg[3] ? 1.f : 0.f)})
            const f32x4 y2 = mm16(yT, y_), y2T = mm16(y_, yT);
            const f32x4 y4 = mm16(y2T, y2), y4T = mm16(y2, y2T);
            const f32x4 y8T = mm16(y4, y4T);
            const f32x4 w1 = mm16(IA(y_), IA(y2T)), w1T = mm16(IA(yT), IA(y2));
            const f32x4 w2 = mm16(w1T, IA(y4T)), w2T = mm16(w1, IA(y4));
            const f32x4 tT = mm16(w2T, IA(y8T));
#undef IA
            *(LDSQ u32x2*)(slot + RWT_TT + lane * 8) = pack4(tT);
            *(LDSQ u32x2*)(slot + RWT_AK + lane * 8) = pack4(akt);
            { const u32x2 a = pack4(arbt), b = pack4(arkt); *(LDSQ u32x4*)(slot + RWT_ARB + lane * 16) = (u32x4){a.x, a.y, b.x, b.y}; }
            flag_st(ready + (c & (RWS_NSLOT - 1)), (unsigned)c + 1u);
            if (c + 4 < NC) RWP_PARK(c + 4);
        }
#undef RWP_PARK
        for (int c = NC - RWS_NSLOT; c < NC; ++c) if (c >= 0 && (c & 3) == p) {
            LDSQ unsigned char* slot = lds + (c & (RWS_NSLOT - 1)) * RWS_SLOT; const unsigned want = (unsigned)c + 1u;
            wait_ge(done + 0, want); wait_ge(done + 1, want); wait_ge(done + 2, want); wait_ge(done + 3, want);
            RWP_FLUSH(c);
        }
#undef RWP_FLUSH
#undef RWP_LOAD
    }
}

DI void mlstm_gate_scan(const GQ float* __restrict__ G, int gi, int gf, int S, GQ float* __restrict__ SC_A, GQ float* __restrict__ SC_M, GQ float* __restrict__ SC_E) {
    const int lane = lane_id(), TPL = S / 64, t0 = lane * TPL;
    float tot = 0.f;
    for (int i = 0; i < TPL; ++i) tot += G[(size_t)(t0 + i) * 8 + gf];
    float inc = tot;
#pragma unroll
    for (int d = 1; d < 64; d <<= 1) { const float t = __shfl_up(inc, d, 64); if (lane >= d) inc += t; }
    const float Fbase = inc - tot;
    float run = Fbase, lmax = -3.0e38f;
    for (int i = 0; i < TPL; ++i) { run += G[(size_t)(t0 + i) * 8 + gf]; const float a = G[(size_t)(t0 + i) * 8 + gi] - run; SC_A[t0 + i] = a; lmax = fmaxf(lmax, a); }
    float mi = lmax;
#pragma unroll
    for (int d = 1; d < 64; d <<= 1) { const float t = __shfl_up(mi, d, 64); if (lane >= d) mi = fmaxf(mi, t); }
    float mprev = __shfl_up(mi, 1, 64); if (lane == 0) mprev = 0.f;
    float M = fmaxf(mprev, 0.f); run = Fbase;
    for (int i = 0; i < TPL; ++i) { run += G[(size_t)(t0 + i) * 8 + gf]; const float a = G[(size_t)(t0 + i) * 8 + gi] - run; M = fmaxf(M, a); SC_M[t0 + i] = M; SC_E[t0 + i] = fexp(-(run + M)); }
}


#ifdef HOST_EMU
#define WG_SYNC() emu_syncthreads()
#else
#define WG_SYNC() __syncthreads()
#endif
DI void mlstm_gate_scan_wg(int wave, const GQ float* __restrict__ G, int gi, int gf, int S, GQ float* __restrict__ SC_A, GQ float* __restrict__ SC_M, GQ float* __restrict__ SC_E, LDSQ float* red) {
    const int lane = lane_id(), TPW = S / 8, NG = TPW / 64, t0 = wave * TPW;
    float F[8], A[8];
    float run = 0.f;
    for (int g = 0; g < NG; ++g) {
        const size_t t = (size_t)(t0 + 64 * g + lane);
        float inc = G[t * 8 + gf]; A[g] = G[t * 8 + gi];
#pragma unroll
        for (int d = 1; d < 64; d <<= 1) { const float x = __shfl_up(inc, d, 64); if (lane >= d) inc += x; }
        F[g] = run + inc; run += __shfl(inc, 63, 64);
    }
    if (lane == 0) red[wave] = run;
    MEMFENCE(); WG_SYNC();
    float base = 0.f;
    for (int w = 0; w < wave; ++w) base += red[w];
    float mrun = -3.0e38f;
    for (int g = 0; g < NG; ++g) {
        F[g] += base; const float a = A[g] - F[g]; A[g] = a;
        SC_A[t0 + 64 * g + lane] = a;
        float mx = a;
#pragma unroll
        for (int d = 1; d < 64; d <<= 1) { const float x = __shfl_up(mx, d, 64); if (lane >= d) mx = fmaxf(mx, x); }
        const float gm = __shfl(mx, 63, 64);
        mx = fmaxf(mx, mrun); mrun = fmaxf(mrun, gm);
        A[g] = mx;
    }
    if (lane == 0) red[8 + wave] = mrun;
    MEMFENCE(); WG_SYNC();
    float mb = 0.f;
    for (int w = 0; w < wave; ++w) mb = fmaxf(mb, red[8 + w]);
    for (int g = 0; g < NG; ++g) { const float M = fmaxf(A[g], mb); SC_M[t0 + 64 * g + lane] = M; SC_E[t0 + 64 * g + lane] = fexp(-(F[g] + M)); }
}
constexpr int MLKP = 288;
constexpr int MLS_SLOT = 9472, MLS_NSLOT = 6, MLS_FLAGS = MLS_SLOT * MLS_NSLOT, MLS_VIMG = MLS_FLAGS + 256, MLS_LDS = MLS_VIMG + 4 * 1024;
DI void mlstm_coop(int wave, const GQ bf16_t* __restrict__ Qp, const GQ bf16_t* __restrict__ Kp, int ldqk, const GQ bf16_t* __restrict__ Vp, int ldv, const GQ float* __restrict__ SC_A, const GQ float* __restrict__ SC_M,
                   int S, GQ bf16_t* __restrict__ NUM, int ldn, GQ float* __restrict__ DEN, int ldd, LDSQ unsigned char* lds) {
    const int lane = lane_id(), fr = lane & 15, fq = lane >> 4;
    const int NC = S / 16;
    LDSQ unsigned* ready = (LDSQ unsigned*)(lds + MLS_FLAGS);
    LDSQ unsigned* done = ready + 16;
    const u32x2 z2 = {0u, 0u};
    const f32x4 z4 = {0.f, 0.f, 0.f, 0.f};
    if (wave < 5) {
        const bool isden = (wave == 4);
        LDSQ unsigned char* Vimg = lds + MLS_VIMG + (wave & 3) * 1024;
        f32x4 C[8][2];
#pragma unroll
        for (int ci = 0; ci < 8; ++ci) { C[ci][0] = z4; C[ci][1] = z4; }
        u32x4 vn = {0u, 0u, 0u, 0u};
#define MLC_LOAD(c_) do { if (!isden) vn = ld16(Vp + (size_t)(16 * (c_) + (lane >> 2)) * ldv + 32 * wave + 8 * (lane & 3)); } while (0)
        MLC_LOAD(0);
        for (int c = 0; c < NC; ++c) {
            const u32x4 vcur = vn;
            if (c + 1 < NC) MLC_LOAD(c + 1);
            MEMFENCE();
            if (!isden) *(LDSQ u32x4*)(Vimg + (lane >> 2) * 64 + (lane & 3) * 16) = vcur;
            MEMFENCE();
            const int sl = c % MLS_NSLOT;
            LDSQ unsigned char* slot = lds + sl * MLS_SLOT;
            wait_ge_t(ready + sl, (unsigned)c + 1u, ready + 32 + wave);
            const u32x2 pf = *(const LDSQ u32x2*)(slot + 4608 + lane * 8);
            u32x2 qc[8];
#pragma unroll
            for (int i = 0; i < 8; ++i) qc[i] = *(const LDSQ u32x2*)(slot + 5376 + i * 512 + lane * 8);
            const f32x4 wi = *(const LDSQ f32x4*)(slot + 5120 + fq * 16), wt = *(const LDSQ f32x4*)(slot + 5184 + fq * 16), rs4 = *(const LDSQ f32x4*)(slot + 5248 + fq * 16);
            const float wst = *(const LDSQ float*)(slot + 5312);
            s16x4 k4[8];
#pragma unroll
            for (int ci = 0; ci < 8; ++ci) k4[ci] = TR16(slot + (4 * fq + (fr >> 2)) * MLKP + (16 * ci + 4 * (fr & 3)) * 2);
            if (!isden) {
                bf16x8 vwb[2];
#pragma unroll
                for (int j = 0; j < 2; ++j) {
                    const s16x4 v4 = TR16(Vimg + (4 * fq + (fr >> 2)) * 64 + 32 * j + 8 * (fr & 3));
                    const f32x4 numI = mfma16(mk8(pf, z2), mk8(tr2(v4), z2), z4);
                    f32x4 inter = z4;
#pragma unroll
                    for (int ks = 0; ks < 4; ++ks) inter = mfma16(mk8(qc[2 * ks], qc[2 * ks + 1]), mk8(pack4(C[2 * ks][j]), pack4(C[2 * ks + 1][j])), inter);
#pragma unroll
                    for (int i = 0; i < 4; ++i) NUM[(size_t)(16 * c + 4 * fq + i) * ldn + 32 * wave + 16 * j + fr] = f2bf(numI[i] + wi[i] * inter[i]);
                    f32x4 vw;
#pragma unroll
                    for (int i = 0; i < 4; ++i) vw[i] = bf2f((unsigned short)v4[i]) * wt[i];
                    vwb[j] = mk8(pack4(vw), z2);
                }
#pragma unroll
                for (int ci = 0; ci < 8; ++ci) { const bf16x8 ka = mk8(tr2(k4[ci]), z2); C[ci][0] = mfma16(ka, vwb[0], C[ci][0] * wst); C[ci][1] = mfma16(ka, vwb[1], C[ci][1] * wst); }
            } else {
                f32x4 inter = z4;
#pragma unroll
                for (int ks = 0; ks < 4; ++ks) inter = mfma16(mk8(qc[2 * ks], qc[2 * ks + 1]), mk8(pack4(C[2 * ks][0]), pack4(C[2 * ks + 1][0])), inter);
                if (fr == 0) {
#pragma unroll
                    for (int i = 0; i < 4; ++i) DEN[(size_t)(16 * c + 4 * fq + i) * ldd] = rs4[i] + wi[i] * inter[i];
                }
                f32x4 vw;
#pragma unroll
                for (int i = 0; i < 4; ++i) vw[i] = (fr == 0) ? wt[i] : 0.f;
                const bf16x8 vwb = mk8(pack4(vw), z2);
#pragma unroll
                for (int ci = 0; ci < 8; ++ci) C[ci][0] = mfma16(mk8(tr2(k4[ci]), z2), vwb, C[ci][0] * wst);
            }
            flag_st(done + wave, (unsigned)c + 1u);
        }
#undef MLC_LOAD
    } else {
        const int p = wave - 5;
        u32x2 qn[8], kn[8]; float an = 0.f, mn = 0.f, mcn = 0.f;
#define MLP_LOAD(c_) do { const size_t row = (size_t)(16 * (c_) + fr); \
    _Pragma("unroll") for (int ks = 0; ks < 4; ++ks) { qn[2 * ks] = ld8(Qp + row * ldqk + 32 * ks + 4 * fq); qn[2 * ks + 1] = ld8(Qp + row * ldqk + 32 * ks + 16 + 4 * fq); \
        kn[2 * ks] = ld8(Kp + row * ldqk + 32 * ks + 4 * fq); kn[2 * ks + 1] = ld8(Kp + row * ldqk + 32 * ks + 16 + 4 * fq); } \
    an = SC_A[row]; mn = SC_M[row]; mcn = ((c_) > 0) ? SC_M[16 * (c_) - 1] : 0.f; } while (0)
        if (p < NC) MLP_LOAD(p);
        for (int c = p; c < NC; c += 3) {
            u32x2 qc[8], kc[8]; const float a = an, Mx = mn, Mcarry = mcn;
#pragma unroll
            for (int i = 0; i < 8; ++i) { qc[i] = qn[i]; kc[i] = kn[i]; }
            if (c + 3 < NC) MLP_LOAD(c + 3);
            const float Mend = __shfl(Mx, 15, 16);
            float as_[4];
#pragma unroll
            for (int i = 0; i < 4; ++i) as_[i] = __shfl(a, 4 * fq + i, 16);
            f32x4 st = z4;
#pragma unroll
            for (int ks = 0; ks < 4; ++ks) st = mfma16(mk8(kc[2 * ks], kc[2 * ks + 1]), mk8(qc[2 * ks], qc[2 * ks + 1]), st);
            f32x4 pt;
#pragma unroll
            for (int i = 0; i < 4; ++i) pt[i] = (4 * fq + i <= fr) ? st[i] * fexp(as_[i] - Mx) : 0.f;
            float rs = (pt[0] + pt[1]) + (pt[2] + pt[3]);
            rs += __shfl_xor(rs, 16); rs += __shfl_xor(rs, 32);
            const int sl = c % MLS_NSLOT;
            if (c >= MLS_NSLOT) { const unsigned want = (unsigned)(c - MLS_NSLOT + 1); wait_ge_t(done + 0, want, ready + 32 + wave); wait_ge(done + 1, want); wait_ge(done + 2, want); wait_ge(done + 3, want); wait_ge(done + 4, want); }
            LDSQ unsigned char* slot = lds + sl * MLS_SLOT;
            MEMFENCE();
#pragma unroll
            for (int ks = 0; ks < 4; ++ks) { *(LDSQ u32x2*)(slot + fr * MLKP + (32 * ks + 4 * fq) * 2) = kc[2 * ks]; *(LDSQ u32x2*)(slot + fr * MLKP + (32 * ks + 16 + 4 * fq) * 2) = kc[2 * ks + 1]; }
            *(LDSQ u32x2*)(slot + 4608 + lane * 8) = pack4(pt);
#pragma unroll
            for (int i = 0; i < 8; ++i) *(LDSQ u32x2*)(slot + 5376 + i * 512 + lane * 8) = qc[i];
            if (fq == 0) { *(LDSQ float*)(slot + 5120 + fr * 4) = fexp(Mcarry - Mx); *(LDSQ float*)(slot + 5184 + fr * 4) = fexp(a - Mend); *(LDSQ float*)(slot + 5248 + fr * 4) = rs; }
            if (lane == 0) *(LDSQ float*)(slot + 5312) = fexp(Mcarry - Mend);
            flag_st(ready + sl, (unsigned)c + 1u);
        }
#undef MLP_LOAD
    }
}

constexpr int M3P = 288, M3T = 32 * M3P;
constexpr int M3_K = 0, M3_Q = M3T, M3_V = 2 * M3T, M3_P = 3 * M3T, M3_WI = M3_P + 2048, M3_WT = M3_WI + 128, M3_RS = M3_WT + 128, M3_A = M3_RS + 128, M3_MX = M3_A + 128, M3_WS = M3_MX + 128;
constexpr int M3_SLOT = M3_P + 2048 + 1024;
template <int NJ, int NCONS, int ABL = 0> DI void mlstm_coop32(int wave, int cbase  , bool with_den, const GQ bf16_t* __restrict__ Qp, const GQ bf16_t* __restrict__ Kp, int ldqk, const GQ bf16_t* __restrict__ Vp, int ldv, const GQ float* __restrict__ SC_A, const GQ float* __restrict__ SC_M,
                     int S, GQ bf16_t* __restrict__ NUM, int ldn, GQ float* __restrict__ DEN, int ldd, LDSQ unsigned char* lds, LDSQ unsigned* flags) {
    constexpr int NTP = (16 * NJ * NCONS == 128) ? 272 : 144, M3_NT = M3_SLOT, M3_DN = M3_NT + 32 * NTP, M3_SLOTX = M3_DN + 128, M3_NSLOT = 3;
    const int lane = lane_id(), fr = lane & 15, fq = lane >> 4;
    const int NC = S / 32;
    LDSQ unsigned* ready = flags;
    LDSQ unsigned* done = flags + 16;
    LDSQ unsigned* flushed = flags + 24;
    const int lrow = lane >> 4, lpc = lane & 15;
#define M3_FLUSH(sp_, cc_) do { MEMFENCE(); \
        if (16 * NJ * NCONS == 128) { _Pragma("unroll") for (int g = 0; g < 8; ++g) { const int r_ = 4 * g + lrow; \
            *(GQ u32x4*)(NUM + (size_t)(32 * (cc_) + r_) * ldn + cbase + 8 * lpc) = *(const LDSQ u32x4*)((sp_) + M3_NT + r_ * NTP + lpc * 16); } } \
        else { _Pragma("unroll") for (int g = 0; g < 4; ++g) { const int r_ = 8 * g + (lane >> 3), pc_ = lane & 7; \
            *(GQ u32x4*)(NUM + (size_t)(32 * (cc_) + r_) * ldn + cbase + 8 * pc_) = *(const LDSQ u32x4*)((sp_) + M3_NT + r_ * NTP + pc_ * 16); } } \
        if (with_den && lane < 32) DEN[(size_t)(32 * (cc_) + lane) * ldd] = *(const LDSQ float*)((sp_) + M3_DN + lane * 4); \
        MEMFENCE(); } while (0)
    const u32x2 z2 = {0u, 0u};
    const f32x4 z4 = {0.f, 0.f, 0.f, 0.f};
    if (wave < 5) {
        if (wave >= NCONS && wave != 4) return;
        const bool isden = (wave == 4);
        f32x4 C[8][NJ];
#pragma unroll
        for (int ci = 0; ci < 8; ++ci)
#pragma unroll
            for (int j = 0; j < NJ; ++j) C[ci][j] = z4;
        const int cw = cbase + 16 * NJ * wave;
        for (int c = 0; c < NC; ++c) {
            const int sl = c % M3_NSLOT;
            LDSQ unsigned char* slot = lds + sl * M3_SLOTX;
            wait_ge_t(ready + sl, (unsigned)c + 1u, flags + 32 + wave);
            const float wst = *(const LDSQ float*)(slot + M3_WS);
            f32x4 wi[2], wt[2];
#pragma unroll
            for (int h = 0; h < 2; ++h) { wi[h] = *(const LDSQ f32x4*)(slot + M3_WI + (16 * h + 4 * fq) * 4); wt[h] = *(const LDSQ f32x4*)(slot + M3_WT + (16 * h + 4 * fq) * 4); }
#define M3_QF(tt_, ks_) mk8(ldl8(slot + M3_Q + (16 * (tt_) + fr) * M3P + (32 * (ks_) + 4 * fq) * 2), ldl8(slot + M3_Q + (16 * (tt_) + fr) * M3P + (32 * (ks_) + 4 * fq) * 2 + 32))
            if (isden && !with_den) { flag_st(done + wave, (unsigned)c + 1u); continue; }
            if (!isden) {
                const u32x4 pf0 = *(const LDSQ u32x4*)(slot + M3_P + lane * 16), pf1 = *(const LDSQ u32x4*)(slot + M3_P + 1024 + lane * 16);
                bf16x8 vwb[NJ];
#pragma unroll
                for (int j = 0; j < NJ; ++j) {
                    const int vo = (4 * fq + (fr >> 2)) * M3P + (cw + 16 * j + 4 * (fr & 3)) * 2;
                    s16x4 v0 = {0, 0, 0, 0}, v1 = {0, 0, 0, 0}; if (!(ABL & 4)) { v0 = TR16(slot + M3_V + vo); v1 = TR16(slot + M3_V + 16 * M3P + vo); }
                    const bf16x8 vb = mk8(tr2(v0), tr2(v1));
                    bf16x8 cb[4];
#pragma unroll
                    for (int ks = 0; ks < 4; ++ks) cb[ks] = mk8(pack4(C[2 * ks][j]), pack4(C[2 * ks + 1][j]));
#pragma unroll
                    for (int tt = 0; tt < 2; ++tt) {
                        f32x4 numI = z4; if (!(ABL & 4)) numI = mfma16(__builtin_bit_cast(bf16x8, tt ? pf1 : pf0), vb, z4);
                        f32x4 inter = z4;
                        if (!(ABL & 2)) {
#pragma unroll
                        for (int ks = 0; ks < 4; ++ks) inter = mfma16(M3_QF(tt, ks), cb[ks], inter); }
#pragma unroll
                        for (int i = 0; i < 4; ++i) *(LDSQ unsigned short*)(slot + M3_NT + (16 * tt + 4 * fq + i) * NTP + (16 * NJ * wave + 16 * j + fr) * 2) = f2bf(numI[i] + wi[tt][i] * inter[i]);
                    }
                    f32x4 w0, w1;
#pragma unroll
                    for (int i = 0; i < 4; ++i) { w0[i] = bf2f((unsigned short)v0[i]) * wt[0][i]; w1[i] = bf2f((unsigned short)v1[i]) * wt[1][i]; }
                    vwb[j] = mk8(pack4(w0), pack4(w1));
                }
#pragma unroll
                for (int ci = 0; ci < ((ABL & 1) ? 0 : 8); ++ci) {
                    const int ko = (4 * fq + (fr >> 2)) * M3P + (16 * ci + 4 * (fr & 3)) * 2;
                    const bf16x8 ka = mk8(tr2(TR16(slot + M3_K + ko)), tr2(TR16(slot + M3_K + 16 * M3P + ko)));
#pragma unroll
                    for (int j = 0; j < NJ; ++j) {
                        C[ci][j] *= wst;
#ifndef HOST_EMU
                        asm volatile("" : "+v"(C[ci][j]));
#endif
                        C[ci][j] = mfma16(ka, vwb[j], C[ci][j]); }
                }
                flag_st(done + wave, (unsigned)c + 1u);
            } else {
                const f32x4 rs0 = *(const LDSQ f32x4*)(slot + M3_RS + (4 * fq) * 4), rs1 = *(const LDSQ f32x4*)(slot + M3_RS + (16 + 4 * fq) * 4);
                bf16x8 cb[4];
#pragma unroll
                for (int ks = 0; ks < 4; ++ks) cb[ks] = mk8(pack4(C[2 * ks][0]), pack4(C[2 * ks + 1][0]));
#pragma unroll
                for (int tt = 0; tt < 2; ++tt) {
                    f32x4 inter = z4;
#pragma unroll
                    for (int ks = 0; ks < 4; ++ks) inter = mfma16(M3_QF(tt, ks), cb[ks], inter);
                    if (fr == 0) {
#pragma unroll
                        for (int i = 0; i < 4; ++i) *(LDSQ float*)(slot + M3_DN + (16 * tt + 4 * fq + i) * 4) = (tt ? rs1[i] : rs0[i]) + wi[tt][i] * inter[i];
                    }
                }
                f32x4 w0, w1;
#pragma unroll
                for (int i = 0; i < 4; ++i) { w0[i] = (fr == 0) ? wt[0][i] : 0.f; w1[i] = (fr == 0) ? wt[1][i] : 0.f; }
                const bf16x8 vwb = mk8(pack4(w0), pack4(w1));
#pragma unroll
                for (int ci = 0; ci < 8; ++ci) {
                    const int ko = (4 * fq + (fr >> 2)) * M3P + (16 * ci + 4 * (fr & 3)) * 2;
                    const bf16x8 ka = mk8(tr2(TR16(slot + M3_K + ko)), tr2(TR16(slot + M3_K + 16 * M3P + ko)));
                    C[ci][0] = mfma16(ka, vwb, C[ci][0] * wst);
                }
                flag_st(done + wave, (unsigned)c + 1u);
            }
        }
    } else {
        const int p = wave - 5;
        u32x4 tk[8], tq[8], tv[8]; float an = 0.f, mn = 0.f, mcn = 0.f;
#define M3_LOAD(c_) do { _Pragma("unroll") for (int g = 0; g < 8; ++g) { const size_t r = (size_t)(32 * (c_) + 4 * g + lrow); \
        tk[g] = ld16(Kp + r * ldqk + 8 * lpc); tq[g] = ld16(Qp + r * ldqk + 8 * lpc); tv[g] = ld16(Vp + r * ldv + 8 * lpc); } \
    an = SC_A[32 * (c_) + (lane & 31)]; mn = SC_M[32 * (c_) + (lane & 31)]; mcn = ((c_) > 0) ? SC_M[32 * (c_) - 1] : 0.f; } while (0)
#define M3_PARK(cc_) do { LDSQ unsigned char* ps_ = lds + ((cc_) % M3_NSLOT) * M3_SLOTX; \
        if ((cc_) >= M3_NSLOT) { const unsigned want_ = (unsigned)((cc_) - M3_NSLOT + 1); _Pragma("unroll") for (int w_ = 0; w_ < NCONS; ++w_) wait_ge_t(done + w_, want_, flags + 32 + wave); wait_ge_t(done + 4, want_, flags + 32 + wave); M3_FLUSH(ps_, (cc_) - M3_NSLOT); } \
        MEMFENCE(); \
        _Pragma("unroll") for (int g = 0; g < 8; ++g) { const int o_ = (4 * g + lrow) * M3P + lpc * 16; *(LDSQ u32x4*)(ps_ + M3_K + o_) = tk[g]; *(LDSQ u32x4*)(ps_ + M3_Q + o_) = tq[g]; *(LDSQ u32x4*)(ps_ + M3_V + o_) = tv[g]; } \
        { const float Mend_ = __shfl(mn, 31, 32); \
          if (lane < 32) { *(LDSQ float*)(ps_ + M3_A + lane * 4) = an; *(LDSQ float*)(ps_ + M3_MX + lane * 4) = mn; \
              *(LDSQ float*)(ps_ + M3_WI + lane * 4) = fexp(mcn - mn); *(LDSQ float*)(ps_ + M3_WT + lane * 4) = fexp(an - Mend_); } \
          if (lane == 0) *(LDSQ float*)(ps_ + M3_WS) = fexp(mcn - Mend_); } \
        MEMFENCE(); WAVE_SYNC(); } while (0)
        if (p < NC) { M3_LOAD(p); M3_PARK(p); }
        for (int c = p; c < NC; c += 3) {
            if (c + 3 < NC) M3_LOAD(c + 3);
            const int sl = c % M3_NSLOT;
            LDSQ unsigned char* slot = lds + sl * M3_SLOTX;
            f32x4 st00 = z4, st01 = z4, st11 = z4;
#pragma unroll
            for (int ks = 0; ks < 4; ++ks) {
                const int o = fr * M3P + (32 * ks + 4 * fq) * 2;
                const bf16x8 k0 = mk8(ldl8(slot + M3_K + o), ldl8(slot + M3_K + o + 32)), k1 = mk8(ldl8(slot + M3_K + 16 * M3P + o), ldl8(slot + M3_K + 16 * M3P + o + 32));
                const bf16x8 q0 = mk8(ldl8(slot + M3_Q + o), ldl8(slot + M3_Q + o + 32)), q1 = mk8(ldl8(slot + M3_Q + 16 * M3P + o), ldl8(slot + M3_Q + 16 * M3P + o + 32));
                st00 = mfma16(k0, q0, st00); st01 = mfma16(k0, q1, st01); st11 = mfma16(k1, q1, st11);
            }
            const f32x4 as0 = *(const LDSQ f32x4*)(slot + M3_A + (4 * fq) * 4), as1 = *(const LDSQ f32x4*)(slot + M3_A + (16 + 4 * fq) * 4);
            const float mx0 = *(const LDSQ float*)(slot + M3_MX + fr * 4), mx1 = *(const LDSQ float*)(slot + M3_MX + (16 + fr) * 4);
            f32x4 p00, p01, p11;
#pragma unroll
            for (int i = 0; i < 4; ++i) {
                p00[i] = (4 * fq + i <= fr) ? st00[i] * fexp(as0[i] - mx0) : 0.f;
                p01[i] = st01[i] * fexp(as0[i] - mx1);
                p11[i] = (4 * fq + i <= fr) ? st11[i] * fexp(as1[i] - mx1) : 0.f;
            }
            float r0 = (p00[0] + p00[1]) + (p00[2] + p00[3]);
            float r1 = ((p01[0] + p01[1]) + (p01[2] + p01[3])) + ((p11[0] + p11[1]) + (p11[2] + p11[3]));
            r0 += __shfl_xor(r0, 16); r0 += __shfl_xor(r0, 32); r1 += __shfl_xor(r1, 16); r1 += __shfl_xor(r1, 32);
            if (fq == 0) { *(LDSQ float*)(slot + M3_RS + fr * 4) = r0; *(LDSQ float*)(slot + M3_RS + (16 + fr) * 4) = r1; }
            { const u32x2 a0 = pack4(p00); *(LDSQ u32x4*)(slot + M3_P + lane * 16) = (u32x4){a0.x, a0.y, 0u, 0u};
              const u32x2 b0 = pack4(p01), b1 = pack4(p11); *(LDSQ u32x4*)(slot + M3_P + 1024 + lane * 16) = (u32x4){b0.x, b0.y, b1.x, b1.y}; }
            flag_st(ready + sl, (unsigned)c + 1u);
            if (c + 3 < NC) M3_PARK(c + 3);
        }
        for (int c = NC - M3_NSLOT; c < NC; ++c) if (c >= 0 && (c % 3) == p) {
            const unsigned want = (unsigned)c + 1u;
#pragma unroll
            for (int w_ = 0; w_ < NCONS; ++w_) wait_ge(done + w_, want);
            wait_ge(done + 4, want);
            LDSQ unsigned char* sp = lds + (c % M3_NSLOT) * M3_SLOTX; M3_FLUSH(sp, c);
        }
#undef M3_FLUSH
#undef M3_PARK
#undef M3_LOAD
    }
}
#define GAS __attribute__((address_space(1)))
#define LAS __attribute__((address_space(3)))
typedef GAS unsigned gu32;
#define RLX_AGENT __ATOMIC_RELAXED, __HIP_MEMORY_SCOPE_AGENT
#define LDS_WAIT() asm volatile("s_waitcnt lgkmcnt(0)" ::: "memory")
#define VM_WAIT() asm volatile("s_waitcnt vmcnt(0)" ::: "memory")

constexpr int CB = 8, CS = 4096, CD = 1024, CM = CB * CS;
constexpr int NPROJ = 3584, PITCH_WIN = 3592, FF = 4096;
constexpr float NORM_EPS = 1e-6f, GN_EPS = 64e-5f;
constexpr int NWAVES = 8;
constexpr size_t MiB = 1u << 20;
constexpr size_t WS_CTL = 0, CTL_ZERO_BYTES = 1 * MiB;
constexpr size_t WS_W = 1 * MiB;
constexpr size_t WS_GATES = 27 * MiB, WS_DEN = 28 * MiB, WS_EMT = 28 * MiB + 512 * 1024, WS_BONUS = 29 * MiB;
constexpr size_t WS_SCA = 31 * MiB, WS_SCM = 31 * MiB + 512 * 1024;
constexpr size_t WS_U = 32 * MiB;
constexpr size_t WS_BIG = 97 * MiB;
constexpr size_t WS_PROJ = WS_BIG, WS_QKC = 321 * MiB, WS_VT = 385 * MiB, WS_NUM = 417 * MiB;
constexpr size_t WS_MIX = WS_BIG;
constexpr size_t WS_HID = WS_BIG, WS_FFO = 353 * MiB;
constexpr size_t WS_XR = 97 * MiB, WS_XK = 161 * MiB, WS_XV = 225 * MiB, WS_RO = 289 * MiB, WS_KO = 353 * MiB, WS_VO = 417 * MiB, WS_LORA = 481 * MiB, WS_GL = 497 * MiB;
constexpr size_t WS_KT = WS_XR, WS_BT = WS_XK, WS_KK = WS_XV, WS_RT = WS_U, WS_YRAW = WS_RO, WS_YG = WS_KO;
constexpr size_t WS_END = 505 * MiB;
constexpr size_t W_IN = 0, W_OUTE = 3670016, W_UP = 5242880, W_DN = 9437184;
constexpr size_t W_RKV = 0, W_LB1 = 3145728, W_LB2 = 3407872, W_W2T = 3670016, W_A2T = 3735552, W_G2T = 3801088, W_OUTO = 3932160;
constexpr int CW_BAR = 4096;

constexpr int RING_BYTES = 131072, LDSCTL_OFF = RING_BYTES, MISC_OFF = LDSCTL_OFF + 320, LDS_BYTES = 147456;

#define XB_TMO      128
#define XB_XCNT(j)  (256  + 64 * (j))
#define XB_XSUB(j)  (1280 + 64 * (j))
#define XB_XGEN(j)  (2304 + 64 * (j))
#define XB_TOP      3328
#define XB_TOPGEN   3392
#define XCD_BAR_WORDS 3456
#define XB_SPIN_CAP (1u << 18)
__device__ __forceinline__ unsigned xb_ld(unsigned* p)              { return __hip_atomic_load(p, __ATOMIC_RELAXED, __HIP_MEMORY_SCOPE_AGENT); }
__device__ __forceinline__ unsigned xb_add(unsigned* p, unsigned v) { return __hip_atomic_fetch_add(p, v, __ATOMIC_RELAXED, __HIP_MEMORY_SCOPE_AGENT); }
__device__ __forceinline__ unsigned xb_xcc_id() { return (unsigned)__builtin_amdgcn_s_getreg((3 << 11) | 20) & 0xFu; }
#define XB_SPIN(cond, bar) do { unsigned _sp = 0; while (cond) { __builtin_amdgcn_s_sleep(1); \
    if ((++_sp & 255u) == 0u) { if (xb_ld(&(bar)[XB_TMO])) break; if (_sp > XB_SPIN_CAP) { atomicAdd(&(bar)[XB_TMO], 1u); break; } } } } while (0)
struct XcdBarrier { unsigned* bar; unsigned x; volatile LAS unsigned* st; };
__device__ __forceinline__ XcdBarrier xcd_barrier_post(unsigned* bar, volatile LAS unsigned* st, bool t0) {
    XcdBarrier b; b.bar = bar; b.x = xb_xcc_id(); b.st = st;
    if (t0) (void)xb_add(&bar[XB_XCNT(b.x)], 1u);
    return b;
}
__device__ __forceinline__ void xcd_barrier_complete(unsigned* bar, unsigned x, unsigned& nloc, unsigned& nx) {
    const unsigned G = gridDim.x * gridDim.y * gridDim.z;
    unsigned sum, cnt, mine, sp = 0u;
    for (;;) {
        sum = 0u; cnt = 0u; mine = 0u;
#pragma unroll
        for (unsigned j = 0; j < 16; ++j) { const unsigned c = xb_ld(&bar[XB_XCNT(j)]); sum += c; cnt += (c > 0u) ? 1u : 0u; mine = (j == x) ? c : mine; }
        if (sum == G) break;
        __builtin_amdgcn_s_sleep(1);
        if ((++sp & 255u) == 0u) { if (xb_ld(&bar[XB_TMO])) break; if (sp > XB_SPIN_CAP) { atomicAdd(&bar[XB_TMO], 1u); break; } }
    }
    nloc = mine > 0u ? mine : 1u; nx = cnt > 0u ? cnt : 1u;
}
__device__ __forceinline__ void xcd_barrier(const XcdBarrier& b, bool t0) {
    asm volatile("s_waitcnt vmcnt(0)" ::: "memory");
    __syncthreads();
    if (t0) {
        unsigned* bar = b.bar;
        __builtin_amdgcn_s_waitcnt(0);
        unsigned nloc = b.st[0], nx = b.st[1];
        if (nloc == 0u) { xcd_barrier_complete(bar, b.x, nloc, nx); b.st[0] = nloc; b.st[1] = nx; }
        const unsigned old = xb_add(&bar[XB_XSUB(b.x)], 1u);
        const unsigned gen = old / nloc;
        if (old + 1u == (gen + 1u) * nloc) {
            __builtin_amdgcn_fence(__ATOMIC_RELEASE, "agent");
            asm volatile("s_waitcnt vmcnt(0)" ::: "memory");
            const unsigned og = xb_add(&bar[XB_TOP], 1u);
            const unsigned tg = og / nx;
            if (og + 1u == (tg + 1u) * nx) xb_add(&bar[XB_TOPGEN], 1u);
            else XB_SPIN(xb_ld(&bar[XB_TOPGEN]) == tg, bar);
            __builtin_amdgcn_fence(__ATOMIC_ACQUIRE, "agent");
            xb_add(&bar[XB_XGEN(b.x)], 1u);
            asm volatile("s_waitcnt vmcnt(0)" ::: "memory");
        } else {
            XB_SPIN(xb_ld(&bar[XB_XGEN(b.x)]) == gen, bar);
            __builtin_amdgcn_fence(__ATOMIC_ACQUIRE, "agent");
            asm volatile("s_waitcnt vmcnt(0)" ::: "memory");
        }
    }
    __syncthreads();
}

namespace pg8 {
constexpr int BM = 256, BK = 64, HALF = 128, HTB = HALF * BK * 2, STAGE_BYTES = 8 * HTB, NXCD = 8, WGM = 8;
__host__ __device__ __forceinline__ int lds_byte(int r, int c) { const int st = (r >> 4) * 2 + (c >> 5), rr = r & 15, cc = c & 31, ob = rr * 64 + cc * 2; return st * 1024 + (ob ^ (((ob >> 9) & 1) << 5)); }
__host__ __device__ __forceinline__ void stage_rc(int b, int& R, int& C) { const int st = b / 1024, sb = b % 1024, swz = sb ^ (((sb >> 9) & 1) << 5); R = (st >> 1) * 16 + swz / 64; C = (st & 1) * 32 + (swz % 64) / 2; }
__host__ __device__ __forceinline__ int perm32(int rho) { const int n = rho >> 4, i = rho & 15; return 8 * (i >> 2) + 4 * n + (i & 3); }
struct Unit { int pm, pn; };
struct UnitPtrs { const GAS char* A; const GAS char* B; int two; };
struct StaticOrder {
    int nM, nN, nwg, G, c;
    __device__ void init(int M, int N, int G_, int c_) { nM = M / BM; nN = N / BM; nwg = nM * nN; G = G_; c = c_; }
    __device__ bool next(int i, Unit& u) const {
        const long L = (long)i * G + c; if (L >= nwg) return false;
        int wgid = (int)L; { const int q = nwg / NXCD, r = nwg % NXCD, xcd = wgid % NXCD, off = wgid / NXCD; wgid = (xcd < r ? xcd * (q + 1) : r * (q + 1) + (xcd - r) * q) + off; }
        const int nig = WGM * nN, gid = wgid / nig, fm = gid * WGM, gsz = (nM - fm) < WGM ? (nM - fm) : WGM;
        u.pm = fm + ((wgid % nig) % gsz); u.pn = (wgid % nig) / gsz; return true;
    }
};
__device__ __forceinline__ unsigned cvt_pk_bf16(float lo, float hi) { unsigned r; asm volatile("v_cvt_pk_bf16_f32 %0, %1, %2" : "=v"(r) : "v"(lo), "v"(hi)); return r; }

template <int LDA, int LDB, int NT> struct ProbPlain {
    const GAS bf16_t* A; const GAS bf16_t* Bt;
    static constexpr long lda = LDA, ldb = LDB; static constexpr bool TWO_SRC = false; static constexpr int NTC = NT;
    __device__ __forceinline__ void ptrs(const Unit& u, UnitPtrs& p) const {
        p.A = (const GAS char*)(A + (size_t)u.pm * BM * lda); p.B = (const GAS char*)(Bt + (size_t)u.pn * BM * ldb);
    }
};
struct ProbRkv {
    const GAS bf16_t* X; size_t xstride; const GAS bf16_t* Wt; const GAS bf16_t* Upad; const GAS bf16_t* LB1; long lb2d;
    static constexpr long lda = 1024, ldb = 1024; static constexpr bool TWO_SRC = true; static constexpr int NTC = 16;
    __device__ __forceinline__ void ptrs(const Unit& u, UnitPtrs& p) const {
        if (u.pn < 12) { p.A = (const GAS char*)(X + (size_t)(u.pn >> 2) * xstride + (size_t)u.pm * BM * 1024); p.B = (const GAS char*)(Wt + (size_t)u.pn * BM * 1024); p.two = 0; }
        else { const size_t arow = (size_t)u.pm * BM + (size_t)(u.pm >> 4) + 1; p.A = (const GAS char*)(Upad + arow * 1024); p.B = (const GAS char*)LB1; p.two = 1; }
    }
};
struct RkvOrder {
    int c;
    __device__ bool next(int i, Unit& u) const { const int half = c & 1; if (i >= (half ? 6 : 7)) return false; u.pm = c >> 1; u.pn = half ? 7 + i : i; return true; }
};
struct EpiStore {
    GAS bf16_t* O; int ldc; int act; int rkv; size_t gstride; GAS bf16_t* Ol;
    static constexpr bool PERM = true;
    __device__ __forceinline__ void operator()(const f32x4 (&acc)[2][2][4][2], const Unit& u, int wr, int wc, int fr, int fq) const {
        GAS bf16_t* base = O; int ld = ldc, colt = u.pn * BM;
        if (rkv) { if (u.pn < 12) { base = O + (size_t)(u.pn >> 2) * gstride; colt = (u.pn & 3) * BM; } else { base = Ol; ld = 256; colt = 0; } }
        const int row0 = u.pm * BM + wr * 64 + fr, col0 = colt + wc * 32 + 8 * fq;
#pragma unroll
        for (int ai = 0; ai < 2; ++ai)
#pragma unroll
            for (int m = 0; m < 4; ++m) { GAS bf16_t* rowp = base + (size_t)(row0 + ai * HALF + m * 16) * ld + col0;
#pragma unroll
                for (int bj = 0; bj < 2; ++bj) { f32x4 v0 = acc[ai][bj][m][0], v1 = acc[ai][bj][m][1];
                    if (rkv && u.pn == 12) {
                        if (bj == 1) {
#pragma unroll
                            for (int q = 0; q < 4; ++q) { v0[q] = sigmoidf_(v0[q]); v1[q] = sigmoidf_(v1[q]); }
                        } else if (wc < 2) {
#pragma unroll
                            for (int q = 0; q < 4; ++q) { v0[q] = tanhf_(v0[q]); v1[q] = tanhf_(v1[q]); }
                        }
                    }
                    if (act == 1) {
#pragma unroll
                        for (int q = 0; q < 4; ++q) { const float a = fmaxf(v0[q], 0.f), b = fmaxf(v1[q], 0.f); v0[q] = a * a; v1[q] = b * b; } }
                    u32x4 w; w.x = cvt_pk_bf16(v0[0], v0[1]); w.y = cvt_pk_bf16(v0[2], v0[3]); w.z = cvt_pk_bf16(v1[0], v1[1]); w.w = cvt_pk_bf16(v1[2], v1[3]);
                    *(GAS u32x4*)(rowp + bj * HALF) = w; } }
    }
};

template <class Prob, class Epi, class Sched>
__device__ __forceinline__ void gemm_phase(LAS unsigned char* lds, int wave_in, const Prob& P, const Sched& S, const Epi& E) {
    const int wid = __builtin_amdgcn_readfirstlane(wave_in); const int lane = lane_id(); const int tid = wid * 64 + lane;
    const int wr = wid >> 2, wc = wid & 3, fr = lane & 15, fq = lane >> 4;
    constexpr long lda = Prob::lda, ldb = Prob::ldb; long lb2d = 0; if constexpr (Prob::TWO_SRC) lb2d = P.lb2d;
    unsigned voffA[2], voffB[2];
#pragma unroll
    for (int i = 0; i < 2; ++i) { int R, C; stage_rc(tid * 16 + i * 8192, R, C); const int Rb = Epi::PERM ? ((R & ~31) + perm32(R & 31)) : R;
        voffA[i] = (unsigned)(R * lda + C) * 2u; voffB[i] = (unsigned)(Rb * ldb + C) * 2u; }
    const long kstep = (long)(BK * 2);
    const long hstepA = (long)HALF * lda * 2, hstepB = (long)HALF * ldb * 2;
    const unsigned ldsw = (unsigned)wid * 1024u;
    const int aoff = lds_byte(wr * 64 + fr, fq * 8), boff = lds_byte(wc * 32 + fr, fq * 8);
#define PG8_SA(b, h) (((b) * 2 + (h)) * HTB)
#define PG8_SB(b, h) ((4 + (b) * 2 + (h)) * HTB)
#define PG8_STAGE(bufoff, gbase, voff) do { _Pragma("unroll") for (int _i = 0; _i < 2; ++_i) \
        __builtin_amdgcn_global_load_lds((const GAS unsigned*)((const GAS char*)(gbase) + (voff)[_i]), (LAS unsigned*)(lds + (bufoff) + ldsw + _i * 8192), 16, 0, 0); } while (0)
#define PG8_LDA(dst, b, h) do { _Pragma("unroll") for (int m = 0; m < 4; ++m) _Pragma("unroll") for (int k = 0; k < 2; ++k) dst[m][k] = *(const LAS bf16x8*)(lds + PG8_SA(b, h) + aoff + m * 2048 + k * 1024); } while (0)
#define PG8_LDB(dst, b, h) do { _Pragma("unroll") for (int n = 0; n < 2; ++n) _Pragma("unroll") for (int k = 0; k < 2; ++k) dst[n][k] = *(const LAS bf16x8*)(lds + PG8_SB(b, h) + boff + n * 2048 + k * 1024); } while (0)
#define PG8_MMA(ai, bj, At, Bt) do { __builtin_amdgcn_s_setprio(1); _Pragma("unroll") for (int m = 0; m < 4; ++m) _Pragma("unroll") for (int n = 0; n < 2; ++n) _Pragma("unroll") for (int k = 0; k < 2; ++k) \
        acc[ai][bj][m][n] = __builtin_amdgcn_mfma_f32_16x16x32_bf16(Bt[n][k], At[m][k], acc[ai][bj][m][n], 0, 0, 0); __builtin_amdgcn_s_setprio(0); } while (0)
#define PG8_WAIT_V(n) asm volatile("s_waitcnt vmcnt(" #n ")" ::: "memory")
#define PG8_WAIT_L(n) asm volatile("s_waitcnt lgkmcnt(" #n ")" ::: "memory")
#define PG8_BAR __builtin_amdgcn_s_barrier()
#define PG8_SCHED __builtin_amdgcn_sched_barrier(0)
#define PG8_KTA(p, tau) ((p).A + ((!Prob::TWO_SRC || (tau) < 16) ? (long)(tau) * kstep : (long)((tau) - 16) * kstep - 2048))
#define PG8_KTB(p, tau) ((p).B + ((!Prob::TWO_SRC || (tau) < 16) ? (long)(tau) * kstep : (long)((tau) - 16) * kstep + lb2d))
    Unit cur, nxt; int ui = 0;
    if (!S.next(0, cur)) return;
    UnitPtrs cp, np; P.ptrs(cur, cp);
    f32x4 acc[2][2][4][2];
#pragma unroll
    for (int a = 0; a < 2; ++a)
#pragma unroll
        for (int b = 0; b < 2; ++b)
#pragma unroll
            for (int m = 0; m < 4; ++m)
#pragma unroll
                for (int n = 0; n < 2; ++n) acc[a][b][m][n] = (f32x4){0.f, 0.f, 0.f, 0.f};
    bf16x8 At[4][2], B0[2][2], B1[2][2];
    {
        const GAS char* cA = cp.A; const GAS char* cB = cp.B;
        PG8_STAGE(PG8_SB(0, 0), cB, voffB); PG8_STAGE(PG8_SB(0, 1), cB + hstepB, voffB); PG8_STAGE(PG8_SA(0, 0), cA, voffA); PG8_STAGE(PG8_SA(0, 1), cA + hstepA, voffA);
        if (wr == 1) PG8_BAR;
        PG8_WAIT_V(2); PG8_BAR;
        PG8_STAGE(PG8_SB(1, 0), cB + kstep, voffB); PG8_STAGE(PG8_SA(1, 0), cA + kstep, voffA); PG8_STAGE(PG8_SB(1, 1), cB + hstepB + kstep, voffB);
        PG8_WAIT_V(6); PG8_BAR;
    }
    for (;;) {
        const bool has_next = S.next(ui + 1, nxt);
        if (has_next) P.ptrs(nxt, np); else np = cp;
        int nt = Prob::NTC; if constexpr (Prob::TWO_SRC) { if (cp.two) nt = 32; }
        for (int t = 0; t < nt; t += 2) {
            const bool last = (t == nt - 2);
            const GAS char* a1 = PG8_KTA(cp, t + 1);
            const GAS char* a2 = last ? np.A : PG8_KTA(cp, t + 2); const GAS char* b2 = last ? np.B : PG8_KTB(cp, t + 2);
            const GAS char* a3 = a2 + kstep; const GAS char* b3 = b2 + kstep;
            PG8_LDB(B0, 0, 0); PG8_LDB(B1, 0, 1); PG8_SCHED; PG8_LDA(At, 0, 0); PG8_STAGE(PG8_SA(1, 1), a1 + hstepA, voffA);
            PG8_WAIT_V(8); PG8_WAIT_L(0); PG8_BAR; PG8_MMA(0, 0, At, B0); PG8_MMA(0, 1, At, B1); PG8_BAR; PG8_SCHED;
            PG8_LDA(At, 0, 1); PG8_STAGE(PG8_SB(0, 0), b2, voffB); PG8_STAGE(PG8_SB(0, 1), b2 + hstepB, voffB); PG8_STAGE(PG8_SA(0, 0), a2, voffA);
            PG8_WAIT_V(8); PG8_WAIT_L(0); PG8_BAR; PG8_MMA(1, 0, At, B0); PG8_MMA(1, 1, At, B1); PG8_BAR; PG8_SCHED;
            PG8_LDB(B0, 1, 0); PG8_LDB(B1, 1, 1); PG8_SCHED; PG8_LDA(At, 1, 0); PG8_STAGE(PG8_SA(0, 1), a2 + hstepA, voffA);
            PG8_WAIT_V(8); PG8_WAIT_L(0); PG8_BAR; PG8_MMA(0, 0, At, B0); PG8_MMA(0, 1, At, B1); PG8_BAR; PG8_SCHED;
            PG8_LDA(At, 1, 1); PG8_STAGE(PG8_SB(1, 0), b3, voffB); PG8_STAGE(PG8_SB(1, 1), b3 + hstepB, voffB); PG8_STAGE(PG8_SA(1, 0), a3, voffA);
            PG8_WAIT_V(8); PG8_WAIT_L(0); PG8_BAR; PG8_MMA(1, 0, At, B0); PG8_MMA(1, 1, At, B1); PG8_BAR; PG8_SCHED;
        }
        if (wr == 0) PG8_BAR;
        E(acc, cur, wr, wc, fr, fq);
        if (!has_next) break;
#pragma unroll
        for (int a = 0; a < 2; ++a)
#pragma unroll
            for (int b = 0; b < 2; ++b)
#pragma unroll
                for (int m = 0; m < 4; ++m)
#pragma unroll
                    for (int n = 0; n < 2; ++n) acc[a][b][m][n] = (f32x4){0.f, 0.f, 0.f, 0.f};
        cur = nxt; cp = np; ++ui;
        if (wr == 1) PG8_BAR;
    }
    PG8_WAIT_V(0);
    PG8_BAR;
#undef PG8_SA
#undef PG8_SB
#undef PG8_STAGE
#undef PG8_LDA
#undef PG8_LDB
#undef PG8_MMA
#undef PG8_WAIT_V
#undef PG8_WAIT_L
#undef PG8_BAR
#undef PG8_SCHED
#undef PG8_KTA
#undef PG8_KTB
}
}

struct Frame {
    LAS unsigned char* lds;
    int tid, lane, wave, vcu, G, gw, NGW;
};
#define DPP_ADD(v, ctrl) v += __builtin_bit_cast(float, __builtin_amdgcn_update_dpp(0, __builtin_bit_cast(int, v), ctrl, 0xF, 0xF, true))
__device__ __forceinline__ float wave_sum(float v) {
    DPP_ADD(v, 0xB1); DPP_ADD(v, 0x4E); DPP_ADD(v, 0x141); DPP_ADD(v, 0x140);
    v += __shfl_xor(v, 16); v += __shfl_xor(v, 32);
    return v;
}
__device__ __forceinline__ void cvt_item(const GAS float* W, int ldw, GAS bf16_t* WT, int ldt, int k0, int n0, const GAS float* sc, int mode, LAS float* scr, int lane) {
#pragma unroll 8
    for (int i = 0; i < 32; ++i) { const int kk = 2 * i + (lane >> 5); float v = W[(size_t)(k0 + kk) * ldw + n0 + (lane & 31)];
        if (mode) { const float s = sc[k0 + kk]; v *= (mode == 1) ? s : (1.0f - s); }
        scr[kk * 33 + (lane & 31)] = v; }
    LDS_WAIT(); asm volatile("" ::: "memory");
    const int c = lane & 7;
#pragma unroll
    for (int j = 0; j < 4; ++j) { const int n = (lane >> 3) + 8 * j; const LAS float* s = scr + (8 * c) * 33 + n;
        u32x4 o; o.x = pk2(s[0 * 33], s[1 * 33]); o.y = pk2(s[2 * 33], s[3 * 33]); o.z = pk2(s[4 * 33], s[5 * 33]); o.w = pk2(s[6 * 33], s[7 * 33]);
        *(GAS u32x4*)(WT + (size_t)(n0 + n) * ldt + k0 + 8 * c) = o; }
    LDS_WAIT(); asm volatile("" ::: "memory");
}
__device__ __forceinline__ void cvt_matrix(const Frame& F, const GAS float* W, int ldw, int K, int N, GAS bf16_t* WT, int ldt, const GAS float* sc, int mode, int& cursor) {
    LAS float* scr = (LAS float*)(F.lds + F.wave * 16384);
    const int nnb = N / 32, nitems = (K / 64) * nnb;
    int first = (F.gw - cursor) % F.NGW; if (first < 0) first += F.NGW;
    for (int it = first; it < nitems; it += F.NGW) cvt_item(W, ldw, WT, ldt, 64 * (it / nnb), 32 * (it % nnb), sc, mode, scr, F.lane);
    cursor += nitems;
}
struct Inputs { const float* p[25]; };
#define INP(i) ((const GAS float*)in.p[i])
__device__ __forceinline__ void convert_layer(const Frame& F, const Inputs& in, GAS bf16_t* Wb, int L) {
    int cur = 0;
    if ((L & 1) == 0) {
        const int e = L >> 1;
        cvt_matrix(F, INP(2) + (size_t)e * 1024 * PITCH_WIN, PITCH_WIN, 1024, NPROJ, Wb + W_IN, 1024, nullptr, 0, cur);
        cvt_matrix(F, INP(6) + (size_t)e * 1024 * 1024, 1024, 1024, 1024, Wb + W_OUTE, 1024, nullptr, 0, cur);
    } else {
        const int o = L >> 1; const GAS float* mu = INP(7) + (size_t)o * 6 * 1024;
        for (int j = 0; j < 3; ++j) cvt_matrix(F, INP(8) + ((size_t)o * 3 + j) * 1024 * 1024, 1024, 1024, 1024, Wb + W_RKV + (size_t)j * 1024 * 1024, 1024, nullptr, 0, cur);
        for (int s = 0; s < 2; ++s) { GAS bf16_t* LB = Wb + (s ? W_LB2 : W_LB1); const int mode = s ? 1 : 2;
            cvt_matrix(F, INP(10) + (size_t)o * 1024 * 64, 64, 1024, 64, LB, 1024, mu + 1 * 1024, mode, cur);
            cvt_matrix(F, INP(13) + (size_t)o * 1024 * 64, 64, 1024, 64, LB + 64 * 1024, 1024, mu + 4 * 1024, mode, cur);
            cvt_matrix(F, INP(15) + (size_t)o * 1024 * 128, 128, 1024, 128, LB + 128 * 1024, 1024, mu + 5 * 1024, mode, cur); }
        cvt_matrix(F, INP(11) + (size_t)o * 64 * 1024, 1024, 64, 1024, Wb + W_W2T, 64, nullptr, 0, cur);
        cvt_matrix(F, INP(14) + (size_t)o * 64 * 1024, 1024, 64, 1024, Wb + W_A2T, 64, nullptr, 0, cur);
        cvt_matrix(F, INP(16) + (size_t)o * 128 * 1024, 1024, 128, 1024, Wb + W_G2T, 128, nullptr, 0, cur);
        cvt_matrix(F, INP(22) + (size_t)o * 1024 * 1024, 1024, 1024, 1024, Wb + W_OUTO, 1024, nullptr, 0, cur);
    }
    cvt_matrix(F, INP(23) + (size_t)L * 1024 * FF, FF, 1024, FF, Wb + W_UP, 1024, nullptr, 0, cur);
    cvt_matrix(F, INP(24) + (size_t)L * FF * 1024, 1024, FF, 1024, Wb + W_DN, FF, nullptr, 0, cur);
}

struct RowPassArgs {
    const GAS float* hsrc; const GAS bf16_t* y; const GAS float* gpost; GAS float* hdst;
    GAS bf16_t* udst; const GAS float* gpre; int upad;
    const GAS float* gate_w; const GAS float* gate_b; GAS float* gates;
};
template <int R>
__device__ __forceinline__ void row_pass(const Frame& F, const RowPassArgs& A) {
    LAS float* GWT = (LAS float*)(F.lds + 65536);
    if (A.gates) {
        for (int idx = F.tid; idx < 8192; idx += NWAVES * 64) { const int k = idx >> 3, j = idx & 7; GWT[j * 1024 + k] = A.gate_w[(size_t)k * PITCH_WIN + NPROJ + j]; }
        __syncthreads();
    }
    f32x4 gp[4], gq[4];
#pragma unroll
    for (int j = 0; j < 4; ++j) { gp[j] = A.gpost ? *(const GAS f32x4*)(A.gpost + 4 * F.lane + 256 * j) : (f32x4){0.f, 0.f, 0.f, 0.f}; gq[j] = A.gpre ? *(const GAS f32x4*)(A.gpre + 4 * F.lane + 256 * j) : (f32x4){0.f, 0.f, 0.f, 0.f}; }
    for (int base = F.gw * R; base < CM; base += F.NGW * R) {
        f32x4 hv[R][4]; u32x2 yw[R][4];
#pragma unroll
        for (int r = 0; r < R; ++r)
#pragma unroll
            for (int j = 0; j < 4; ++j) { hv[r][j] = *(const GAS f32x4*)(A.hsrc + (size_t)(base + r) * CD + 4 * F.lane + 256 * j); if (A.y) yw[r][j] = ld8(A.y + (size_t)(base + r) * CD + 4 * F.lane + 256 * j); }
        if (A.y) {
            f32x4 yf[R][4]; float ss[R];
#pragma unroll
            for (int r = 0; r < R; ++r) { ss[r] = 0.f;
#pragma unroll
                for (int j = 0; j < 4; ++j) { const u32x2 w = yw[r][j];
                    yf[r][j] = (f32x4){bf2f((unsigned short)(w.x & 0xffffu)), bf2f((unsigned short)(w.x >> 16)), bf2f((unsigned short)(w.y & 0xffffu)), bf2f((unsigned short)(w.y >> 16))};
                    ss[r] += (yf[r][j][0] * yf[r][j][0] + yf[r][j][1] * yf[r][j][1]) + (yf[r][j][2] * yf[r][j][2] + yf[r][j][3] * yf[r][j][3]); } }
#pragma unroll
            for (int r = 0; r < R; ++r) ss[r] = wave_sum(ss[r]);
#pragma unroll
            for (int r = 0; r < R; ++r) { const float rs = __builtin_amdgcn_rsqf(ss[r] * (1.0f / CD) + NORM_EPS);
#pragma unroll
                for (int j = 0; j < 4; ++j) { hv[r][j] += yf[r][j] * rs * gp[j]; *(GAS f32x4*)(A.hdst + (size_t)(base + r) * CD + 4 * F.lane + 256 * j) = hv[r][j]; } }
        }
        if (A.udst) {
            float ss[R];
#pragma unroll
            for (int r = 0; r < R; ++r) { ss[r] = 0.f;
#pragma unroll
                for (int j = 0; j < 4; ++j) ss[r] += (hv[r][j][0] * hv[r][j][0] + hv[r][j][1] * hv[r][j][1]) + (hv[r][j][2] * hv[r][j][2] + hv[r][j][3] * hv[r][j][3]); }
#pragma unroll
            for (int r = 0; r < R; ++r) ss[r] = wave_sum(ss[r]);
#pragma unroll
            for (int r = 0; r < R; ++r) {
                const int row = base + r;
                const float rs = __builtin_amdgcn_rsqf(ss[r] * (1.0f / CD) + NORM_EPS);
                const size_t urow = A.upad ? (size_t)row + (size_t)(row / CS) + 1 : (size_t)row;
                f32x4 uf[4];
#pragma unroll
                for (int j = 0; j < 4; ++j) { uf[j] = hv[r][j] * rs * gq[j]; *(GAS u32x2*)(A.udst + urow * CD + 4 * F.lane + 256 * j) = pack4(uf[j]); }
                if (A.upad && (row % CS) == 0) {
#pragma unroll
                    for (int j = 0; j < 4; ++j) *(GAS u32x2*)(A.udst + (urow - 1) * CD + 4 * F.lane + 256 * j) = (u32x2){0u, 0u};
                }
                if (A.gates) {
                    float v[8];
                    int goff = 4 * F.lane; asm volatile("" : "+v"(goff));
#pragma unroll
                    for (int g = 0; g < 8; ++g) { float s = 0.f;
#pragma unroll
                        for (int j = 0; j < 4; ++j) { const f32x4 w = *(const LAS f32x4*)(GWT + g * 1024 + goff + 256 * j); s += (uf[j][0] * w[0] + uf[j][1] * w[1]) + (uf[j][2] * w[2] + uf[j][3] * w[3]); }
                        v[g] = s; }
                    const bool b5 = (F.lane & 32) != 0, b4 = (F.lane & 16) != 0, b3 = (F.lane & 8) != 0;
                    float r4[4], r2[2];
#pragma unroll
                    for (int i = 0; i < 4; ++i) { const float snd = b5 ? v[i] : v[i + 4], kp = b5 ? v[i + 4] : v[i]; r4[i] = kp + __shfl_xor(snd, 32); }
#pragma unroll
                    for (int i = 0; i < 2; ++i) { const float snd = b4 ? r4[i] : r4[i + 2], kp = b4 ? r4[i + 2] : r4[i]; r2[i] = kp + __shfl_xor(snd, 16); }
                    float r1; { const float snd = b3 ? r2[0] : r2[1], kp = b3 ? r2[1] : r2[0]; r1 = kp + __shfl_xor(snd, 8); }
                    r1 += __shfl_xor(r1, 4); r1 += __shfl_xor(r1, 2); r1 += __shfl_xor(r1, 1);
                    if ((F.lane & 7) == 0) { const int o = F.lane >> 3; float g = r1 + A.gate_b[o]; if (o >= 4) g = -softplusf(-g); A.gates[(size_t)row * 8 + o] = g; }
                }
            }
        }
    }
}
__device__ __forceinline__ void mix_pass(const Frame& F, const GAS bf16_t* Upad, const GAS float* mu, GAS bf16_t* XR, GAS bf16_t* XK, GAS bf16_t* XV) {
    f32x4 m0[4], m2[4], m3[4];
#pragma unroll
    for (int j = 0; j < 4; ++j) { m0[j] = *(const GAS f32x4*)(mu + 0 * 1024 + 4 * F.lane + 256 * j); m2[j] = *(const GAS f32x4*)(mu + 2 * 1024 + 4 * F.lane + 256 * j); m3[j] = *(const GAS f32x4*)(mu + 3 * 1024 + 4 * F.lane + 256 * j); }
    constexpr int R = 4;
    for (int base = F.gw * R; base < CM; base += F.NGW * R) {
        u32x2 a[R][4], b[R][4];
#pragma unroll
        for (int r = 0; r < R; ++r) { const size_t urow = (size_t)(base + r) + (size_t)((base + r) / CS) + 1;
#pragma unroll
            for (int j = 0; j < 4; ++j) { const size_t c = 4 * F.lane + 256 * j; a[r][j] = ld8(Upad + urow * CD + c); b[r][j] = ld8(Upad + (urow - 1) * CD + c); } }
#pragma unroll
        for (int r = 0; r < R; ++r)
#pragma unroll
            for (int j = 0; j < 4; ++j) {
                const size_t c = 4 * F.lane + 256 * j;
                const f32x4 u = {bf2f((unsigned short)(a[r][j].x & 0xffffu)), bf2f((unsigned short)(a[r][j].x >> 16)), bf2f((unsigned short)(a[r][j].y & 0xffffu)), bf2f((unsigned short)(a[r][j].y >> 16))};
                const f32x4 p = {bf2f((unsigned short)(b[r][j].x & 0xffffu)), bf2f((unsigned short)(b[r][j].x >> 16)), bf2f((unsigned short)(b[r][j].y & 0xffffu)), bf2f((unsigned short)(b[r][j].y >> 16))};
                const f32x4 xx = p - u;
                *(GAS u32x2*)(XR + (size_t)(base + r) * CD + c) = pack4(u + xx * m0[j]);
                *(GAS u32x2*)(XK + (size_t)(base + r) * CD + c) = pack4(u + xx * m2[j]);
                *(GAS u32x2*)(XV + (size_t)(base + r) * CD + c) = pack4(u + xx * m3[j]);
            }
    }
}
__device__ __forceinline__ void conv_vt_pass(const Frame& F, const GAS bf16_t* PROJ, const GAS float* convw, GAS bf16_t* QKC, GAS bf16_t* VT, const GAS float* GATES, GAS float* SCA, GAS float* SCM, GAS float* SCE) {
    if (blockIdx.x < 32) { const int st = blockIdx.x, b = st >> 2, mh = st & 3; mlstm_gate_scan_wg(F.wave, GATES + (size_t)b * CS * 8, mh, 4 + mh, CS, SCA + (size_t)st * CS, SCM + (size_t)st * CS, SCE + (size_t)st * CS, (LAS float*)(F.lds + 80000)); }
    {
        const int cg = F.tid & 127, rs = F.tid >> 7, c0 = 8 * cg;
        float w[4][8];
#pragma unroll
        for (int j = 0; j < 4; ++j) { const f32x4 a = *(const GAS f32x4*)(convw + j * 1024 + c0), b = *(const GAS f32x4*)(convw + j * 1024 + c0 + 4);
#pragma unroll
            for (int q = 0; q < 4; ++q) { w[j][q] = a[q]; w[j][4 + q] = b[q]; } }
        const float osc = (c0 >= 512) ? 0.08838834764831845f : 1.0f;
        for (int ub = blockIdx.x; ub < CM / 64; ub += F.G) {
            const int r0 = ub * 64 + rs * 16;
            u32x4 x0, x1, x2;
            const int tin = r0 % CS;
            const u32x4 zz = {0u, 0u, 0u, 0u};
            x0 = (tin >= 3) ? ld16(PROJ + (size_t)(r0 - 3) * NPROJ + 1536 + c0) : zz;
            x1 = (tin >= 2) ? ld16(PROJ + (size_t)(r0 - 2) * NPROJ + 1536 + c0) : zz;
            x2 = (tin >= 1) ? ld16(PROJ + (size_t)(r0 - 1) * NPROJ + 1536 + c0) : zz;
#pragma unroll 4
            for (int i = 0; i < 16; ++i) {
                const u32x4 x3 = ld16(PROJ + (size_t)(r0 + i) * NPROJ + 1536 + c0);
                u32x4 o;
#pragma unroll
                for (int q = 0; q < 4; ++q) {
                    float acc0 = w[0][2 * q] * bf2f((unsigned short)(x0[q] & 0xffffu)) + w[1][2 * q] * bf2f((unsigned short)(x1[q] & 0xffffu)) + w[2][2 * q] * bf2f((unsigned short)(x2[q] & 0xffffu)) + w[3][2 * q] * bf2f((unsigned short)(x3[q] & 0xffffu));
                    float acc1 = w[0][2 * q + 1] * bf2f((unsigned short)(x0[q] >> 16)) + w[1][2 * q + 1] * bf2f((unsigned short)(x1[q] >> 16)) + w[2][2 * q + 1] * bf2f((unsigned short)(x2[q] >> 16)) + w[3][2 * q + 1] * bf2f((unsigned short)(x3[q] >> 16));
                    acc0 = acc0 * sigmoidf_(acc0) * osc; acc1 = acc1 * sigmoidf_(acc1) * osc;
                    o[q] = pk2(acc0, acc1);
                }
                *(GAS u32x4*)(QKC + (size_t)(r0 + i) * CD + c0) = o;
                x0 = x1; x1 = x2; x2 = x3;
            }
        }
    }
    {
        LAS unsigned char* tile = F.lds + F.wave * 9216;
        for (int it = F.gw; it < CB * 8 * (CS / 64); it += F.NGW) {
            const int bh = it / (CS / 64), tb = it % (CS / 64), b = bh >> 3, h = bh & 7;
            const size_t tok0 = (size_t)b * CS + (size_t)tb * 64;
#pragma unroll
            for (int i = 0; i < 8; ++i) { const int r = 8 * i + (F.lane >> 3), ch = F.lane & 7;
                *(LAS u32x4*)(tile + r * 144 + ch * 16) = ld16(PROJ + (tok0 + r) * NPROJ + 1024 + 64 * h + 8 * ch); }
            LDS_WAIT(); asm volatile("" ::: "memory");
#pragma unroll
            for (int i = 0; i < 8; ++i) { const int pidx = i * 64 + F.lane, d = pidx >> 3, tg = pidx & 7;
                unsigned short e[8];
#pragma unroll
                for (int q = 0; q < 8; ++q) e[q] = *(const LAS unsigned short*)(tile + (8 * tg + q) * 144 + d * 2);
                u32x4 o = {(unsigned)e[0] | ((unsigned)e[1] << 16), (unsigned)e[2] | ((unsigned)e[3] << 16), (unsigned)e[4] | ((unsigned)e[5] << 16), (unsigned)e[6] | ((unsigned)e[7] << 16)};
                *(GAS u32x4*)(VT + ((size_t)bh * 64 + d) * CS + (size_t)tb * 64 + 8 * tg) = o; }
            LDS_WAIT(); asm volatile("" ::: "memory");
        }
    }
}
#ifndef MLFORM
#define MLFORM 1
#endif
#if MLFORM == 4
#define MLWG 32
#else
#define MLWG 64
#endif
__device__ __forceinline__ void mixers_even_phase(const Frame& F, const GAS bf16_t* PROJ, const GAS bf16_t* QKC, const GAS bf16_t* VT, const GAS float* SCA, const GAS float* SCM, GAS bf16_t* MIXCAT, GAS bf16_t* NUM, GAS float* DEN) {
    const int wg = blockIdx.x;
#ifndef NO_ML
    if (wg < MLWG) {
        LAS unsigned* flags = (LAS unsigned*)(F.lds + LDSCTL_OFF);
        if (F.tid < 64) flags[F.tid] = 0u;
        __syncthreads();
#if MLFORM == 4
        const int st = wg, b = st >> 2, mh = st & 3; const size_t r0 = (size_t)b * CS;
        mlstm_coop32<4, 2>(F.wave, 0, true, QKC + r0 * CD + 128 * mh, QKC + r0 * CD + 512 + 128 * mh, CD, PROJ + r0 * NPROJ + 2560 + 128 * mh, NPROJ, SCA + (size_t)st * CS, SCM + (size_t)st * CS, CS,
                           NUM + r0 * 512 + 128 * mh, 512, DEN + r0 * 4 + mh, 4, F.lds, flags);
#else
        const int st = wg >> 1, half = wg & 1, b = st >> 2, mh = st & 3; const size_t r0 = (size_t)b * CS;
#ifdef ABL_PROBE
        { const unsigned long long t0 = __builtin_amdgcn_s_memrealtime();
          mlstm_coop32<1, 4, ABL_PROBE>(F.wave, 64 * half, half == 0, QKC + r0 * CD + 128 * mh, QKC + r0 * CD + 512 + 128 * mh, CD, PROJ + r0 * NPROJ + 2560 + 128 * mh, NPROJ, SCA + (size_t)st * CS, SCM + (size_t)st * CS, CS,
                           NUM + (size_t)17 * 1048576 + r0 * 512 + 128 * mh, 512, DEN + (size_t)115 * 1048576 + r0 * 4 + mh, 4, F.lds, flags);
          __syncthreads();
          if (blockIdx.x == 0 && F.tid == 0) ((volatile LAS unsigned long long*)(F.lds + MISC_OFF + 64))[1] += __builtin_amdgcn_s_memrealtime() - t0;
          if (F.tid < 64) flags[F.tid] = 0u;
          __syncthreads(); }
#endif
        mlstm_coop32<1, 4>(F.wave, 64 * half, half == 0, QKC + r0 * CD + 128 * mh, QKC + r0 * CD + 512 + 128 * mh, CD, PROJ + r0 * NPROJ + 2560 + 128 * mh, NPROJ, SCA + (size_t)st * CS, SCM + (size_t)st * CS, CS,
                           NUM + r0 * 512 + 128 * mh, 512, DEN + r0 * 4 + mh, 4, F.lds, flags);
#endif
        return;
    }
#endif
#ifndef NO_SB
    const int worker = (wg - MLWG) * NWAVES + F.wave;
    constexpr int NWORK = (256 - MLWG) * NWAVES, NUNIT = CB * 8 * (CS / 32);
    for (int u = worker; u < NUNIT; u += NWORK) {
        const int bh = u / (CS / 32), qb = u % (CS / 32), b = bh >> 3, h = bh & 7;
        const size_t r0 = (size_t)b * CS;
        sb_attn_unit(PROJ + r0 * NPROJ + 64 * h, PROJ + r0 * NPROJ + 512 + 64 * h, NPROJ, VT + (size_t)bh * 64 * CS, CS, MIXCAT + r0 * CD + 64 * h, CD, 32 * qb);
    }
#endif
}
__device__ __forceinline__ void mlstm_post_pass(const Frame& F, const GAS bf16_t* NUM, const GAS float* DEN, const GAS float* SCE, const GAS bf16_t* PROJ, const GAS float* head_g, GAS bf16_t* MIXCAT) {
    const int hd = F.lane >> 4;
    f32x4 g0 = *(const GAS f32x4*)(head_g + 8 * F.lane), g1 = *(const GAS f32x4*)(head_g + 8 * F.lane + 4);
    for (int row = F.gw; row < CM; row += F.NGW) {
        const u32x4 nv = ld16(NUM + (size_t)row * 512 + 8 * F.lane), ov = ld16(PROJ + (size_t)row * NPROJ + 3072 + 8 * F.lane);
        const float den = DEN[(size_t)row * 4 + hd], emt = SCE[(size_t)((row / CS) * 4 + hd) * CS + (row % CS)];
        const float inv = __builtin_amdgcn_rcpf(fmaxf(fabsf(den), emt));
        float hvv[8]; float ss = 0.f;
#pragma unroll
        for (int q = 0; q < 4; ++q) { hvv[2 * q] = bf2f((unsigned short)(nv[q] & 0xffffu)) * inv; hvv[2 * q + 1] = bf2f((unsigned short)(nv[q] >> 16)) * inv; ss += hvv[2 * q] * hvv[2 * q] + hvv[2 * q + 1] * hvv[2 * q + 1]; }
        ss += __shfl_xor(ss, 1); ss += __shfl_xor(ss, 2); ss += __shfl_xor(ss, 4); ss += __shfl_xor(ss, 8);
        const float rs = __builtin_amdgcn_rsqf(ss * (1.0f / 128.0f) + NORM_EPS);
        u32x4 o;
#pragma unroll
        for (int q = 0; q < 4; ++q) {
            const float ga = (q < 2) ? g0[2 * q] : g1[2 * q - 4], gb = (q < 2) ? g0[2 * q + 1] : g1[2 * q - 3];
            const float a = hvv[2 * q] * rs * ga * sigmoidf_(bf2f((unsigned short)(ov[q] & 0xffffu)));
            const float b = hvv[2 * q + 1] * rs * gb * sigmoidf_(bf2f((unsigned short)(ov[q] >> 16)));
            o[q] = pk2(a, b);
        }
        *(GAS u32x4*)(MIXCAT + (size_t)row * CD + 512 + 8 * F.lane) = o;
    }
}
#ifndef PH_MASK
#define PH_MASK 0xFFFFFFFFu
#endif
#define PH(k) ((PH_MASK >> (k)) & 1u)
#ifndef PROBE_MASK
#define PROBE_MASK 0u
#endif
#define REPS(k) (((PROBE_MASK >> (k)) & 1u) ? 2 : 1)
#ifndef PROBE_T
#define PROBE_T 0u
#endif
#define TWORDS ((volatile LAS unsigned long long*)((LAS unsigned char*)lds_raw + MISC_OFF + 64))
#ifndef PROBE_BLK
#define PROBE_BLK 0
#endif
#ifdef CLK_PHASE
#define CLKS(k) do { if ((k) == CLK_PHASE && blockIdx.x == PROBE_BLK && T0_()) TWORDS[2] = __builtin_amdgcn_s_memtime(); } while (0)
#define CLKE(k) do { if ((k) == CLK_PHASE && blockIdx.x == PROBE_BLK && T0_()) TWORDS[1] += (__builtin_amdgcn_s_memtime() - TWORDS[2]) / 100ull; } while (0)
#else
#define CLKS(k) do {} while (0)
#define CLKE(k) do {} while (0)
#endif
#define TSTART(k) do { if (((PROBE_T >> (k)) & 1u) && blockIdx.x == PROBE_BLK && T0_()) TWORDS[0] = __builtin_amdgcn_s_memrealtime(); } while (0)
#define TEND(k) do { if (((PROBE_T >> (k)) & 1u) && blockIdx.x == PROBE_BLK && T0_()) TWORDS[1] += __builtin_amdgcn_s_memrealtime() - TWORDS[0]; } while (0)
struct Args { Inputs in; float* out; unsigned char* ws; };
__device__ __forceinline__ Frame make_frame(LAS unsigned char* lds, int wave_s) {
    Frame F; int bx = blockIdx.x; asm volatile("" : "+s"(bx)); int wv = wave_s; asm volatile("" : "+s"(wv));
    F.lds = lds; F.lane = lane_id(); F.wave = wv; F.tid = wv * 64 + F.lane;
    F.G = gridDim.x; F.vcu = (bx % 8) * (F.G / 8) + bx / 8;
    F.gw = F.vcu * NWAVES + F.wave; F.NGW = F.G * NWAVES; return F;
}
#define PHASE_BEGIN Frame F = make_frame((LAS unsigned char*)lds_raw, wave_s_); unsigned char* wsg_ = args.ws; asm volatile("" : "+s"(wsg_)); GAS unsigned char* ws = (GAS unsigned char*)wsg_; (void)F; \
    GAS bf16_t* Wb = (GAS bf16_t*)(ws + WS_W); GAS bf16_t* U = (GAS bf16_t*)(ws + WS_U); (void)Wb; (void)U; GAS float* HOUT = (GAS float*)args.out; (void)HOUT;
#define T0_() (wave_s_ == 0 && lane_id() == 0)
#define GRID_BAR() do { unsigned char* wsb = args.ws; asm volatile("" : "+s"(wsb)); XcdBarrier bar; bar.bar = (unsigned*)(wsb + WS_CTL) + CW_BAR; bar.x = xb_xcc_id(); \
    bar.st = (volatile LAS unsigned*)((LAS unsigned char*)lds_raw + MISC_OFF) + 8; xcd_barrier(bar, T0_()); } while (0)
__global__ void __launch_bounds__(NWAVES * 64, 2) hybrid_fwd(Args args) {
    extern __shared__ __attribute__((aligned(16))) unsigned char lds_raw[];
    const int wave_s_ = __builtin_amdgcn_readfirstlane((int)(threadIdx.x >> 6));
    {
        LAS unsigned char* l3 = (LAS unsigned char*)lds_raw;
        for (int u = threadIdx.x; u < (LDS_BYTES - LDSCTL_OFF) / 4; u += NWAVES * 64) ((LAS unsigned*)(l3 + LDSCTL_OFF))[u] = 0u;
        __syncthreads();
        (void)xcd_barrier_post((unsigned*)(args.ws + WS_CTL) + CW_BAR, (volatile LAS unsigned*)(l3 + MISC_OFF) + 8, T0_());
    }
    const Inputs& in = args.in;
    {
        PHASE_BEGIN
        if (PH(0)) { convert_layer(F, in, Wb, 0); }
        __syncthreads();
        if (PH(1)) { RowPassArgs A{INP(0), nullptr, nullptr, nullptr, U, INP(1) + 0, 0, INP(2), INP(3), (GAS float*)(ws + WS_GATES)}; row_pass<2>(F, A); }
    }
    GRID_BAR();

    for (int L = 0; L < 4; ++L) {
        if ((L & 1) == 0) {
            const int e = L >> 1;
            TSTART(2); CLKS(2);
            if (PH(2)) {
                PHASE_BEGIN
                pg8::ProbPlain<1024, 1024, 16> P{U, Wb + W_IN}; pg8::StaticOrder S; S.init(CM, NPROJ, F.G, (int)blockIdx.x);
                pg8::EpiStore E{(GAS bf16_t*)(ws + WS_PROJ), NPROJ, 0, 0, 0, nullptr};
                pg8::gemm_phase(F.lds, F.wave, P, S, E);
            }
            GRID_BAR();
            CLKE(2); TEND(2);
            TSTART(3); CLKS(3);
            if (PH(3)) { PHASE_BEGIN conv_vt_pass(F, (const GAS bf16_t*)(ws + WS_PROJ), INP(4) + (size_t)e * 4 * 1024, (GAS bf16_t*)(ws + WS_QKC), (GAS bf16_t*)(ws + WS_VT), (const GAS float*)(ws + WS_GATES), (GAS float*)(ws + WS_SCA), (GAS float*)(ws + WS_SCM), (GAS float*)(ws + WS_EMT)); }
            GRID_BAR();
            CLKE(3); TEND(3);
            TSTART(4); CLKS(4);
            if (PH(4)) { PHASE_BEGIN mixers_even_phase(F, (const GAS bf16_t*)(ws + WS_PROJ), (const GAS bf16_t*)(ws + WS_QKC), (const GAS bf16_t*)(ws + WS_VT), (const GAS float*)(ws + WS_SCA), (const GAS float*)(ws + WS_SCM), U  , (GAS bf16_t*)(ws + WS_NUM), (GAS float*)(ws + WS_DEN)); }
#ifdef E3_PRE
            __syncthreads(); CLKE(4); TEND(4);
#endif
            GRID_BAR();
#ifndef E3_PRE
            CLKE(4); TEND(4);
#endif
            TSTART(5); CLKS(5);
            if (PH(5)) { PHASE_BEGIN mlstm_post_pass(F, (const GAS bf16_t*)(ws + WS_NUM), (const GAS float*)(ws + WS_DEN), (const GAS float*)(ws + WS_EMT), (const GAS bf16_t*)(ws + WS_PROJ), INP(5) + (size_t)e * 512, U); }
            GRID_BAR();
            CLKE(5); TEND(5);
        } else {
            const int o = L >> 1;
            TSTART(6); CLKS(6);
            if (PH(6)) { PHASE_BEGIN mix_pass(F, U, INP(7) + (size_t)o * 6 * 1024, (GAS bf16_t*)(ws + WS_XR), (GAS bf16_t*)(ws + WS_XK), (GAS bf16_t*)(ws + WS_XV)); }
            GRID_BAR();
            CLKE(6); TEND(6);
            TSTART(7); CLKS(7);
            if (PH(7)) {
                PHASE_BEGIN
                pg8::ProbRkv P{(const GAS bf16_t*)(ws + WS_XR), (size_t)(WS_XK - WS_XR) / 2, Wb + W_RKV, U, Wb + W_LB1, (long)(W_LB2 - W_LB1) * 2};
                pg8::RkvOrder S{F.vcu};
                pg8::EpiStore E{(GAS bf16_t*)(ws + WS_RO), 1024, 0, 1, (size_t)(WS_KO - WS_RO) / 2, (GAS bf16_t*)(ws + WS_LORA)};
                pg8::gemm_phase(F.lds, F.wave, P, S, E);
            }
            GRID_BAR();
            CLKE(7); TEND(7);
            TSTART(8); CLKS(8);
            if (PH(8)) {
                PHASE_BEGIN
                RwkvPrepArgs P{(const GAS bf16_t*)(ws + WS_RO), (const GAS bf16_t*)(ws + WS_KO), CD, (const GAS bf16_t*)(ws + WS_LORA), 256, Wb + W_W2T, Wb + W_A2T, INP(9) + (size_t)o * 1024, INP(12) + (size_t)o * 1024, INP(17) + (size_t)o * 1024, INP(18) + (size_t)o * 1024,
                               INP(19) + (size_t)o * 1024, (GAS bf16_t*)(ws + WS_KT), (GAS bf16_t*)(ws + WS_BT), (GAS bf16_t*)(ws + WS_KK), (GAS bf16_t*)(ws + WS_RT), (GAS float*)(ws + WS_GL), (GAS float*)(ws + WS_BONUS)};
                rwkv_prep_loop(P, F.gw, F.NGW, (CM / 16) * 16, F.lds + F.wave * 10752);
            }
            GRID_BAR();
            CLKE(8); TEND(8);
            TSTART(9); CLKS(9);
            if (PH(9)) {
                PHASE_BEGIN
#ifdef LAT_PROBE
                if (blockIdx.x == LAT_PROBE && T0_()) {
                    const GAS unsigned* base = (const GAS unsigned*)(ws + WS_KT) + (size_t)(blockIdx.x >> 4) * CS * 512 + (blockIdx.x & 15) * 32; unsigned x = 0;
                    const unsigned long long t0 = __builtin_amdgcn_s_memrealtime();
                    for (int i = 0; i < 256; ++i) { x = base[(size_t)(i * 16 + (x & 1u)) * 512]; }
                    const unsigned long long t1 = __builtin_amdgcn_s_memrealtime();
                    TWORDS[1] += (t1 - t0) + (x == 0x12345u ? 1 : 0);
                }
#endif
#ifdef CLK_PROBE
                if (blockIdx.x == 0 && T0_()) TWORDS[2] = __builtin_amdgcn_s_memtime();
#endif
                if (blockIdx.x < 128) {
                    if (F.tid < 64) ((LAS unsigned*)(F.lds + RWS_FLAGS))[F.tid] = 0u;
                    __syncthreads();
                    const int bh = blockIdx.x, b = bh >> 4, h = bh & 15;
                    const size_t r0 = (size_t)b * CS, co = 64 * h;
                    rwkv_scan_coop(F.wave, (const GAS bf16_t*)(ws + WS_KT) + r0 * CD + co, (const GAS bf16_t*)(ws + WS_BT) + r0 * CD + co, (const GAS bf16_t*)(ws + WS_KK) + r0 * CD + co, (const GAS bf16_t*)(ws + WS_RT) + r0 * CD + co,
                                   (const GAS bf16_t*)(ws + WS_VO) + r0 * CD + co, CD, (const GAS float*)(ws + WS_GL) + (r0 / 16) * 1024 + co, CS, (GAS bf16_t*)(ws + WS_YRAW) + r0 * CD + co, CD, F.lds);
#ifdef COOP_PROBE
                    __syncthreads(); if (blockIdx.x == 0 && T0_()) TWORDS[1] += ((LAS unsigned*)(F.lds + RWS_FLAGS))[32 + COOP_PROBE];
#endif
#ifdef CLK_PROBE
                    if (blockIdx.x == 0 && T0_()) TWORDS[1] += (__builtin_amdgcn_s_memtime() - TWORDS[2]) / 100ull;
#endif
                }
            }
#ifdef R9_PRE
            __syncthreads(); CLKE(9); TEND(9);
#endif
            GRID_BAR();
#ifndef R9_PRE
            CLKE(9); TEND(9);
#endif
            TSTART(10); CLKS(10);
            if (PH(10)) {
                PHASE_BEGIN
                rwkv_post_loop((const GAS bf16_t*)(ws + WS_YRAW), (const GAS bf16_t*)(ws + WS_VO), (const GAS bf16_t*)(ws + WS_LORA), Wb + W_G2T, (const GAS float*)(ws + WS_BONUS), INP(20) + (size_t)o * 1024, INP(21) + (size_t)o * 1024, (GAS bf16_t*)(ws + WS_YG), CD, F.gw, F.NGW, (CM / 16) * 16, F.lds + F.wave * 10752);
            }
            GRID_BAR();
            CLKE(10); TEND(10);
        }
        TSTART(11); CLKS(11);
        if (PH(11)) {
            PHASE_BEGIN
            const bool odd = (L & 1) != 0;
            pg8::ProbPlain<1024, 1024, 16> P{odd ? (const GAS bf16_t*)(ws + WS_YG) : (const GAS bf16_t*)U, Wb + (odd ? W_OUTO : W_OUTE)}; pg8::StaticOrder S; S.init(CM, CD, F.G, (int)blockIdx.x);
            pg8::EpiStore E{(GAS bf16_t*)(ws + WS_MIX), CD, 0, 0, 0, nullptr};
            pg8::gemm_phase(F.lds, F.wave, P, S, E);
        }
        GRID_BAR();
        CLKE(11); TEND(11);
        TSTART(12); CLKS(12);
        if (PH(12)) { PHASE_BEGIN const GAS float* ng = INP(1) + (size_t)L * 4 * 1024; RowPassArgs A{L == 0 ? INP(0) : HOUT, (const GAS bf16_t*)(ws + WS_MIX), ng + 1 * 1024, HOUT, U, ng + 2 * 1024, 0, nullptr, nullptr, nullptr}; row_pass<4>(F, A); }
        GRID_BAR();
        CLKE(12); TEND(12);
#ifdef CLK_PROBE2
        if (blockIdx.x == 0 && T0_()) TWORDS[2] = __builtin_amdgcn_s_memtime();
#endif
        TSTART(13); CLKS(13);
        if (PH(13)) {
            PHASE_BEGIN
            pg8::ProbPlain<1024, 1024, 16> P{U, Wb + W_UP}; pg8::StaticOrder S; S.init(CM, FF, F.G, (int)blockIdx.x);
            pg8::EpiStore E{(GAS bf16_t*)(ws + WS_HID), FF, 1, 0, 0, nullptr};
            pg8::gemm_phase(F.lds, F.wave, P, S, E);
        }
        GRID_BAR();
#ifdef CLK_PROBE2
        if (blockIdx.x == 0 && T0_()) TWORDS[1] += (__builtin_amdgcn_s_memtime() - TWORDS[2]) / 100ull;
#endif
        CLKE(13); TEND(13);
        TSTART(14); CLKS(14);
        if (PH(14)) {
            PHASE_BEGIN
            pg8::ProbPlain<FF, FF, 64> P{(const GAS bf16_t*)(ws + WS_HID), Wb + W_DN}; pg8::StaticOrder S; S.init(CM, CD, F.G, (int)blockIdx.x);
            pg8::EpiStore E{(GAS bf16_t*)(ws + WS_FFO), CD, 0, 0, 0, nullptr};
            pg8::gemm_phase(F.lds, F.wave, P, S, E);
        }
        GRID_BAR();
        CLKE(14); TEND(14);
        TSTART(15); CLKS(15);
        if (PH(15)) {
            PHASE_BEGIN
            const GAS float* ng = INP(1) + (size_t)L * 4 * 1024;
            const bool lastL = (L == 3); const bool next_even = ((L + 1) & 1) == 0;
            if (!lastL) { convert_layer(F, in, Wb, L + 1); }
            __syncthreads();
            const GAS float* ngn = INP(1) + (size_t)(L + 1) * 4 * 1024;
            const bool gts = !lastL && next_even;
            RowPassArgs A{HOUT, (const GAS bf16_t*)(ws + WS_FFO), ng + 3 * 1024, HOUT, lastL ? nullptr : U, lastL ? nullptr : ngn, next_even ? 0 : 1,
                          gts ? INP(2) + (size_t)((L + 1) >> 1) * 1024 * PITCH_WIN : nullptr, gts ? INP(3) + (size_t)((L + 1) >> 1) * 8 : nullptr, gts ? (GAS float*)(ws + WS_GATES) : nullptr};
            row_pass<2>(F, A);
        }
        if (L < 3) GRID_BAR();
        CLKE(15); TEND(15);
    }
#ifdef BAR_PROBE
    for (int i = 0; i < BAR_PROBE; ++i) GRID_BAR();
#endif
    if (PROBE_T != 0u && blockIdx.x == PROBE_BLK && T0_()) {
        const unsigned long long te = __builtin_amdgcn_s_memrealtime() + 4ull * TWORDS[1];
        while (__builtin_amdgcn_s_memrealtime() < te) __builtin_amdgcn_s_sleep(8);
    }
}

extern "C" void kernel_launch(void* const* d_in, const int* in_sizes, int n_in, void* d_out, int out_size, void* d_ws, size_t ws_size, hipStream_t stream) {
    static int grid = 0;
    if (grid == 0) {
        if (n_in != 25 || out_size != CM * CD || ws_size < WS_END) { fprintf(stderr, "kernel_launch: unexpected shapes (n_in %d, out %d, ws %zu)\n", n_in, out_size, ws_size); grid = -1; return; }
        int dev = 0, cus = 0, per_cu = 0;
        if (hipGetDevice(&dev) != hipSuccess || hipDeviceGetAttribute(&cus, hipDeviceAttributeMultiprocessorCount, dev) != hipSuccess) { grid = -1; return; }
        if (hipFuncSetAttribute((const void*)hybrid_fwd, hipFuncAttributeMaxDynamicSharedMemorySize, LDS_BYTES) != hipSuccess) { grid = -1; return; }
        if (hipOccupancyMaxActiveBlocksPerMultiprocessor(&per_cu, (const void*)hybrid_fwd, NWAVES * 64, LDS_BYTES) != hipSuccess || per_cu < 1) fprintf(stderr, "kernel_launch: occupancy query reports %d\n", per_cu);
        (void)hipGetLastError();
        grid = cus;
        if (grid != 256) fprintf(stderr, "kernel_launch: %d CUs (the phase deals assume 256)\n", grid);
    }
    if (grid < 0) return;
    if (hipMemsetAsync((char*)d_ws + WS_CTL, 0, CTL_ZERO_BYTES, stream) != hipSuccess) return;
    Args a{};
    for (int i = 0; i < 25; ++i) a.in.p[i] = (const float*)d_in[i];
    a.out = (float*)d_out; a.ws = (unsigned char*)d_ws;
    hipLaunchKernelGGL(hybrid_fwd, dim3(grid), dim3(NWAVES * 64), LDS_BYTES, stream, a);
}
```

```cpp
#include <hip/hip_runtime.h>
#include <cstdio>
#include <cstdint>
typedef short bf16x8 __attribute__((ext_vector_type(8)));
typedef short s16x4 __attribute__((ext_vector_type(4)));
typedef float f32x4 __attribute__((ext_vector_type(4)));
typedef float f32x16 __attribute__((ext_vector_type(16)));
typedef unsigned u32x4 __attribute__((ext_vector_type(4)));
typedef unsigned u32x2 __attribute__((ext_vector_type(2)));
#ifdef HOST_EMU
#define GQ
#define LDSQ
#define DI inline
DI int lane_id() { return emu_lane(); }
DI s16x4 TR16(const LDSQ void* p) { return emu_tr16(p); }
DI unsigned short f2bf(float f) { return (unsigned short)emu_f2bf(f); }
#define MEMFENCE() do {} while (0)
#define WAVE_SYNC() emu_sync()
#define SCHED_FENCE() do {} while (0)
#else
#define LDSQ __attribute__((address_space(3)))
#define GQ __attribute__((address_space(1)))
#define DI __device__ __forceinline__
typedef short v4i16_t __attribute__((ext_vector_type(4)));
typedef __bf16 bf16x2_t __attribute__((ext_vector_type(2)));
typedef float f32x2_t __attribute__((ext_vector_type(2)));
DI int lane_id() { int l; asm volatile("v_mbcnt_lo_u32_b32 %0, -1, 0\n\tv_mbcnt_hi_u32_b32 %0, -1, %0" : "=&v"(l)); return l; }
DI s16x4 TR16(const LDSQ void* p) { return __builtin_bit_cast(s16x4, __builtin_amdgcn_ds_read_tr16_b64_v4i16((LDSQ v4i16_t*)p)); }
DI unsigned short f2bf(float f) { f32x2_t v = {f, 0.f}; bf16x2_t b = __builtin_convertvector(v, bf16x2_t); return (unsigned short)(__builtin_bit_cast(unsigned, b) & 0xffffu); }
#define MEMFENCE() asm volatile("" ::: "memory")
#define WAVE_SYNC() do {} while (0)
#define SCHED_FENCE() __builtin_amdgcn_sched_barrier(0)
#endif
typedef unsigned short bf16_t;
#ifdef HOST_EMU
#define ROW_SHR(v, d) ((lane_id() & 15) >= (d) ? __shfl_up((v), (d), 16) : (__shfl_up((v), (d), 16), 0.f))
#else
#define ROW_SHR(v, d) __builtin_bit_cast(float, __builtin_amdgcn_update_dpp(0, __builtin_bit_cast(int, (v)), 0x110 + (d), 0xF, 0xF, true))
#endif
#ifdef HOST_EMU
#define WSHFL_UP(v, d, lane) __shfl_up((v), (d), 64)
#define SHX(v, m, lane) __shfl_xor((v), (m))
#define WLAST(v) __shfl((v), 63, 64)
#define WLANE(v, k) __shfl((v), (k), 64)
#else
#define WSHFL_UP(v, d, lane) __builtin_bit_cast(float, __builtin_amdgcn_ds_bpermute(((lane) - (d)) << 2, __builtin_bit_cast(int, (v))))
#define SHX(v, m, lane) __builtin_bit_cast(float, __builtin_amdgcn_ds_bpermute(((lane) ^ (m)) << 2, __builtin_bit_cast(int, (v))))
#define WLAST(v) __builtin_bit_cast(float, __builtin_amdgcn_readlane(__builtin_bit_cast(int, (v)), 63))
#define WLANE(v, k) __builtin_bit_cast(float, __builtin_amdgcn_readlane(__builtin_bit_cast(int, (v)), (k)))
#endif
DI float bf2f(unsigned short s) { unsigned u = ((unsigned)s) << 16; return __builtin_bit_cast(float, u); }
DI unsigned pk2(float lo, float hi) {
#ifdef HOST_EMU
    return (unsigned)f2bf(lo) | ((unsigned)f2bf(hi) << 16);
#else
    f32x2_t v = {lo, hi}; bf16x2_t b = __builtin_convertvector(v, bf16x2_t); return __builtin_bit_cast(unsigned, b);
#endif
}
DI f32x4 mfma16(bf16x8 a, bf16x8 b, f32x4 c) { return __builtin_amdgcn_mfma_f32_16x16x32_bf16(a, b, c, 0, 0, 0); }
DI f32x16 mfma32(bf16x8 a, bf16x8 b, f32x16 c) { return __builtin_amdgcn_mfma_f32_32x32x16_bf16(a, b, c, 0, 0, 0); }
DI bf16x8 mk8(u32x2 lo, u32x2 hi) { u32x4 v = {lo.x, lo.y, hi.x, hi.y}; return __builtin_bit_cast(bf16x8, v); }
DI u32x2 pack4(f32x4 v) { u32x2 r = {pk2(v[0], v[1]), pk2(v[2], v[3])}; return r; }
DI u32x2 ld8(const GQ bf16_t* p) { return *(const GQ u32x2*)p; }
DI u32x4 ld16(const GQ bf16_t* p) { return *(const GQ u32x4*)p; }
DI u32x2 tr2(s16x4 v) { return __builtin_bit_cast(u32x2, v); }
DI u32x2 ldl8(const LDSQ unsigned char* p) { return *(const LDSQ u32x2*)p; }
DI float fexp(float x) { return __builtin_amdgcn_exp2f(x * 1.4426950408889634f); }
DI float flog(float x) { return __builtin_amdgcn_logf(x) * 0.6931471805599453f; }
DI float softplusf(float x) { return fmaxf(x, 0.f) + flog(1.0f + fexp(-fabsf(x))); }
DI float sigmoidf_(float x) { return __builtin_amdgcn_rcpf(1.0f + fexp(-x)); }
DI float tanhf_(float x) { const float xc = fminf(fmaxf(x, -15.f), 15.f); const float e = fexp(2.f * xc); return (e - 1.f) * __builtin_amdgcn_rcpf(e + 1.f); }

#define SB_STOP 36.0f
DI int crow32(int i, int h) { return (i & 3) + 8 * (i >> 2) + 4 * h; }
DI void sb_attn_unit(const GQ bf16_t* __restrict__ Q, const GQ bf16_t* __restrict__ K, int ldqk, const GQ bf16_t* __restrict__ V, int ldv, LDSQ unsigned char* vtile, GQ bf16_t* __restrict__ O, int ldo, int t0  ) {
    const int lane = lane_id(), r = lane & 31, hi = lane >> 5;
    bf16x8 qf[4];
#pragma unroll
    for (int s = 0; s < 4; ++s) qf[s] = __builtin_bit_cast(bf16x8, ld16(Q + (size_t)(t0 + r) * ldqk + 16 * s + 8 * hi));
    f32x16 o0, o1;
#pragma unroll
    for (int i = 0; i < 16; ++i) { o0[i] = 0.f; o1[i] = 0.f; }
    float carry = 0.f;
    const int tq = t0 + r;
    u32x4 kn[4]; u32x4 vn[4];
    int s0 = t0;
#define SB_LOAD(kd, vd, s0_) do { \
    _Pragma("unroll") for (int s = 0; s < 4; ++s) kd[s] = ld16(K + (size_t)((s0_) + r) * ldqk + 16 * s + 8 * hi); \
    _Pragma("unroll") for (int i = 0; i < 4; ++i) vd[i] = ld16(V + (size_t)((s0_) + 8 * i + (lane >> 3)) * ldv + 8 * (lane & 7)); } while (0)
    SB_LOAD(kn, vn, s0);
    for (;;) {
        u32x4 kc[4];
#pragma unroll
        for (int s = 0; s < 4; ++s) kc[s] = kn[s];
#pragma unroll
        for (int i = 0; i < 4; ++i) *(LDSQ u32x4*)(vtile + (8 * i + (lane >> 3)) * 144 + (lane & 7) * 16) = vn[i];
        MEMFENCE(); WAVE_SYNC();
        const int sn = s0 - 32;
        if (sn >= 0) SB_LOAD(kn, vn, sn);
        f32x16 z;
#pragma unroll
        for (int i = 0; i < 16; ++i) z[i] = 0.f;
#pragma unroll
        for (int s = 0; s < 4; ++s) z = mfma32(__builtin_bit_cast(bf16x8, kc[s]), qf[s], z);
        float sp[16];
        const bool diag = (s0 == t0);
#pragma unroll
        for (int i = 0; i < 16; ++i) { z[i] *= 0.125f; const bool valid = !diag || (s0 + crow32(i, hi) < tq); sp[i] = valid ? softplusf(z[i]) : 0.f; if (!valid) z[i] = -1e30f; }
        float gs[4], pg[4];
#pragma unroll
        for (int g = 0; g < 4; ++g) gs[g] = (sp[4 * g] + sp[4 * g + 1]) + (sp[4 * g + 2] + sp[4 * g + 3]);
#pragma unroll
        for (int g = 0; g < 4; ++g) pg[g] = SHX(gs[g], 32, lane);
        float after[4];
        {
            const float o3 = 0.f, o2 = gs[3], o1_ = gs[3] + gs[2], o0_ = o1_ + gs[1];
            const float p3i = pg[3], p2i = pg[3] + pg[2], p1i = p2i + pg[1], p0i = p1i + pg[0];
            const float pe3 = 0.f, pe2 = p3i, pe1 = p2i, pe0 = p1i;
            after[0] = o0_ + (hi ? pe0 : p0i); after[1] = o1_ + (hi ? pe1 : p1i); after[2] = o2 + (hi ? pe2 : p2i); after[3] = o3 + (hi ? pe3 : p3i);
        }
        const float tot = (gs[0] + gs[1]) + (gs[2] + gs[3]) + (pg[0] + pg[1]) + (pg[2] + pg[3]);
        f32x16 p;
#pragma unroll
        for (int g = 0; g < 4; ++g) {
            float c = carry + after[g];
#pragma unroll
            for (int j = 3; j >= 0; --j) { c += sp[4 * g + j]; p[4 * g + j] = fexp(z[4 * g + j] - c); }
        }
        carry += tot;
#pragma unroll
        for (int s = 0; s < 2; ++s) {
            u32x4 pb = {pk2(p[8 * s], p[8 * s + 1]), pk2(p[8 * s + 2], p[8 * s + 3]), pk2(p[8 * s + 4], p[8 * s + 5]), pk2(p[8 * s + 6], p[8 * s + 7])};
            const bf16x8 pbv = __builtin_bit_cast(bf16x8, pb);
            const int vro = (16 * s + 4 * hi + ((lane & 15) >> 2)) * 144 + (16 * ((lane >> 4) & 1) + 4 * (lane & 3)) * 2;
            o0 = mfma32(mk8(tr2(TR16(vtile + vro)), tr2(TR16(vtile + vro + 8 * 144))), pbv, o0);
            o1 = mfma32(mk8(tr2(TR16(vtile + vro + 64)), tr2(TR16(vtile + vro + 8 * 144 + 64))), pbv, o1);
        }
        MEMFENCE(); WAVE_SYNC();
        if (sn < 0) break;
        if (__all(carry > SB_STOP)) break;
        s0 = sn;
    }
#undef SB_LOAD
#pragma unroll
    for (int g = 0; g < 4; ++g) {
        u32x2 w0 = {pk2(o0[4 * g], o0[4 * g + 1]), pk2(o0[4 * g + 2], o0[4 * g + 3])};
        u32x2 w1 = {pk2(o1[4 * g], o1[4 * g + 1]), pk2(o1[4 * g + 2], o1[4 * g + 3])};
        GQ bf16_t* op = O + (size_t)(t0 + r) * ldo + 8 * g + 4 * hi;
        *(GQ u32x2*)op = w0; *(GQ u32x2*)(op + 32) = w1;
    }
}

DI void mlstm_stream(const GQ bf16_t* __restrict__ Qp, const GQ bf16_t* __restrict__ Kp, int ldqk, const GQ bf16_t* __restrict__ Vp, int ldv, const GQ float* __restrict__ G, int gi, int gf,
                     int S, int den, GQ bf16_t* __restrict__ NUM, int ldn, GQ float* __restrict__ DEN, GQ float* __restrict__ EMT, int ldd, LDSQ unsigned char* lds) {
    const int lane = lane_id(), fr = lane & 15, fq = lane >> 4;
    LDSQ unsigned char* Kimg = lds;
    LDSQ unsigned char* Vimg = lds + 4096;
    f32x4 C[8];
#pragma unroll
    for (int ci = 0; ci < 8; ++ci) C[ci] = (f32x4){0.f, 0.f, 0.f, 0.f};
    float Fcarry = 0.f, Mcarry = 0.f;
    const int NC = S / 16;
    u32x2 qn[8], kn[8]; u32x4 vn = {0u, 0u, 0u, 0u}; float lin, lfn;
#define ML_LOAD(c_) do { const size_t row = (size_t)(16 * (c_) + fr); \
    _Pragma("unroll") for (int ks = 0; ks < 4; ++ks) { qn[2 * ks] = ld8(Qp + row * ldqk + 32 * ks + 4 * fq); qn[2 * ks + 1] = ld8(Qp + row * ldqk + 32 * ks + 16 + 4 * fq); \
        kn[2 * ks] = ld8(Kp + row * ldqk + 32 * ks + 4 * fq); kn[2 * ks + 1] = ld8(Kp + row * ldqk + 32 * ks + 16 + 4 * fq); } \
    if (!den && lane < 32) vn = ld16(Vp + (size_t)(16 * (c_) + (lane >> 1)) * ldv + 8 * (lane & 1)); \
    lin = G[row * 8 + gi]; lfn = G[row * 8 + gf]; } while (0)
    ML_LOAD(0);
    for (int c = 0; c < NC; ++c) {
        u32x2 qc[8], kc[8]; u32x4 vcur = vn; const float li = lin, lf = lfn;
#pragma unroll
        for (int i = 0; i < 8; ++i) { qc[i] = qn[i]; kc[i] = kn[i]; }
        if (c + 1 < NC) ML_LOAD(c + 1);
        MEMFENCE();
#pragma unroll
        for (int ks = 0; ks < 4; ++ks) { *(LDSQ u32x2*)(Kimg + fr * 256 + (32 * ks + 4 * fq) * 2) = kc[2 * ks]; *(LDSQ u32x2*)(Kimg + fr * 256 + (32 * ks + 16 + 4 * fq) * 2) = kc[2 * ks + 1]; }
        if (den) { if (lane < 32) { u32x4 e0 = {(lane & 1) ? 0u : 0x3F80u, 0u, 0u, 0u}; *(LDSQ u32x4*)(Vimg + (lane >> 1) * 32 + (lane & 1) * 16) = e0; } }
        else { if (lane < 32) *(LDSQ u32x4*)(Vimg + (lane >> 1) * 32 + (lane & 1) * 16) = vcur; }
        MEMFENCE();
        float inc = lf;
#pragma unroll
        for (int d = 1; d < 16; d <<= 1) { const float t = __shfl_up(inc, d, 16); if (fr >= d) inc += t; }
        const float Fg = Fcarry + inc, a = li - Fg;
        float mx = a;
#pragma unroll
        for (int d = 1; d < 16; d <<= 1) { const float t = __shfl_up(mx, d, 16); if (fr >= d) mx = fmaxf(mx, t); }
        const float Mx = fmaxf(Mcarry, mx);
        const float Mend = __shfl(Mx, 15, 16), Ftot = __shfl(inc, 15, 16);
        float as_[4], Mxs[4], Fgs[4];
#pragma unroll
        for (int i = 0; i < 4; ++i) { as_[i] = __shfl(a, 4 * fq + i, 16); Mxs[i] = __shfl(Mx, 4 * fq + i, 16); Fgs[i] = __shfl(Fg, 4 * fq + i, 16); }
        f32x4 st = {0.f, 0.f, 0.f, 0.f};
#pragma unroll
        for (int ks = 0; ks < 4; ++ks) st = mfma16(mk8(kc[2 * ks], kc[2 * ks + 1]), mk8(qc[2 * ks], qc[2 * ks + 1]), st);
        f32x4 pt;
#pragma unroll
        for (int i = 0; i < 4; ++i) pt[i] = (4 * fq + i <= fr) ? st[i] * fexp(as_[i] - Mx) : 0.f;
        const s16x4 v4 = TR16(Vimg + (4 * fq + (fr >> 2)) * 32 + 8 * (fr & 3));
        const u32x2 z2 = {0u, 0u};
        f32x4 numI = mfma16(mk8(pack4(pt), z2), mk8(tr2(v4), z2), (f32x4){0.f, 0.f, 0.f, 0.f});
        f32x4 inter = {0.f, 0.f, 0.f, 0.f};
#pragma unroll
        for (int ks = 0; ks < 4; ++ks) inter = mfma16(mk8(qc[2 * ks], qc[2 * ks + 1]), mk8(pack4(C[2 * ks]), pack4(C[2 * ks + 1])), inter);
        f32x4 num;
#pragma unroll
        for (int i = 0; i < 4; ++i) num[i] = numI[i] + fexp(Mcarry - Mxs[i]) * inter[i];
        if (den) {
            if (fr == 0) {
#pragma unroll
                for (int i = 0; i < 4; ++i) { const size_t row = (size_t)(16 * c + 4 * fq + i); DEN[row * ldd] = num[i]; EMT[row * ldd] = fexp(-(Fgs[i] + Mxs[i])); }
            }
        } else {
#pragma unroll
            for (int i = 0; i < 4; ++i) NUM[(size_t)(16 * c + 4 * fq + i) * ldn + fr] = f2bf(num[i]);
        }
        const float wstate = fexp(Mcarry - Mend);
        f32x4 vw;
#pragma unroll
        for (int i = 0; i < 4; ++i) vw[i] = bf2f((unsigned short)v4[i]) * fexp(as_[i] - Mend);
        const bf16x8 vwb = mk8(pack4(vw), z2);
#pragma unroll
        for (int ci = 0; ci < 8; ++ci) {
            const s16x4 k4 = TR16(Kimg + (4 * fq + (fr >> 2)) * 256 + (16 * ci + 4 * (fr & 3)) * 2);
            C[ci] = mfma16(mk8(tr2(k4), z2), vwb, C[ci] * wstate);
        }
        Mcarry = Mend; Fcarry += Ftot;
        MEMFENCE();
    }
#undef ML_LOAD
}

struct RwkvPrepArgs {
    const GQ bf16_t *R, *K; int ld;
    const GQ bf16_t* LORA; int ldl;
    const GQ bf16_t *W2T, *A2T;
    const GQ float *w0, *a0, *k_k, *k_a, *r_k;
    GQ bf16_t *KT, *BT, *KK, *RT;
    GQ float* GL;
    GQ float* BONUS;
};
struct RwkvPrepIn { u32x4 lw[2], la[2]; u32x2 r2[4], k2[4]; };
DI void rwkv_prep_load(const RwkvPrepArgs& P, int chunk, int h, RwkvPrepIn& I) {
    const int lane = lane_id(), fr = lane & 15, fq = lane >> 4;
    const size_t row = (size_t)chunk * 16 + fr;
#pragma unroll
    for (int s = 0; s < 2; ++s) { I.lw[s] = ld16(P.LORA + row * P.ldl + 32 * s + 8 * fq); I.la[s] = ld16(P.LORA + row * P.ldl + 64 + 32 * s + 8 * fq); }
#pragma unroll
    for (int ti = 0; ti < 4; ++ti) { const int ch0 = 64 * h + 16 * ti + 4 * fq; I.r2[ti] = ld8(P.R + row * P.ld + ch0); I.k2[ti] = ld8(P.K + row * P.ld + ch0); }
}
DI void rwkv_prep_compute(const RwkvPrepArgs& P, int chunk, int h, const RwkvPrepIn& I) {
    const int lane = lane_id(), fr = lane & 15, fq = lane >> 4;
    const size_t row = (size_t)chunk * 16 + fr;
    bf16x8 bw[2], ba[2];
#pragma unroll
    for (int s = 0; s < 2; ++s) {
        u32x4 t;
#pragma unroll
        for (int j = 0; j < 4; ++j) { const unsigned w = I.lw[s][j]; t[j] = pk2(tanhf_(bf2f((unsigned short)(w & 0xffffu))), tanhf_(bf2f((unsigned short)(w >> 16)))); }
        bw[s] = __builtin_bit_cast(bf16x8, t);
        ba[s] = __builtin_bit_cast(bf16x8, I.la[s]);
    }
    float ss = 0.f, bon = 0.f;
    float kap[16], av[16], kp[16], rv[16], ld_[16];
#pragma unroll
    for (int ti = 0; ti < 4; ++ti) {
        const int chl = 16 * ti + fr;
        f32x4 dw = {0.f, 0.f, 0.f, 0.f}, da = {0.f, 0.f, 0.f, 0.f};
#pragma unroll
        for (int s = 0; s < 2; ++s) {
            dw = mfma16(__builtin_bit_cast(bf16x8, ld16(P.W2T + (size_t)(64 * h + chl) * 64 + 32 * s + 8 * fq)), bw[s], dw);
            da = mfma16(__builtin_bit_cast(bf16x8, ld16(P.A2T + (size_t)(64 * h + chl) * 64 + 32 * s + 8 * fq)), ba[s], da);
        }
        const int ch0 = 64 * h + 16 * ti + 4 * fq;
        const u32x2 r2 = I.r2[ti], k2 = I.k2[ti];
        const f32x4 w0v = *(const GQ f32x4*)(P.w0 + ch0), a0v = *(const GQ f32x4*)(P.a0 + ch0), kkv = *(const GQ f32x4*)(P.k_k + ch0), kav = *(const GQ f32x4*)(P.k_a + ch0), rkv = *(const GQ f32x4*)(P.r_k + ch0);
#pragma unroll
        for (int i = 0; i < 4; ++i) {
            const int e = 4 * ti + i;
            const float r = bf2f((unsigned short)((i & 1) ? (r2[i >> 1] >> 16) : (r2[i >> 1] & 0xffffu)));
            const float k = bf2f((unsigned short)((i & 1) ? (k2[i >> 1] >> 16) : (k2[i >> 1] & 0xffffu)));
            const float wl = w0v[i] + dw[i];
            const float logw = -softplusf(-wl) - 0.5f;
            ld_[e] = -fexp(logw);
            const float a = sigmoidf_(a0v[i] + da[i]);
            const float kkr = k * kkv[i];
            ss += kkr * kkr;
            const float k1 = k * (1.0f + (a - 1.0f) * kav[i]);
            bon += r * k1 * rkv[i];
            kap[e] = kkr; av[e] = a; kp[e] = k1; rv[e] = r;
        }
    }
    ss += SHX(ss, 16, lane); ss += SHX(ss, 32, lane);
    bon += SHX(bon, 16, lane); bon += SHX(bon, 32, lane);
    const float rn = __builtin_amdgcn_rsqf(fmaxf(ss, 1e-24f));
    if (fq == 0) P.BONUS[row * 16 + h] = bon;
#pragma unroll
    for (int ti = 0; ti < 4; ++ti) {
        const int ch0 = 64 * h + 16 * ti + 4 * fq;
        f32x4 okt, obt, okk, ort, ogl;
#pragma unroll
        for (int i = 0; i < 4; ++i) {
            const int e = 4 * ti + i;
            float cs = ld_[e];
            cs += ROW_SHR(cs, 1); cs += ROW_SHR(cs, 2); cs += ROW_SHR(cs, 4); cs += ROW_SHR(cs, 8);
            const float gi = fexp(cs), ginv = __builtin_amdgcn_rcpf(gi);
            float gx = ROW_SHR(gi, 1); if (fr == 0) gx = 1.0f;
            const float kappa = kap[e] * rn;
            okt[i] = kappa * gx; obt[i] = kappa * av[e] * ginv; okk[i] = kp[e] * ginv; ort[i] = rv[e] * gi; ogl[i] = gi;
        }
        *(GQ u32x2*)(P.KT + row * P.ld + ch0) = pack4(okt);
        *(GQ u32x2*)(P.BT + row * P.ld + ch0) = pack4(obt);
        *(GQ u32x2*)(P.KK + row * P.ld + ch0) = pack4(okk);
        *(GQ u32x2*)(P.RT + row * P.ld + ch0) = pack4(ort);
        if (fr == 15) *(GQ f32x4*)(P.GL + (size_t)chunk * 1024 + ch0) = ogl;
    }
}
DI void rwkv_prep_unit(const RwkvPrepArgs& P, int chunk, int h) { RwkvPrepIn I; rwkv_prep_load(P, chunk, h, I); rwkv_prep_compute(P, chunk, h, I); }
constexpr int RPP = 144, RPT = 16 * RPP, RPL = 272, RP_R = 0, RP_K = RPT, RP_L = 2 * RPT, RP_BYTES = 4 * RPT;
#define RW_CHUNK(u_) ((((u_) >> 4) / ncs) * 256 + c0 + (((u_) >> 4) % ncs))
DI void rwkv_prep_loop(const RwkvPrepArgs& P, int first, int stride, int nunits, LDSQ unsigned char* scr, int c0 = 0, int ncs = 256) {
    if (first >= nunits) return;
    const int lane = lane_id(), fr = lane & 15, fq = lane >> 4, h = first & 15;
    const int lrow = lane >> 3, lpc = lane & 7, qrow = lane >> 4, qpc = lane & 15;
    bf16x8 wA[4][2], aA[4][2];
#pragma unroll
    for (int ti = 0; ti < 4; ++ti)
#pragma unroll
        for (int s = 0; s < 2; ++s) { wA[ti][s] = __builtin_bit_cast(bf16x8, ld16(P.W2T + (size_t)(64 * h + 16 * ti + fr) * 64 + 32 * s + 8 * fq)); aA[ti][s] = __builtin_bit_cast(bf16x8, ld16(P.A2T + (size_t)(64 * h + 16 * ti + fr) * 64 + 32 * s + 8 * fq)); }
    LDSQ float* vec = (LDSQ float*)(scr + RP_BYTES);
    vec[0 * 64 + lane] = P.w0[64 * h + lane]; vec[1 * 64 + lane] = P.a0[64 * h + lane]; vec[2 * 64 + lane] = P.k_k[64 * h + lane]; vec[3 * 64 + lane] = P.k_a[64 * h + lane]; vec[4 * 64 + lane] = P.r_k[64 * h + lane];
    MEMFENCE(); WAVE_SYNC();
    u32x4 tr_[2], tk_[2], tl_[4];
#define RP_LOAD(u_) do { const size_t r0_ = (size_t)RW_CHUNK(u_) * 16; \
    _Pragma("unroll") for (int hf = 0; hf < 2; ++hf) { tr_[hf] = ld16(P.R + (r0_ + 8 * hf + lrow) * P.ld + 64 * h + 8 * lpc); tk_[hf] = ld16(P.K + (r0_ + 8 * hf + lrow) * P.ld + 64 * h + 8 * lpc); } \
    _Pragma("unroll") for (int g = 0; g < 4; ++g) tl_[g] = ld16(P.LORA + (r0_ + 4 * g + qrow) * P.ldl + 8 * qpc); } while (0)
#define RP_PARK() do { MEMFENCE(); \
    _Pragma("unroll") for (int hf = 0; hf < 2; ++hf) { *(LDSQ u32x4*)(scr + RP_R + (8 * hf + lrow) * RPP + lpc * 16) = tr_[hf]; *(LDSQ u32x4*)(scr + RP_K + (8 * hf + lrow) * RPP + lpc * 16) = tk_[hf]; } \
    _Pragma("unroll") for (int g = 0; g < 4; ++g) *(LDSQ u32x4*)(scr + RP_L + (4 * g + qrow) * RPL + qpc * 16) = tl_[g]; MEMFENCE(); WAVE_SYNC(); } while (0)
    RP_LOAD(first); RP_PARK();
    for (int u = first; u < nunits; u += stride) {
        const int chunk = RW_CHUNK(u);
        const size_t row = (size_t)chunk * 16 + fr;
        if (u + stride < nunits) RP_LOAD(u + stride);
        bf16x8 bw[2], ba[2];
#pragma unroll
        for (int s = 0; s < 2; ++s) {
            bw[s] = __builtin_bit_cast(bf16x8, *(const LDSQ u32x4*)(scr + RP_L + fr * RPL + (32 * s + 8 * fq) * 2));
            ba[s] = __builtin_bit_cast(bf16x8, *(const LDSQ u32x4*)(scr + RP_L + fr * RPL + (64 + 32 * s + 8 * fq) * 2));
        }
        u32x2 r2a[4], k2a[4];
#pragma unroll
        for (int ti = 0; ti < 4; ++ti) { r2a[ti] = ldl8(scr + RP_R + fr * RPP + (16 * ti + 4 * fq) * 2); k2a[ti] = ldl8(scr + RP_K + fr * RPP + (16 * ti + 4 * fq) * 2); }
        MEMFENCE(); WAVE_SYNC();
        float ss = 0.f, bon = 0.f;
#pragma unroll
        for (int ti = 0; ti < 4; ++ti) {
            const f32x4 kkv = *(const LDSQ f32x4*)(vec + 128 + 16 * ti + 4 * fq); const u32x2 k2 = k2a[ti];
#pragma unroll
            for (int i = 0; i < 4; ++i) { const float kkr = bf2f((unsigned short)((i & 1) ? (k2[i >> 1] >> 16) : (k2[i >> 1] & 0xffffu))) * kkv[i]; ss += kkr * kkr; }
        }
        ss += SHX(ss, 16, lane); ss += SHX(ss, 32, lane);
        const float rn = __builtin_amdgcn_rsqf(fmaxf(ss, 1e-24f));
#pragma unroll
        for (int ti = 0; ti < 4; ++ti) {
            f32x4 dw = {0.f, 0.f, 0.f, 0.f}, da = {0.f, 0.f, 0.f, 0.f};
#pragma unroll
            for (int s = 0; s < 2; ++s) { dw = mfma16(wA[ti][s], bw[s], dw); da = mfma16(aA[ti][s], ba[s], da); }
            const u32x2 r2 = r2a[ti], k2 = k2a[ti];
            const int cl0 = 16 * ti + 4 * fq;
            const f32x4 w0v = *(const LDSQ f32x4*)(vec + cl0), a0v = *(const LDSQ f32x4*)(vec + 64 + cl0), kkv = *(const LDSQ f32x4*)(vec + 128 + cl0), kav = *(const LDSQ f32x4*)(vec + 192 + cl0), rkv = *(const LDSQ f32x4*)(vec + 256 + cl0);
            f32x4 okt, obt, okk, ort, ogl;
#pragma unroll
            for (int i = 0; i < 4; ++i) {
                const float r = bf2f((unsigned short)((i & 1) ? (r2[i >> 1] >> 16) : (r2[i >> 1] & 0xffffu)));
                const float k = bf2f((unsigned short)((i & 1) ? (k2[i >> 1] >> 16) : (k2[i >> 1] & 0xffffu)));
                const float ld = -0.6065306597126334f * sigmoidf_(w0v[i] + dw[i]);
                const float a = sigmoidf_(a0v[i] + da[i]);
                const float kappa = k * kkv[i] * rn;
                const float k1 = k * (1.0f + (a - 1.0f) * kav[i]);
                bon += r * k1 * rkv[i];
                float cs = ld;
                cs += ROW_SHR(cs, 1); cs += ROW_SHR(cs, 2); cs += ROW_SHR(cs, 4); cs += ROW_SHR(cs, 8);
                const float gi = fexp(cs), ginv = __builtin_amdgcn_rcpf(gi);
                float gx = ROW_SHR(gi, 1); if (fr == 0) gx = 1.0f;
                okt[i] = kappa * gx; obt[i] = kappa * a * ginv; okk[i] = k1 * ginv; ort[i] = r * gi; ogl[i] = gi;
            }
            const int o = fr * RPP + (16 * ti + 4 * fq) * 2;
            *(LDSQ u32x2*)(scr + 0 * RPT + o) = pack4(okt); *(LDSQ u32x2*)(scr + 1 * RPT + o) = pack4(obt); *(LDSQ u32x2*)(scr + 2 * RPT + o) = pack4(okk); *(LDSQ u32x2*)(scr + 3 * RPT + o) = pack4(ort);
            if (fr == 15) *(GQ f32x4*)(P.GL + (size_t)chunk * 1024 + 64 * h + 16 * ti + 4 * fq) = ogl;
            MEMFENCE();
        }
        bon += SHX(bon, 16, lane); bon += SHX(bon, 32, lane);
        if (fq == 0) P.BONUS[row * 16 + h] = bon;
        MEMFENCE(); WAVE_SYNC();
#pragma unroll
        for (int hf = 0; hf < 2; ++hf) {
            const size_t go = ((size_t)chunk * 16 + 8 * hf + lrow) * P.ld + 64 * h + 8 * lpc; const int lo = (8 * hf + lrow) * RPP + lpc * 16;
            *(GQ u32x4*)(P.KT + go) = *(const LDSQ u32x4*)(scr + 0 * RPT + lo); *(GQ u32x4*)(P.BT + go) = *(const LDSQ u32x4*)(scr + 1 * RPT + lo);
            *(GQ u32x4*)(P.KK + go) = *(const LDSQ u32x4*)(scr + 2 * RPT + lo); *(GQ u32x4*)(P.RT + go) = *(const LDSQ u32x4*)(scr + 3 * RPT + lo);
        }
        MEMFENCE(); WAVE_SYNC();
        if (u + stride < nunits) RP_PARK();
    }
#undef RP_LOAD
#undef RP_PARK
}

DI void rwkv_post_loop(const GQ bf16_t* __restrict__ YRAW, const GQ bf16_t* __restrict__ V, const GQ bf16_t* __restrict__ LORA, const GQ bf16_t* __restrict__ G2T, const GQ float* __restrict__ BONUS,
                       const GQ float* __restrict__ ln_g, const GQ float* __restrict__ ln_b, GQ bf16_t* __restrict__ YG, int ld, int first, int stride, int nunits, LDSQ unsigned char* scr, int c0 = 0, int ncs = 256) {
    if (first >= nunits) return;
    const int lane = lane_id(), fr = lane & 15, fq = lane >> 4, h = first & 15;
    const int lrow = lane >> 3, lpc = lane & 7, qrow = lane >> 4, qpc = lane & 15;
    bf16x8 gA[4][4];
#pragma unroll
    for (int ti = 0; ti < 4; ++ti)
#pragma unroll
        for (int s = 0; s < 4; ++s) gA[ti][s] = __builtin_bit_cast(bf16x8, ld16(G2T + (size_t)(64 * h + 16 * ti + fr) * 128 + 32 * s + 8 * fq));
    LDSQ float* vec = (LDSQ float*)(scr + RP_BYTES);
    vec[lane] = ln_g[64 * h + lane]; vec[64 + lane] = ln_b[64 * h + lane];
    MEMFENCE(); WAVE_SYNC();
    u32x4 ty_[2], tv_[2], tl_[4]; float bonn = 0.f;
#define PO_LOAD(u_) do { const size_t r0_ = (size_t)RW_CHUNK(u_) * 16; \
    _Pragma("unroll") for (int hf = 0; hf < 2; ++hf) { ty_[hf] = ld16(YRAW + (r0_ + 8 * hf + lrow) * ld + 64 * h + 8 * lpc); tv_[hf] = ld16(V + (r0_ + 8 * hf + lrow) * ld + 64 * h + 8 * lpc); } \
    _Pragma("unroll") for (int g = 0; g < 4; ++g) tl_[g] = ld16(LORA + (r0_ + 4 * g + qrow) * 256 + 128 + 8 * qpc); \
    bonn = BONUS[(r0_ + fr) * 16 + h]; } while (0)
#define PO_PARK() do { MEMFENCE(); \
    _Pragma("unroll") for (int hf = 0; hf < 2; ++hf) { *(LDSQ u32x4*)(scr + RP_R + (8 * hf + lrow) * RPP + lpc * 16) = ty_[hf]; *(LDSQ u32x4*)(scr + RP_K + (8 * hf + lrow) * RPP + lpc * 16) = tv_[hf]; } \
    _Pragma("unroll") for (int g = 0; g < 4; ++g) *(LDSQ u32x4*)(scr + RP_L + (4 * g + qrow) * RPL + qpc * 16) = tl_[g]; MEMFENCE(); WAVE_SYNC(); } while (0)
    PO_LOAD(first); PO_PARK();
    for (int u = first; u < nunits; u += stride) {
        const int chunk = RW_CHUNK(u);
        const float bon = bonn;
        if (u + stride < nunits) PO_LOAD(u + stride);
        bf16x8 bg[4];
#pragma unroll
        for (int s = 0; s < 4; ++s) bg[s] = __builtin_bit_cast(bf16x8, *(const LDSQ u32x4*)(scr + RP_L + fr * RPL + (32 * s + 8 * fq) * 2));
        u32x2 y2a[4], v2a[4];
#pragma unroll
        for (int ti = 0; ti < 4; ++ti) { y2a[ti] = ldl8(scr + RP_R + fr * RPP + (16 * ti + 4 * fq) * 2); v2a[ti] = ldl8(scr + RP_K + fr * RPP + (16 * ti + 4 * fq) * 2); }
        MEMFENCE(); WAVE_SYNC();
        float yv[16], gt[16]; float sm = 0.f;
#pragma unroll
        for (int ti = 0; ti < 4; ++ti) {
            f32x4 g = {0.f, 0.f, 0.f, 0.f};
#pragma unroll
            for (int s = 0; s < 4; ++s) g = mfma16(gA[ti][s], bg[s], g);
            const u32x2 y2 = y2a[ti];
            yv[4 * ti] = bf2f((unsigned short)(y2.x & 0xffffu)); yv[4 * ti + 1] = bf2f((unsigned short)(y2.x >> 16)); yv[4 * ti + 2] = bf2f((unsigned short)(y2.y & 0xffffu)); yv[4 * ti + 3] = bf2f((unsigned short)(y2.y >> 16));
#pragma unroll
            for (int i = 0; i < 4; ++i) { gt[4 * ti + i] = g[i]; sm += yv[4 * ti + i]; }
        }
        sm += SHX(sm, 16, lane); sm += SHX(sm, 32, lane);
        const float mean = sm * (1.0f / 64.0f); float vs = 0.f;
#pragma unroll
        for (int e2 = 0; e2 < 16; ++e2) { const float d = yv[e2] - mean; vs += d * d; }
        vs += SHX(vs, 16, lane); vs += SHX(vs, 32, lane);
        const float rstd = __builtin_amdgcn_rsqf(vs * (1.0f / 64.0f) + 64e-5f);
#pragma unroll
        for (int ti = 0; ti < 4; ++ti) {
            const int ch0 = 64 * h + 16 * ti + 4 * fq;
            const f32x4 lg = *(const LDSQ f32x4*)(vec + 16 * ti + 4 * fq), lb = *(const LDSQ f32x4*)(vec + 64 + 16 * ti + 4 * fq);
            const u32x2 v2 = v2a[ti];
            const float vv[4] = {bf2f((unsigned short)(v2.x & 0xffffu)), bf2f((unsigned short)(v2.x >> 16)), bf2f((unsigned short)(v2.y & 0xffffu)), bf2f((unsigned short)(v2.y >> 16))};
            f32x4 o;
#pragma unroll
            for (int i = 0; i < 4; ++i) o[i] = ((yv[4 * ti + i] - mean) * rstd * lg[i] + lb[i] + bon * vv[i]) * gt[4 * ti + i];
            *(LDSQ u32x2*)(scr + fr * RPP + (16 * ti + 4 * fq) * 2) = pack4(o);
        }
        MEMFENCE(); WAVE_SYNC();
#pragma unroll
        for (int hf = 0; hf < 2; ++hf) *(GQ u32x4*)(YG + ((size_t)chunk * 16 + 8 * hf + lrow) * ld + 64 * h + 8 * lpc) = *(const LDSQ u32x4*)(scr + (8 * hf + lrow) * RPP + lpc * 16);
        MEMFENCE(); WAVE_SYNC();
        if (u + stride < nunits) PO_PARK();
    }
#undef PO_LOAD
#undef PO_PARK
}

DI bf16x8 pk_lo(f32x4 v) { const u32x2 z2 = {0u, 0u}; return mk8(pack4(v), z2); }
DI f32x4 mm16(f32x4 accPT, f32x4 accQ) { return mfma16(pk_lo(accPT), pk_lo(accQ), (f32x4){0.f, 0.f, 0.f, 0.f}); }
DI void rwkv_scan_stream(const GQ bf16_t* __restrict__ KT, const GQ bf16_t* __restrict__ BT, const GQ bf16_t* __restrict__ KK, const GQ bf16_t* __restrict__ RT, const GQ bf16_t* __restrict__ V, int ld,
                         const GQ float* __restrict__ GL, int S, GQ bf16_t* __restrict__ Y, int ldy, LDSQ unsigned char* lds) {
    const int lane = lane_id(), fr = lane & 15, fq = lane >> 4;
    LDSQ unsigned char* BTimg = lds;
    LDSQ unsigned char* KKimg = lds + 2048;
    LDSQ unsigned char* Vimg = lds + 4096;
    f32x4 H[4];
#pragma unroll
    for (int ci = 0; ci < 4; ++ci) H[ci] = (f32x4){0.f, 0.f, 0.f, 0.f};
    const int NC = S / 16;
    u32x2 ktn[4], btn[4], kkn[4], rtn[4]; u32x4 vn = {0u, 0u, 0u, 0u}; f32x4 gln[4];
#define RW_LOAD(c_) do { const size_t row = (size_t)(16 * (c_) + fr); \
    _Pragma("unroll") for (int s = 0; s < 2; ++s) _Pragma("unroll") for (int q = 0; q < 2; ++q) { const size_t o = row * ld + 32 * s + 16 * q + 4 * fq; \
        ktn[2 * s + q] = ld8(KT + o); btn[2 * s + q] = ld8(BT + o); kkn[2 * s + q] = ld8(KK + o); rtn[2 * s + q] = ld8(RT + o); } \
    if (lane < 32) vn = ld16(V + (size_t)(16 * (c_) + (lane >> 1)) * ld + 8 * (lane & 1)); \
    _Pragma("unroll") for (int ci = 0; ci < 4; ++ci) gln[ci] = *(const GQ f32x4*)(GL + (size_t)(c_) * 1024 + 16 * ci + 4 * fq); } while (0)
    RW_LOAD(0);
    const bool dg[4] = {4 * fq + 0 == fr, 4 * fq + 1 == fr, 4 * fq + 2 == fr, 4 * fq + 3 == fr};
    for (int c = 0; c < NC; ++c) {
        u32x2 kt[4], bt[4], kk[4], rt[4]; const u32x4 vcur = vn; f32x4 gl[4];
#pragma unroll
        for (int i = 0; i < 4; ++i) { kt[i] = ktn[i]; bt[i] = btn[i]; kk[i] = kkn[i]; rt[i] = rtn[i]; gl[i] = gln[i]; }
        if (c + 1 < NC) RW_LOAD(c + 1);
        MEMFENCE();
#pragma unroll
        for (int s = 0; s < 2; ++s)
#pragma unroll
            for (int q = 0; q < 2; ++q) { const int off = fr * 128 + (32 * s + 16 * q + 4 * fq) * 2; *(LDSQ u32x2*)(BTimg + off) = bt[2 * s + q]; *(LDSQ u32x2*)(KKimg + off) = kk[2 * s + q]; }
        if (lane < 32) *(LDSQ u32x4*)(Vimg + (lane >> 1) * 32 + (lane & 1) * 16) = vcur;
        MEMFENCE();
        const f32x4 z4 = {0.f, 0.f, 0.f, 0.f};
        f32x4 x1 = z4, x2 = z4, akt = z4, arbt = z4, arkt = z4;
#pragma unroll
        for (int s = 0; s < 2; ++s) {
            const bf16x8 fkt = mk8(kt[2 * s], kt[2 * s + 1]), fbt = mk8(bt[2 * s], bt[2 * s + 1]), fkk = mk8(kk[2 * s], kk[2 * s + 1]), frt = mk8(rt[2 * s], rt[2 * s + 1]);
            x1 = mfma16(fbt, fkt, x1);
            x2 = mfma16(fkt, fbt, x2);
            akt = mfma16(fkk, fkt, akt);
            arbt = mfma16(fbt, frt, arbt);
            arkt = mfma16(fkk, frt, arkt);
        }
        f32x4 yT, y_;
#pragma unroll
        for (int i = 0; i < 4; ++i) {
            const int rr = 4 * fq + i;
            yT[i] = (rr < fr) ? -x1[i] : 0.f;
            y_[i] = (fr < rr) ? -x2[i] : 0.f;
            akt[i] = (rr < fr) ? akt[i] : 0.f;
            arbt[i] = (rr <= fr) ? arbt[i] : 0.f;
            arkt[i] = (rr <= fr) ? arkt[i] : 0.f;
        }
#define IA(x) ((f32x4){(x)[0] + (dg[0] ? 1.f : 0.f), (x)[1] + (dg[1] ? 1.f : 0.f), (x)[2] + (dg[2] ? 1.f : 0.f), (x)[3] + (dg[3] ? 1.f : 0.f)})
        const f32x4 y2 = mm16(yT, y_), y2T = mm16(y_, yT);
        const f32x4 y4 = mm16(y2T, y2), y4T = mm16(y2, y2T);
        const f32x4 y8T = mm16(y4, y4T);
        const f32x4 w1 = mm16(IA(y_), IA(y2T)), w1T = mm16(IA(yT), IA(y2));
        const f32x4 w2 = mm16(w1T, IA(y4T)), w2T = mm16(w1, IA(y4));
        const f32x4 tT = mm16(w2T, IA(y8T));
#undef IA
        const bf16x8 hb0 = mk8(pack4(H[0]), pack4(H[1])), hb1 = mk8(pack4(H[2]), pack4(H[3]));
        const s16x4 v4 = TR16(Vimg + (4 * fq + (fr >> 2)) * 32 + 8 * (fr & 3));
        const u32x2 z2 = {0u, 0u};
        f32x4 g = mfma16(mk8(kt[0], kt[1]), hb0, z4);
        g = mfma16(mk8(kt[2], kt[3]), hb1, g);
        g = mfma16(pk_lo(akt), mk8(tr2(v4), z2), g);
        const f32x4 tg = mfma16(pk_lo(tT), pk_lo(g), z4);
        const f32x4 u = -tg;
        f32x4 yo = mfma16(mk8(rt[0], rt[1]), hb0, z4);
        yo = mfma16(mk8(rt[2], rt[3]), hb1, yo);
        const bf16x8 uv = mk8(pack4(u), tr2(v4));
        yo = mfma16(mk8(pack4(arbt), pack4(arkt)), uv, yo);
#pragma unroll
        for (int i = 0; i < 4; ++i) Y[(size_t)(16 * c + 4 * fq + i) * ldy + fr] = f2bf(yo[i]);
#pragma unroll
        for (int ci = 0; ci < 4; ++ci) {
            const int off = (4 * fq + (fr >> 2)) * 128 + (16 * ci + 4 * (fr & 3)) * 2;
            const s16x4 b4 = TR16(BTimg + off), k4 = TR16(KKimg + off);
            H[ci] = mfma16(mk8(tr2(b4), tr2(k4)), uv, H[ci]) * gl[ci];
        }
        MEMFENCE();
    }
#undef RW_LOAD
}

#ifdef HOST_EMU
DI unsigned flag_ld(const LDSQ unsigned* p) { return __atomic_load_n(p, __ATOMIC_ACQUIRE); }
DI void flag_st(LDSQ unsigned* p, unsigned v) { emu_sync(); __atomic_store_n(p, v, __ATOMIC_RELEASE); }
DI void spin_pause() { std::this_thread::yield(); }
#else
DI unsigned flag_ld(const LDSQ unsigned* p) { unsigned v; asm volatile("ds_read_b32 %0, %1\n\ts_waitcnt lgkmcnt(0)" : "=v"(v) : "v"((unsigned)(size_t)p) : "memory"); return v; }
DI void flag_st(LDSQ unsigned* p, unsigned v) { asm volatile("ds_write_b32 %0, %1" :: "v"((unsigned)(size_t)p), "v"(v) : "memory"); }
DI void spin_pause() { asm volatile("s_nop 7"); }
#endif
#define COOP_SPIN_CAP (1u << 24)
#if defined(COOP_PROBE) && !defined(HOST_EMU)
DI void wait_ge_t(const LDSQ unsigned* p, unsigned want, LDSQ unsigned* acc) { const unsigned long long t0 = __builtin_amdgcn_s_memrealtime(); unsigned n = 0; while (flag_ld(p) < want) { spin_pause(); if (++n > COOP_SPIN_CAP) break; } MEMFENCE();
    const unsigned dt = (unsigned)(__builtin_amdgcn_s_memrealtime() - t0); if (lane_id() == 0) *acc += dt; }
#else
#define wait_ge_t(p, want, acc) wait_ge(p, want)
#endif
DI void wait_ge(const LDSQ unsigned* p, unsigned want) { unsigned n = 0; while (flag_ld(p) < want) { spin_pause(); if (++n > COOP_SPIN_CAP) break; } MEMFENCE(); }
#ifdef HOST_EMU
DI bool flags4_ge(const LDSQ unsigned* p, unsigned want, bool extra) { bool ok = flag_ld(p) >= want && flag_ld(p + 1) >= want && flag_ld(p + 2) >= want && flag_ld(p + 3) >= want; if (extra) ok = ok && flag_ld(p + 4) >= want; return ok; }
#else
DI bool flags4_ge(const LDSQ unsigned* p, unsigned want, bool extra) {
    u32x4 v; unsigned w = want;
    if (extra) asm volatile("ds_read_b128 %0, %2\n\tds_read_b32 %1, %2 offset:16\n\ts_waitcnt lgkmcnt(0)" : "=&v"(v), "=&v"(w) : "v"((unsigned)(size_t)p) : "memory");
    else asm volatile("ds_read_b128 %0, %1\n\ts_waitcnt lgkmcnt(0)" : "=&v"(v) : "v"((unsigned)(size_t)p) : "memory");
    return v.x >= want && v.y >= want && v.z >= want && v.w >= want && w >= want;
}
#endif
DI void wait_ge4(const LDSQ unsigned* p, unsigned want, bool extra) { unsigned n = 0; while (!flags4_ge(p, want, extra)) { spin_pause(); if (++n > COOP_SPIN_CAP) break; } MEMFENCE(); }

#if defined(SEG_PROBE) && !defined(HOST_EMU)
#define SEG_STAMP(i) do { if (wave == 0) { const unsigned now_ = (unsigned)__builtin_amdgcn_s_memrealtime(); if (lane == 0) ready[40 + (i)] += now_ - seg_last_; seg_last_ = now_; } } while (0)
#else
#define SEG_STAMP(i) do {} while (0)
#endif
constexpr int RWP = 144, RWTS = 16 * RWP;
constexpr int RWT_KT = 0, RWT_BT = RWTS, RWT_KK = 2 * RWTS, RWT_RT = 3 * RWTS, RWT_V = 4 * RWTS, RWT_GL = 5 * RWTS, RWT_TT = RWT_GL + 256, RWT_AK = RWT_TT + 512, RWT_ARB = RWT_AK + 512, RWT_Y = RWT_ARB + 1024;
constexpr int RWS_SLOT = RWT_Y + RWTS, RWS_NSLOT = 8, RWS_FLAGS = RWS_SLOT * RWS_NSLOT, RWS_LDS = RWS_FLAGS + 256;
DI void rwkv_scan_coop(int wave, const GQ bf16_t* __restrict__ KT, const GQ bf16_t* __restrict__ BT, const GQ bf16_t* __restrict__ KK, const GQ bf16_t* __restrict__ RT, const GQ bf16_t* __restrict__ V, int ld,
                       const GQ float* __restrict__ GL, int S, GQ bf16_t* __restrict__ Y, int ldy, LDSQ unsigned char* lds, const GQ float* Hin = nullptr, GQ float* Hout = nullptr) {
    const int lane = lane_id(), fr = lane & 15, fq = lane >> 4;
    const int NC = S / 16;
    LDSQ unsigned* ready = (LDSQ unsigned*)(lds + RWS_FLAGS);
    LDSQ unsigned* done = ready + 16;
    const u32x2 z2 = {0u, 0u};
    const f32x4 z4 = {0.f, 0.f, 0.f, 0.f};
    if (wave < 4) {
#ifndef HOST_EMU
        __builtin_amdgcn_s_setprio(3);
#endif
        f32x4 H[4];
#pragma unroll
        for (int ci = 0; ci < 4; ++ci) H[ci] = Hin ? *(const GQ f32x4*)(Hin + (size_t)(wave * 64 + lane) * 16 + 4 * ci) : z4;
        struct ConsOps { u32x2 kt[4], rt[4]; u32x2 tT, ak; u32x4 arbk; f32x4 gl[4]; s16x4 v4, b4[4], k4[4]; };
#define RWC_LOAD(O, c_) do { LDSQ unsigned char* sl_ = lds + ((c_) & (RWS_NSLOT - 1)) * RWS_SLOT; \
            wait_ge_t(ready + ((c_) & (RWS_NSLOT - 1)), (unsigned)(c_) + 1u, ready + 32 + wave); \
            _Pragma("unroll") for (int s = 0; s < 2; ++s) _Pragma("unroll") for (int q = 0; q < 2; ++q) { const int o = fr * RWP + (32 * s + 16 * q + 4 * fq) * 2; O.kt[2 * s + q] = ldl8(sl_ + RWT_KT + o); O.rt[2 * s + q] = ldl8(sl_ + RWT_RT + o); } \
            O.tT = ldl8(sl_ + RWT_TT + lane * 8); O.ak = ldl8(sl_ + RWT_AK + lane * 8); \
            O.arbk = *(const LDSQ u32x4*)(sl_ + RWT_ARB + lane * 16); \
            _Pragma("unroll") for (int ci = 0; ci < 4; ++ci) O.gl[ci] = *(const LDSQ f32x4*)(sl_ + RWT_GL + (16 * ci + 4 * fq) * 4); \
            O.v4 = TR16(sl_ + RWT_V + (4 * fq + (fr >> 2)) * RWP + (16 * wave + 4 * (fr & 3)) * 2);     \
            _Pragma("unroll") for (int ci = 0; ci < 4; ++ci) { const int off = (4 * fq + (fr >> 2)) * RWP + (16 * ci + 4 * (fr & 3)) * 2; O.b4[ci] = TR16(sl_ + RWT_BT + off); O.k4[ci] = TR16(sl_ + RWT_KK + off); } \
        } while (0)
#define RWC_COMP(O, c_) do { LDSQ unsigned char* sl_ = lds + ((c_) & (RWS_NSLOT - 1)) * RWS_SLOT; \
            const bf16x8 hb0 = mk8(pack4(H[0]), pack4(H[1])), hb1 = mk8(pack4(H[2]), pack4(H[3])); \
            f32x4 g = mfma16(mk8(O.kt[0], O.kt[1]), hb0, z4); \
            g = mfma16(mk8(O.kt[2], O.kt[3]), hb1, g); \
            g = mfma16(mk8(O.ak, z2), mk8(tr2(O.v4), z2), g); \
            const f32x4 tg = mfma16(mk8(O.tT, z2), pk_lo(g), z4); \
            const f32x4 u = -tg; \
            f32x4 yo = mfma16(mk8(O.rt[0], O.rt[1]), hb0, z4); \
            yo = mfma16(mk8(O.rt[2], O.rt[3]), hb1, yo); \
            const bf16x8 uv = mk8(pack4(u), tr2(O.v4)); \
            yo = mfma16(__builtin_bit_cast(bf16x8, O.arbk), uv, yo); \
            _Pragma("unroll") for (int i = 0; i < 4; ++i) *(LDSQ unsigned short*)(sl_ + RWT_Y + (4 * fq + i) * RWP + (16 * wave + fr) * 2) = f2bf(yo[i]); \
            _Pragma("unroll") for (int ci = 0; ci < 4; ++ci) H[ci] = mfma16(mk8(tr2(O.b4[ci]), tr2(O.k4[ci])), uv, H[ci]) * O.gl[ci]; \
            flag_st(done + wave, (unsigned)(c_) + 1u); \
        } while (0)
        ConsOps A, B;
        RWC_LOAD(A, 0);
        for (int c = 0; c < NC; c += 2) {
            RWC_LOAD(B, c + 1);
            RWC_COMP(A, c);
            if (c + 2 < NC) RWC_LOAD(A, c + 2);
            RWC_COMP(B, c + 1);
        }
#undef RWC_LOAD
#undef RWC_COMP
        if (Hout) {
#pragma unroll
            for (int ci = 0; ci < 4; ++ci) *(GQ f32x4*)(Hout + (size_t)(wave * 64 + lane) * 16 + 4 * ci) = H[ci]; }
    } else {
#ifndef HOST_EMU
        __builtin_amdgcn_s_setprio(0);
#endif
        const int p = wave - 4;
        const int lrow = lane >> 3, lpc = lane & 7;
        u32x4 tn[5][2]; float gln = 0.f;
#define RWP_LOAD(c_) do { _Pragma("unroll") for (int hf = 0; hf < 2; ++hf) { const size_t o = (size_t)(16 * (c_) + 8 * hf + lrow) * ld + 8 * lpc; \
        tn[0][hf] = ld16(KT + o); tn[1][hf] = ld16(BT + o); tn[2][hf] = ld16(KK + o); tn[3][hf] = ld16(RT + o); tn[4][hf] = ld16(V + o); } \
    gln = GL[(size_t)(c_) * 1024 + lane]; } while (0)
#define RWP_FLUSH(cc_) do { const u32x4 y0 = *(const LDSQ u32x4*)(slot + RWT_Y + lrow * RWP + lpc * 16), y1 = *(const LDSQ u32x4*)(slot + RWT_Y + (8 + lrow) * RWP + lpc * 16); \
    *(GQ u32x4*)(Y + (size_t)(16 * (cc_) + lrow) * ldy + 8 * lpc) = y0; *(GQ u32x4*)(Y + (size_t)(16 * (cc_) + 8 + lrow) * ldy + 8 * lpc) = y1; MEMFENCE(); } while (0)
        const bool dg[4] = {4 * fq + 0 == fr, 4 * fq + 1 == fr, 4 * fq + 2 == fr, 4 * fq + 3 == fr};
#define RWP_PARK(cc_) do { LDSQ unsigned char* ps_ = lds + ((cc_) & (RWS_NSLOT - 1)) * RWS_SLOT; \
        if ((cc_) >= RWS_NSLOT) { const unsigned want_ = (unsigned)((cc_) - RWS_NSLOT + 1); wait_ge4(done, want_, false); \
            { LDSQ unsigned char* slot = ps_; RWP_FLUSH((cc_) - RWS_NSLOT); } } \
        MEMFENCE(); \
        _Pragma("unroll") for (int a = 0; a < 5; ++a) _Pragma("unroll") for (int hf = 0; hf < 2; ++hf) *(LDSQ u32x4*)(ps_ + a * RWTS + (8 * hf + lrow) * RWP + lpc * 16) = tn[a][hf]; \
        *(LDSQ float*)(ps_ + RWT_GL + lane * 4) = gln; MEMFENCE(); WAVE_SYNC(); } while (0)
        if (p < NC) { RWP_LOAD(p); RWP_PARK(p); }
        for (int c = p; c < NC; c += 4) {
            if (c + 4 < NC) RWP_LOAD(c + 4);
            LDSQ unsigned char* slot = lds + (c & (RWS_NSLOT - 1)) * RWS_SLOT;
            u32x2 kt[4], bt[4], kk[4], rt[4];
#pragma unroll
            for (int s = 0; s < 2; ++s)
#pragma unroll
                for (int q = 0; q < 2; ++q) { const int o = fr * RWP + (32 * s + 16 * q + 4 * fq) * 2;
                    kt[2 * s + q] = ldl8(slot + RWT_KT + o); bt[2 * s + q] = ldl8(slot + RWT_BT + o); kk[2 * s + q] = ldl8(slot + RWT_KK + o); rt[2 * s + q] = ldl8(slot + RWT_RT + o); }
            f32x4 x1 = z4, x2 = z4, akt = z4, arbt = z4, arkt = z4;
#pragma unroll
            for (int s = 0; s < 2; ++s) {
                const bf16x8 fkt = mk8(kt[2 * s], kt[2 * s + 1]), fbt = mk8(bt[2 * s], bt[2 * s + 1]), fkk = mk8(kk[2 * s], kk[2 * s + 1]), frt = mk8(rt[2 * s], rt[2 * s + 1]);
                x1 = mfma16(fbt, fkt, x1); x2 = mfma16(fkt, fbt, x2); akt = mfma16(fkk, fkt, akt); arbt = mfma16(fbt, frt, arbt); arkt = mfma16(fkk, frt, arkt);
            }
            f32x4 yT, y_;
#pragma unroll
            for (int i = 0; i < 4; ++i) {
                const int rr = 4 * fq + i;
                yT[i] = (rr < fr) ? -x1[i] : 0.f; y_[i] = (fr < rr) ? -x2[i] : 0.f;
                akt[i] = (rr < fr) ? akt[i] : 0.f; arbt[i] = (rr <= fr) ? arbt[i] : 0.f; arkt[i] = (rr <= fr) ? arkt[i] : 0.f;
            }
#define IA(x) ((f32x4){(x)[0] + (dg[0] ? 1.f : 0.f), (x)[1] + (dg[1] ? 1.f : 0.f), (x)[2] + (dg[2] ? 1.f : 0.f), (x)[3] + (dg[3] ? 1.f : 0.f)})
            const f32x4 y2 = mm16(yT, y_), y2T = mm16(y_, yT);
            const f32x4 y4 = mm16(y2T, y2), y4T = mm16(y2, y2T);
            const f32x4 y8T = mm16(y4, y4T);
            const f32x4 w1 = mm16(IA(y_), IA(y2T)), w1T = mm16(IA(yT), IA(y2));
            const f32x4 w2 = mm16(w1T, IA(y4T)), w2T = mm16(w1, IA(y4));
            const f32x4 tT = mm16(w2T, IA(y8T));
#undef IA
            *(LDSQ u32x2*)(slot + RWT_TT + lane * 8) = pack4(tT);
            *(LDSQ u32x2*)(slot + RWT_AK + lane * 8) = pack4(akt);
            { const u32x2 a = pack4(arbt), b = pack4(arkt); *(LDSQ u32x4*)(slot + RWT_ARB + lane * 16) = (u32x4){a.x, a.y, b.x, b.y}; }
            flag_st(ready + (c & (RWS_NSLOT - 1)), (unsigned)c + 1u);
            if (c + 4 < NC) RWP_PARK(c + 4);
        }
#undef RWP_PARK
        for (int c = NC - RWS_NSLOT; c < NC; ++c) if (c >= 0 && (c & 3) == p) {
            LDSQ unsigned char* slot = lds + (c & (RWS_NSLOT - 1)) * RWS_SLOT; const unsigned want = (unsigned)c + 1u;
            wait_ge4(done, want, false);
            RWP_FLUSH(c);
        }
#undef RWP_FLUSH
#undef RWP_LOAD
    }
}

DI void mlstm_gate_scan(const GQ float* __restrict__ G, int gi, int gf, int S, GQ float* __restrict__ SC_A, GQ float* __restrict__ SC_M, GQ float* __restrict__ SC_E) {
    const int lane = lane_id(), TPL = S / 64, t0 = lane * TPL;
    float tot = 0.f;
    for (int i = 0; i < TPL; ++i) tot += G[(size_t)(t0 + i) * 8 + gf];
    float inc = tot;
#pragma unroll
    for (int d = 1; d < 64; d <<= 1) { const float t = __shfl_up(inc, d, 64); if (lane >= d) inc += t; }
    const float Fbase = inc - tot;
    float run = Fbase, lmax = -3.0e38f;
    for (int i = 0; i < TPL; ++i) { run += G[(size_t)(t0 + i) * 8 + gf]; const float a = G[(size_t)(t0 + i) * 8 + gi] - run; SC_A[t0 + i] = a; lmax = fmaxf(lmax, a); }
    float mi = lmax;
#pragma unroll
    for (int d = 1; d < 64; d <<= 1) { const float t = __shfl_up(mi, d, 64); if (lane >= d) mi = fmaxf(mi, t); }
    float mprev = __shfl_up(mi, 1, 64); if (lane == 0) mprev = 0.f;
    float M = fmaxf(mprev, 0.f); run = Fbase;
    for (int i = 0; i < TPL; ++i) { run += G[(size_t)(t0 + i) * 8 + gf]; const float a = G[(size_t)(t0 + i) * 8 + gi] - run; M = fmaxf(M, a); SC_M[t0 + i] = M; SC_E[t0 + i] = fexp(-(run + M)); }
}


#ifdef HOST_EMU
#define WG_SYNC() emu_syncthreads()
#else
#define WG_SYNC() __syncthreads()
#endif
DI void mlstm_gate_scan_wg(int wave, const GQ float* __restrict__ G, int gi, int gf, int S, GQ float* __restrict__ SC_A, GQ float* __restrict__ SC_M, GQ float* __restrict__ SC_E, LDSQ float* red) {
    const int lane = lane_id(), TPW = S / 8, NG = TPW / 64, t0 = wave * TPW;
    float F[8], A[8];
    float run = 0.f;
    for (int g = 0; g < NG; ++g) {
        const size_t t = (size_t)(t0 + 64 * g + lane);
        float inc = G[t * 8 + gf]; A[g] = G[t * 8 + gi];
#pragma unroll
        for (int d = 1; d < 64; d <<= 1) { const float x = WSHFL_UP(inc, d, lane); if (lane >= d) inc += x; }
        F[g] = run + inc; run += WLAST(inc);
    }
    if (lane == 0) red[wave] = run;
    MEMFENCE(); WG_SYNC();
    float base = 0.f;
    for (int w = 0; w < wave; ++w) base += red[w];
    float mrun = -3.0e38f;
    for (int g = 0; g < NG; ++g) {
        F[g] += base; const float a = A[g] - F[g]; A[g] = a;
        SC_A[t0 + 64 * g + lane] = a;
        float mx = a;
#pragma unroll
        for (int d = 1; d < 64; d <<= 1) { const float x = WSHFL_UP(mx, d, lane); if (lane >= d) mx = fmaxf(mx, x); }
        const float gm = WLAST(mx);
        mx = fmaxf(mx, mrun); mrun = fmaxf(mrun, gm);
        A[g] = mx;
    }
    if (lane == 0) red[8 + wave] = mrun;
    MEMFENCE(); WG_SYNC();
    float mb = 0.f;
    for (int w = 0; w < wave; ++w) mb = fmaxf(mb, red[8 + w]);
    for (int g = 0; g < NG; ++g) { const float M = fmaxf(A[g], mb); SC_M[t0 + 64 * g + lane] = M; SC_E[t0 + 64 * g + lane] = fexp(-(F[g] + M)); }
}
constexpr int MLKP = 288;
constexpr int MLS_SLOT = 9472, MLS_NSLOT = 6, MLS_FLAGS = MLS_SLOT * MLS_NSLOT, MLS_VIMG = MLS_FLAGS + 256, MLS_LDS = MLS_VIMG + 4 * 1024;
DI void mlstm_coop(int wave, const GQ bf16_t* __restrict__ Qp, const GQ bf16_t* __restrict__ Kp, int ldqk, const GQ bf16_t* __restrict__ Vp, int ldv, const GQ float* __restrict__ SC_A, const GQ float* __restrict__ SC_M,
                   int S, GQ bf16_t* __restrict__ NUM, int ldn, GQ float* __restrict__ DEN, int ldd, LDSQ unsigned char* lds) {
    const int lane = lane_id(), fr = lane & 15, fq = lane >> 4;
    const int NC = S / 16;
    LDSQ unsigned* ready = (LDSQ unsigned*)(lds + MLS_FLAGS);
    LDSQ unsigned* done = ready + 16;
    const u32x2 z2 = {0u, 0u};
    const f32x4 z4 = {0.f, 0.f, 0.f, 0.f};
    if (wave < 5) {
        const bool isden = (wave == 4);
        LDSQ unsigned char* Vimg = lds + MLS_VIMG + (wave & 3) * 1024;
        f32x4 C[8][2];
#pragma unroll
        for (int ci = 0; ci < 8; ++ci) { C[ci][0] = z4; C[ci][1] = z4; }
        u32x4 vn = {0u, 0u, 0u, 0u};
#define MLC_LOAD(c_) do { if (!isden) vn = ld16(Vp + (size_t)(16 * (c_) + (lane >> 2)) * ldv + 32 * wave + 8 * (lane & 3)); } while (0)
        MLC_LOAD(0);
        for (int c = 0; c < NC; ++c) {
            const u32x4 vcur = vn;
            if (c + 1 < NC) MLC_LOAD(c + 1);
            MEMFENCE();
            if (!isden) *(LDSQ u32x4*)(Vimg + (lane >> 2) * 64 + (lane & 3) * 16) = vcur;
            MEMFENCE();
            const int sl = c % MLS_NSLOT;
            LDSQ unsigned char* slot = lds + sl * MLS_SLOT;
            wait_ge_t(ready + sl, (unsigned)c + 1u, ready + 32 + wave);
            const u32x2 pf = *(const LDSQ u32x2*)(slot + 4608 + lane * 8);
            u32x2 qc[8];
#pragma unroll
            for (int i = 0; i < 8; ++i) qc[i] = *(const LDSQ u32x2*)(slot + 5376 + i * 512 + lane * 8);
            const f32x4 wi = *(const LDSQ f32x4*)(slot + 5120 + fq * 16), wt = *(const LDSQ f32x4*)(slot + 5184 + fq * 16), rs4 = *(const LDSQ f32x4*)(slot + 5248 + fq * 16);
            const float wst = *(const LDSQ float*)(slot + 5312);
            s16x4 k4[8];
#pragma unroll
            for (int ci = 0; ci < 8; ++ci) k4[ci] = TR16(slot + (4 * fq + (fr >> 2)) * MLKP + (16 * ci + 4 * (fr & 3)) * 2);
            if (!isden) {
                bf16x8 vwb[2];
#pragma unroll
                for (int j = 0; j < 2; ++j) {
                    const s16x4 v4 = TR16(Vimg + (4 * fq + (fr >> 2)) * 64 + 32 * j + 8 * (fr & 3));
                    const f32x4 numI = mfma16(mk8(pf, z2), mk8(tr2(v4), z2), z4);
                    f32x4 inter = z4;
#pragma unroll
                    for (int ks = 0; ks < 4; ++ks) inter = mfma16(mk8(qc[2 * ks], qc[2 * ks + 1]), mk8(pack4(C[2 * ks][j]), pack4(C[2 * ks + 1][j])), inter);
#pragma unroll
                    for (int i = 0; i < 4; ++i) NUM[(size_t)(16 * c + 4 * fq + i) * ldn + 32 * wave + 16 * j + fr] = f2bf(numI[i] + wi[i] * inter[i]);
                    f32x4 vw;
#pragma unroll
                    for (int i = 0; i < 4; ++i) vw[i] = bf2f((unsigned short)v4[i]) * wt[i];
                    vwb[j] = mk8(pack4(vw), z2);
                }
#pragma unroll
                for (int ci = 0; ci < 8; ++ci) { const bf16x8 ka = mk8(tr2(k4[ci]), z2); C[ci][0] = mfma16(ka, vwb[0], C[ci][0] * wst); C[ci][1] = mfma16(ka, vwb[1], C[ci][1] * wst); }
        #ifndef HOST_EMU
        __builtin_amdgcn_s_setprio(0);
#endif
    } else {
                f32x4 inter = z4;
#pragma unroll
                for (int ks = 0; ks < 4; ++ks) inter = mfma16(mk8(qc[2 * ks], qc[2 * ks + 1]), mk8(pack4(C[2 * ks][0]), pack4(C[2 * ks + 1][0])), inter);
                if (fr == 0) {
#pragma unroll
                    for (int i = 0; i < 4; ++i) DEN[(size_t)(16 * c + 4 * fq + i) * ldd] = rs4[i] + wi[i] * inter[i];
                }
                f32x4 vw;
#pragma unroll
                for (int i = 0; i < 4; ++i) vw[i] = (fr == 0) ? wt[i] : 0.f;
                const bf16x8 vwb = mk8(pack4(vw), z2);
#pragma unroll
                for (int ci = 0; ci < 8; ++ci) C[ci][0] = mfma16(mk8(tr2(k4[ci]), z2), vwb, C[ci][0] * wst);
            }
            flag_st(done + wave, (unsigned)c + 1u);
        }
#undef MLC_LOAD
    } else {
        const int p = wave - 5;
        u32x2 qn[8], kn[8]; float an = 0.f, mn = 0.f, mcn = 0.f;
#define MLP_LOAD(c_) do { const size_t row = (size_t)(16 * (c_) + fr); \
    _Pragma("unroll") for (int ks = 0; ks < 4; ++ks) { qn[2 * ks] = ld8(Qp + row * ldqk + 32 * ks + 4 * fq); qn[2 * ks + 1] = ld8(Qp + row * ldqk + 32 * ks + 16 + 4 * fq); \
        kn[2 * ks] = ld8(Kp + row * ldqk + 32 * ks + 4 * fq); kn[2 * ks + 1] = ld8(Kp + row * ldqk + 32 * ks + 16 + 4 * fq); } \
    an = SC_A[row]; mn = SC_M[row]; mcn = ((c_) > 0) ? SC_M[16 * (c_) - 1] : 0.f; } while (0)
        if (p < NC) MLP_LOAD(p);
        for (int c = p; c < NC; c += 3) {
            u32x2 qc[8], kc[8]; const float a = an, Mx = mn, Mcarry = mcn;
#pragma unroll
            for (int i = 0; i < 8; ++i) { qc[i] = qn[i]; kc[i] = kn[i]; }
            if (c + 3 < NC) MLP_LOAD(c + 3);
            const float Mend = __shfl(Mx, 15, 16);
            float as_[4];
#pragma unroll
            for (int i = 0; i < 4; ++i) as_[i] = __shfl(a, 4 * fq + i, 16);
            f32x4 st = z4;
#pragma unroll
            for (int ks = 0; ks < 4; ++ks) st = mfma16(mk8(kc[2 * ks], kc[2 * ks + 1]), mk8(qc[2 * ks], qc[2 * ks + 1]), st);
            f32x4 pt;
#pragma unroll
            for (int i = 0; i < 4; ++i) pt[i] = (4 * fq + i <= fr) ? st[i] * fexp(as_[i] - Mx) : 0.f;
            float rs = (pt[0] + pt[1]) + (pt[2] + pt[3]);
            rs += SHX(rs, 16, lane); rs += SHX(rs, 32, lane);
            const int sl = c % MLS_NSLOT;
            if (c >= MLS_NSLOT) { const unsigned want = (unsigned)(c - MLS_NSLOT + 1); wait_ge_t(done + 0, want, ready + 32 + wave); wait_ge(done + 1, want); wait_ge(done + 2, want); wait_ge(done + 3, want); wait_ge(done + 4, want); }
            LDSQ unsigned char* slot = lds + sl * MLS_SLOT;
            MEMFENCE();
#pragma unroll
            for (int ks = 0; ks < 4; ++ks) { *(LDSQ u32x2*)(slot + fr * MLKP + (32 * ks + 4 * fq) * 2) = kc[2 * ks]; *(LDSQ u32x2*)(slot + fr * MLKP + (32 * ks + 16 + 4 * fq) * 2) = kc[2 * ks + 1]; }
            *(LDSQ u32x2*)(slot + 4608 + lane * 8) = pack4(pt);
#pragma unroll
            for (int i = 0; i < 8; ++i) *(LDSQ u32x2*)(slot + 5376 + i * 512 + lane * 8) = qc[i];
            if (fq == 0) { *(LDSQ float*)(slot + 5120 + fr * 4) = fexp(Mcarry - Mx); *(LDSQ float*)(slot + 5184 + fr * 4) = fexp(a - Mend); *(LDSQ float*)(slot + 5248 + fr * 4) = rs; }
            if (lane == 0) *(LDSQ float*)(slot + 5312) = fexp(Mcarry - Mend);
            flag_st(ready + sl, (unsigned)c + 1u);
        }
#undef MLP_LOAD
    }
}

constexpr int M3P = 288, M3T = 32 * M3P;
constexpr int M3_K = 0, M3_Q = M3T, M3_V = 2 * M3T, M3_P = 3 * M3T, M3_WI = M3_P + 2048, M3_WT = M3_WI + 128, M3_RS = M3_WT + 128, M3_A = M3_RS + 128, M3_MX = M3_A + 128, M3_WS = M3_MX + 128;
constexpr int M3_SLOT = M3_P + 2048 + 1024;
#if defined(PARK_PROBE) && !defined(HOST_EMU)
#define PARK_PROBE_WAIT() do { const unsigned long long t0_ = __builtin_amdgcn_s_memrealtime(); asm volatile("s_waitcnt vmcnt(0)" ::: "memory"); \
        const unsigned dt_ = (unsigned)(__builtin_amdgcn_s_memrealtime() - t0_); if (wave == 5 && lane == 0) flags[40] += dt_; } while (0)
#else
#define PARK_PROBE_WAIT() do {} while (0)
#endif
#if defined(PST_PROBE) && !defined(HOST_EMU)
#define CST(i) do { if (wave == 0) { asm volatile("s_waitcnt lgkmcnt(0)" ::: "memory"); const unsigned now_ = (unsigned)__builtin_amdgcn_s_memrealtime(); if (lane == 0) flags[44 + (i)] += now_ - cst_last_; cst_last_ = now_; } } while (0)
#else
#define CST(i) do {} while (0)
#endif
#if defined(PST_PROBE) && !defined(HOST_EMU)
#define PST(i) do { if (wave == 5) { const unsigned now_ = (unsigned)__builtin_amdgcn_s_memrealtime(); if (lane == 0) flags[40 + (i)] += now_ - pst_last_; pst_last_ = now_; } } while (0)
#else
#define PST(i) do {} while (0)
#endif
#define ML_HOISTK 1
template <int NJ, int NCONS, int ABL = 0> DI void mlstm_coop32(int wave, int cbase  , bool with_den, const GQ bf16_t* __restrict__ Qp, const GQ bf16_t* __restrict__ Kp, int ldqk, const GQ bf16_t* __restrict__ Vp, int ldv, const GQ float* __restrict__ SC_A, const GQ float* __restrict__ SC_M,
                     int S, GQ bf16_t* __restrict__ NUM, int ldn, GQ float* __restrict__ DEN, int ldd, LDSQ unsigned char* lds, LDSQ unsigned* flags) {
    constexpr int VW = 16 * NJ * NCONS, M3VP = (VW == 128) ? M3P : 144;
    constexpr int M3_P = M3_V + 32 * M3VP, M3_WI = M3_P + 2048, M3_WT = M3_WI + 128, M3_RS = M3_WT + 128, M3_A = M3_RS + 128, M3_MX = M3_A + 128, M3_WS = M3_MX + 128, M3_SLOT = M3_P + 2048 + 1024;
    constexpr int NTP = (VW == 128) ? 272 : 144, M3_NT = M3_SLOT, M3_DN = M3_NT + 32 * NTP, M3_SLOTX = M3_DN + 128, M3_NSLOT = (4 * M3_SLOTX <= 131072) ? 4 : 3;
    const int vc0 = (VW == 128) ? 0 : cbase;
    const int lane = lane_id(), fr = lane & 15, fq = lane >> 4;
    const int NC = S / 32;
    LDSQ unsigned* ready = flags;
    LDSQ unsigned* done = flags + 16;
    LDSQ unsigned* flushed = flags + 24;
    const int lrow = lane >> 4, lpc = lane & 15;
#define M3_FLUSH(sp_, cc_) do { MEMFENCE(); \
        if (16 * NJ * NCONS == 128) { _Pragma("unroll") for (int g = 0; g < 8; ++g) { const int r_ = 4 * g + lrow; \
            *(GQ u32x4*)(NUM + (size_t)(32 * (cc_) + r_) * ldn + cbase + 8 * lpc) = *(const LDSQ u32x4*)((sp_) + M3_NT + r_ * NTP + lpc * 16); } } \
        else { _Pragma("unroll") for (int g = 0; g < 4; ++g) { const int r_ = 8 * g + (lane >> 3), pc_ = lane & 7; \
            *(GQ u32x4*)(NUM + (size_t)(32 * (cc_) + r_) * ldn + cbase + 8 * pc_) = *(const LDSQ u32x4*)((sp_) + M3_NT + r_ * NTP + pc_ * 16); } } \
        if (with_den && lane < 32) DEN[(size_t)(32 * (cc_) + lane) * ldd] = *(const LDSQ float*)((sp_) + M3_DN + lane * 4); \
        MEMFENCE(); } while (0)
    const u32x2 z2 = {0u, 0u};
    const f32x4 z4 = {0.f, 0.f, 0.f, 0.f};
    if (wave < 5) {
        if (wave >= NCONS && wave != 4) return;
#ifndef HOST_EMU
        __builtin_amdgcn_s_setprio(3);
#endif
        const bool isden = (wave == 4);
        f32x4 C[8][NJ];
#pragma unroll
        for (int ci = 0; ci < 8; ++ci)
#pragma unroll
            for (int j = 0; j < NJ; ++j) C[ci][j] = z4;
        const int cw = cbase + 16 * NJ * wave;
#if defined(PST_PROBE) && !defined(HOST_EMU)
        unsigned cst_last_ = (unsigned)__builtin_amdgcn_s_memrealtime();
#endif
        for (int c = 0; c < NC; ++c) {
            const int sl = c % M3_NSLOT;
            LDSQ unsigned char* slot = lds + sl * M3_SLOTX;
            CST(0);
            wait_ge_t(ready + sl, (unsigned)c + 1u, flags + 32 + wave);
            CST(1);
            const float wst = *(const LDSQ float*)(slot + M3_WS);
            f32x4 wi[2], wt[2];
#pragma unroll
            for (int h = 0; h < 2; ++h) { wi[h] = *(const LDSQ f32x4*)(slot + M3_WI + (16 * h + 4 * fq) * 4); wt[h] = *(const LDSQ f32x4*)(slot + M3_WT + (16 * h + 4 * fq) * 4); }
#define M3_QF(tt_, ks_) mk8(ldl8(slot + M3_Q + (16 * (tt_) + fr) * M3P + (32 * (ks_) + 4 * fq) * 2), ldl8(slot + M3_Q + (16 * (tt_) + fr) * M3P + (32 * (ks_) + 4 * fq) * 2 + 32))
            if (isden && !with_den) { flag_st(done + wave, (unsigned)c + 1u); continue; }
            if (!isden) {
                const u32x4 pf0 = *(const LDSQ u32x4*)(slot + M3_P + lane * 16), pf1 = *(const LDSQ u32x4*)(slot + M3_P + 1024 + lane * 16);
#ifdef ML_HOISTK
                bf16x8 kaf[8];
#pragma unroll
                for (int ci = 0; ci < 8; ++ci) { const int ko = (4 * fq + (fr >> 2)) * M3P + (16 * ci + 4 * (fr & 3)) * 2; kaf[ci] = mk8(tr2(TR16(slot + M3_K + ko)), tr2(TR16(slot + M3_K + 16 * M3P + ko))); }
                SCHED_FENCE();
#endif
                bf16x8 vwb[NJ];
#pragma unroll
                for (int j = 0; j < NJ; ++j) {
                    const int vo = (4 * fq + (fr >> 2)) * M3VP + (cw - vc0 + 16 * j + 4 * (fr & 3)) * 2;
                    s16x4 v0 = {0, 0, 0, 0}, v1 = {0, 0, 0, 0}; if (!(ABL & 4)) { v0 = TR16(slot + M3_V + vo); v1 = TR16(slot + M3_V + 16 * M3VP + vo); }
                    const bf16x8 vb = mk8(tr2(v0), tr2(v1));
                    bf16x8 cb[4];
#pragma unroll
                    for (int ks = 0; ks < 4; ++ks) cb[ks] = mk8(pack4(C[2 * ks][j]), pack4(C[2 * ks + 1][j]));
#pragma unroll
                    for (int tt = 0; tt < 2; ++tt) {
                        f32x4 numI = z4; if (!(ABL & 4)) numI = mfma16(__builtin_bit_cast(bf16x8, tt ? pf1 : pf0), vb, z4);
                        f32x4 inter = z4;
                        if (!(ABL & 2)) {
#pragma unroll
                        for (int ks = 0; ks < 4; ++ks) inter = mfma16(M3_QF(tt, ks), cb[ks], inter); }
#pragma unroll
                        for (int i = 0; i < 4; ++i) *(LDSQ unsigned short*)(slot + M3_NT + (16 * tt + 4 * fq + i) * NTP + (16 * NJ * wave + 16 * j + fr) * 2) = f2bf(numI[i] + wi[tt][i] * inter[i]);
                    }
                    f32x4 w0, w1;
#pragma unroll
                    for (int i = 0; i < 4; ++i) { w0[i] = bf2f((unsigned short)v0[i]) * wt[0][i]; w1[i] = bf2f((unsigned short)v1[i]) * wt[1][i]; }
                    vwb[j] = mk8(pack4(w0), pack4(w1));
                }
#pragma unroll
                CST(2);
                for (int ci = 0; ci < ((ABL & 1) ? 0 : 8); ++ci) {
#ifdef ML_HOISTK
                    const bf16x8 ka = kaf[ci];
#else
                    const int ko = (4 * fq + (fr >> 2)) * M3P + (16 * ci + 4 * (fr & 3)) * 2;
                    const bf16x8 ka = mk8(tr2(TR16(slot + M3_K + ko)), tr2(TR16(slot + M3_K + 16 * M3P + ko)));
#endif
#pragma unroll
                    for (int j = 0; j < NJ; ++j) {
                        C[ci][j] *= wst;
#ifndef HOST_EMU
                        asm volatile("" : "+v"(C[ci][j]));
#endif
                        C[ci][j] = mfma16(ka, vwb[j], C[ci][j]); }
                }
                flag_st(done + wave, (unsigned)c + 1u);
            } else {
                const f32x4 rs0 = *(const LDSQ f32x4*)(slot + M3_RS + (4 * fq) * 4), rs1 = *(const LDSQ f32x4*)(slot + M3_RS + (16 + 4 * fq) * 4);
                bf16x8 cb[4];
#pragma unroll
                for (int ks = 0; ks < 4; ++ks) cb[ks] = mk8(pack4(C[2 * ks][0]), pack4(C[2 * ks + 1][0]));
#pragma unroll
                for (int tt = 0; tt < 2; ++tt) {
                    f32x4 inter = z4;
#pragma unroll
                    for (int ks = 0; ks < 4; ++ks) inter = mfma16(M3_QF(tt, ks), cb[ks], inter);
                    if (fr == 0) {
#pragma unroll
                        for (int i = 0; i < 4; ++i) *(LDSQ float*)(slot + M3_DN + (16 * tt + 4 * fq + i) * 4) = (tt ? rs1[i] : rs0[i]) + wi[tt][i] * inter[i];
                    }
                }
                f32x4 w0, w1;
#pragma unroll
                for (int i = 0; i < 4; ++i) { w0[i] = (fr == 0) ? wt[0][i] : 0.f; w1[i] = (fr == 0) ? wt[1][i] : 0.f; }
                const bf16x8 vwb = mk8(pack4(w0), pack4(w1));
#pragma unroll
                for (int ci = 0; ci < 8; ++ci) {
                    const int ko = (4 * fq + (fr >> 2)) * M3P + (16 * ci + 4 * (fr & 3)) * 2;
                    const bf16x8 ka = mk8(tr2(TR16(slot + M3_K + ko)), tr2(TR16(slot + M3_K + 16 * M3P + ko)));
                    C[ci][0] = mfma16(ka, vwb, C[ci][0] * wst);
                }
                flag_st(done + wave, (unsigned)c + 1u);
            }
        }
    } else {
        const int p = wave - 5;
        u32x4 tk[8], tq[8], tv[8]; float an = 0.f, mn = 0.f, mcn = 0.f;
#if defined(PST_PROBE) && !defined(HOST_EMU)
        unsigned pst_last_ = (unsigned)__builtin_amdgcn_s_memrealtime();
#endif
#define M3_LOAD(c_) do { _Pragma("unroll") for (int g = 0; g < 8; ++g) { const size_t r = (size_t)(32 * (c_) + 4 * g + lrow); \
        tk[g] = ld16(Kp + r * ldqk + 8 * lpc); tq[g] = ld16(Qp + r * ldqk + 8 * lpc); if (VW == 128) tv[g] = ld16(Vp + r * ldv + 8 * lpc); } \
    if (VW != 128) { _Pragma("unroll") for (int g = 0; g < 4; ++g) tv[g] = ld16(Vp + (size_t)(32 * (c_) + 8 * g + (lane >> 3)) * ldv + vc0 + 8 * (lane & 7)); } \
    an = SC_A[32 * (c_) + (lane & 31)]; mn = SC_M[32 * (c_) + (lane & 31)]; mcn = ((c_) > 0) ? SC_M[32 * (c_) - 1] : 0.f; } while (0)
#define M3_PARK(cc_) do { LDSQ unsigned char* ps_ = lds + ((cc_) % M3_NSLOT) * M3_SLOTX; \
        if ((cc_) >= M3_NSLOT) { const unsigned want_ = (unsigned)((cc_) - M3_NSLOT + 1); if (NCONS == 4) wait_ge4(done, want_, true); else { _Pragma("unroll") for (int w_ = 0; w_ < NCONS; ++w_) wait_ge_t(done + w_, want_, flags + 32 + wave); wait_ge_t(done + 4, want_, flags + 32 + wave); } PST(1); PARK_PROBE_WAIT(); M3_FLUSH(ps_, (cc_) - M3_NSLOT); PST(2); } \
        MEMFENCE(); \
        _Pragma("unroll") for (int g = 0; g < 8; ++g) { const int o_ = (4 * g + lrow) * M3P + lpc * 16; *(LDSQ u32x4*)(ps_ + M3_K + o_) = tk[g]; *(LDSQ u32x4*)(ps_ + M3_Q + o_) = tq[g]; if (VW == 128) *(LDSQ u32x4*)(ps_ + M3_V + o_) = tv[g]; } \
        if (VW != 128) { _Pragma("unroll") for (int g = 0; g < 4; ++g) *(LDSQ u32x4*)(ps_ + M3_V + (8 * g + (lane >> 3)) * M3VP + (lane & 7) * 16) = tv[g]; } \
        { const float Mend_ = WLANE(mn, 31);     \
          if (lane < 32) { *(LDSQ float*)(ps_ + M3_A + lane * 4) = an; *(LDSQ float*)(ps_ + M3_MX + lane * 4) = mn; \
              *(LDSQ float*)(ps_ + M3_WI + lane * 4) = fexp(mcn - mn); *(LDSQ float*)(ps_ + M3_WT + lane * 4) = fexp(an - Mend_); } \
          if (lane == 0) *(LDSQ float*)(ps_ + M3_WS) = fexp(mcn - Mend_); } \
        MEMFENCE(); WAVE_SYNC(); } while (0)
        if (p < NC) { M3_LOAD(p); M3_PARK(p); }
        for (int c = p; c < NC; c += 3) {
            if (c + 3 < NC) M3_LOAD(c + 3);
            const int sl = c % M3_NSLOT;
            LDSQ unsigned char* slot = lds + sl * M3_SLOTX;
            f32x4 st00 = z4, st01 = z4, st11 = z4;
#pragma unroll
            for (int ks = 0; ks < 4; ++ks) {
                const int o = fr * M3P + (32 * ks + 4 * fq) * 2;
                const bf16x8 k0 = mk8(ldl8(slot + M3_K + o), ldl8(slot + M3_K + o + 32)), k1 = mk8(ldl8(slot + M3_K + 16 * M3P + o), ldl8(slot + M3_K + 16 * M3P + o + 32));
                const bf16x8 q0 = mk8(ldl8(slot + M3_Q + o), ldl8(slot + M3_Q + o + 32)), q1 = mk8(ldl8(slot + M3_Q + 16 * M3P + o), ldl8(slot + M3_Q + 16 * M3P + o + 32));
                st00 = mfma16(k0, q0, st00); st01 = mfma16(k0, q1, st01); st11 = mfma16(k1, q1, st11);
            }
            const f32x4 as0 = *(const LDSQ f32x4*)(slot + M3_A + (4 * fq) * 4), as1 = *(const LDSQ f32x4*)(slot + M3_A + (16 + 4 * fq) * 4);
            const float mx0 = *(const LDSQ float*)(slot + M3_MX + fr * 4), mx1 = *(const LDSQ float*)(slot + M3_MX + (16 + fr) * 4);
            f32x4 p00, p01, p11;
#pragma unroll
            for (int i = 0; i < 4; ++i) {
                p00[i] = (4 * fq + i <= fr) ? st00[i] * fexp(as0[i] - mx0) : 0.f;
                p01[i] = st01[i] * fexp(as0[i] - mx1);
                p11[i] = (4 * fq + i <= fr) ? st11[i] * fexp(as1[i] - mx1) : 0.f;
            }
            float r0 = (p00[0] + p00[1]) + (p00[2] + p00[3]);
            float r1 = ((p01[0] + p01[1]) + (p01[2] + p01[3])) + ((p11[0] + p11[1]) + (p11[2] + p11[3]));
            r0 += SHX(r0, 16, lane); r0 += SHX(r0, 32, lane); r1 += SHX(r1, 16, lane); r1 += SHX(r1, 32, lane);
            if (fq == 0) { *(LDSQ float*)(slot + M3_RS + fr * 4) = r0; *(LDSQ float*)(slot + M3_RS + (16 + fr) * 4) = r1; }
            { const u32x2 a0 = pack4(p00); *(LDSQ u32x4*)(slot + M3_P + lane * 16) = (u32x4){a0.x, a0.y, 0u, 0u};
              const u32x2 b0 = pack4(p01), b1 = pack4(p11); *(LDSQ u32x4*)(slot + M3_P + 1024 + lane * 16) = (u32x4){b0.x, b0.y, b1.x, b1.y}; }
            flag_st(ready + sl, (unsigned)c + 1u); PST(0);
            if (c + 3 < NC) M3_PARK(c + 3);
            PST(3);
        }
        for (int c = NC - M3_NSLOT; c < NC; ++c) if (c >= 0 && (c % 3) == p) {
            const unsigned want = (unsigned)c + 1u;
            if (NCONS == 4) wait_ge4(done, want, true); else {
#pragma unroll
            for (int w_ = 0; w_ < NCONS; ++w_) wait_ge(done + w_, want);
            wait_ge(done + 4, want); }
            LDSQ unsigned char* sp = lds + (c % M3_NSLOT) * M3_SLOTX; M3_FLUSH(sp, c);
        }
#undef M3_FLUSH
#undef M3_PARK
#undef M3_LOAD
    }
}
#define GAS __attribute__((address_space(1)))
#define LAS __attribute__((address_space(3)))
typedef GAS unsigned gu32;
#define RLX_AGENT __ATOMIC_RELAXED, __HIP_MEMORY_SCOPE_AGENT
#define LDS_WAIT() asm volatile("s_waitcnt lgkmcnt(0)" ::: "memory")
#define VM_WAIT() asm volatile("s_waitcnt vmcnt(0)" ::: "memory")

constexpr int CB = 8, CS = 4096, CD = 1024, CM = CB * CS;
constexpr int NPROJ = 3584, PITCH_WIN = 3592, FF = 4096;
constexpr float NORM_EPS = 1e-6f, GN_EPS = 64e-5f;
constexpr int NWAVES = 8;
constexpr size_t MiB = 1u << 20;
constexpr size_t WS_CTL = 0, CTL_ZERO_BYTES = 64 * 1024;
constexpr size_t WS_W = 1 * MiB;
constexpr size_t WS_GATES = 27 * MiB, WS_DEN = 28 * MiB, WS_EMT = 28 * MiB + 512 * 1024, WS_BONUS = 29 * MiB;
constexpr size_t WS_SCA = 31 * MiB, WS_SCM = 31 * MiB + 512 * 1024;
constexpr size_t WS_U = 32 * MiB;
constexpr size_t WS_BIG = 97 * MiB;
constexpr size_t WS_PROJ = WS_BIG, WS_QKC = 321 * MiB, WS_VT = 385 * MiB, WS_NUM = 417 * MiB;
constexpr size_t WS_MIX = WS_BIG;
constexpr size_t WS_HID = WS_BIG, WS_FFO = 357 * MiB;
constexpr int YP = CD + 64;
constexpr int HLP = CD + 64;
constexpr int HIDP = FF + 64;
constexpr size_t WS_XR = 97 * MiB, WS_XK = 161 * MiB, WS_XV = 225 * MiB, WS_RO = 289 * MiB, WS_KO = 353 * MiB, WS_VO = 417 * MiB, WS_LORA = 481 * MiB, WS_GL = 497 * MiB;
constexpr size_t WS_KT = WS_XR, WS_BT = WS_XK, WS_KK = WS_XV, WS_RT = WS_U, WS_YRAW = WS_RO, WS_YG = WS_KO;
constexpr size_t WS_RS = 31 * MiB;
constexpr size_t WS_HL = 425 * MiB;
constexpr size_t WS_END = 505 * MiB;
constexpr size_t W_IN = 0, W_OUTE = 3670016, W_UP = 5242880, W_DN = 9437184;
constexpr size_t W_RKV = 0, W_LB1 = 3145728, W_LB2 = 3407872, W_OUTO = 3670016, W_W2T = 4980736, W_A2T = 5046272, W_G2T = 5111808;
constexpr int CW_BAR = 4096;

constexpr int RING_BYTES = 131072, LDSCTL_OFF = RING_BYTES, MISC_OFF = LDSCTL_OFF + 320, EPI_STG_OFF = LDSCTL_OFF + 512, LDS_BYTES = EPI_STG_OFF + 8 * 2048;

#define XB_TMO      128
#define XB_XCNT(j)  (256  + 64 * (j))
#define XB_XSUB(j)  (1280 + 64 * (j))
#define XB_XGEN(j)  (2304 + 64 * (j))
#define XB_TOP      3328
#define XB_TOPGEN   3392
#define XCD_BAR_WORDS 3456
#define XB_SPIN_CAP (1u << 18)
__device__ __forceinline__ unsigned xb_ld(unsigned* p)              { return __hip_atomic_load(p, __ATOMIC_RELAXED, __HIP_MEMORY_SCOPE_AGENT); }
__device__ __forceinline__ unsigned xb_add(unsigned* p, unsigned v) { return __hip_atomic_fetch_add(p, v, __ATOMIC_RELAXED, __HIP_MEMORY_SCOPE_AGENT); }
__device__ __forceinline__ unsigned xb_xcc_id() { return (unsigned)__builtin_amdgcn_s_getreg((3 << 11) | 20) & 0xFu; }
#define XB_SPIN(cond, bar) do { unsigned _sp = 0; while (cond) { __builtin_amdgcn_s_sleep(1); \
    if ((++_sp & 255u) == 0u) { if (xb_ld(&(bar)[XB_TMO])) break; if (_sp > XB_SPIN_CAP) { atomicAdd(&(bar)[XB_TMO], 1u); break; } } } } while (0)
struct XcdBarrier { unsigned* bar; unsigned x; volatile LAS unsigned* st; };
__device__ __forceinline__ XcdBarrier xcd_barrier_post(unsigned* bar, volatile LAS unsigned* st, bool t0) {
    XcdBarrier b; b.bar = bar; b.x = xb_xcc_id(); b.st = st;
    if (t0) (void)xb_add(&bar[XB_XCNT(b.x)], 1u);
    return b;
}
__device__ __forceinline__ void xcd_barrier_complete(unsigned* bar, unsigned x, unsigned& nloc, unsigned& nx) {
    const unsigned G = gridDim.x * gridDim.y * gridDim.z;
    unsigned sum, cnt, mine, sp = 0u;
    for (;;) {
        sum = 0u; cnt = 0u; mine = 0u;
#pragma unroll
        for (unsigned j = 0; j < 16; ++j) { const unsigned c = xb_ld(&bar[XB_XCNT(j)]); sum += c; cnt += (c > 0u) ? 1u : 0u; mine = (j == x) ? c : mine; }
        if (sum == G) break;
        __builtin_amdgcn_s_sleep(1);
        if ((++sp & 255u) == 0u) { if (xb_ld(&bar[XB_TMO])) break; if (sp > XB_SPIN_CAP) { atomicAdd(&bar[XB_TMO], 1u); break; } }
    }
    nloc = mine > 0u ? mine : 1u; nx = cnt > 0u ? cnt : 1u;
}
__device__ __forceinline__ void xcd_barrier(const XcdBarrier& b, bool t0) {
    asm volatile("s_waitcnt vmcnt(0)" ::: "memory");
    __syncthreads();
    if (t0) {
        unsigned* bar = b.bar;
        __builtin_amdgcn_s_waitcnt(0);
        unsigned nloc = b.st[0], nx = b.st[1];
        if (nloc == 0u) { xcd_barrier_complete(bar, b.x, nloc, nx); b.st[0] = nloc; b.st[1] = nx; }
        const unsigned old = xb_add(&bar[XB_XSUB(b.x)], 1u);
        const unsigned gen = old / nloc;
        if (old + 1u == (gen + 1u) * nloc) {
            __builtin_amdgcn_fence(__ATOMIC_RELEASE, "agent");
            asm volatile("s_waitcnt vmcnt(0)" ::: "memory");
            const unsigned og = xb_add(&bar[XB_TOP], 1u);
            const unsigned tg = og / nx;
            if (og + 1u == (tg + 1u) * nx) xb_add(&bar[XB_TOPGEN], 1u);
            else XB_SPIN(xb_ld(&bar[XB_TOPGEN]) == tg, bar);
            __builtin_amdgcn_fence(__ATOMIC_ACQUIRE, "agent");
            xb_add(&bar[XB_XGEN(b.x)], 1u);
            asm volatile("s_waitcnt vmcnt(0)" ::: "memory");
        } else {
            XB_SPIN(xb_ld(&bar[XB_XGEN(b.x)]) == gen, bar);
            __builtin_amdgcn_fence(__ATOMIC_ACQUIRE, "agent");
            asm volatile("s_waitcnt vmcnt(0)" ::: "memory");
        }
    }
    __syncthreads();
}

namespace pg8 {
constexpr int BM = 256, BK = 64, HALF = 128, HTB = HALF * BK * 2, STAGE_BYTES = 8 * HTB, NXCD = 8, WGM = 8;
__host__ __device__ __forceinline__ int lds_byte(int r, int c) { const int st = (r >> 4) * 2 + (c >> 5), rr = r & 15, cc = c & 31, ob = rr * 64 + cc * 2; return st * 1024 + (ob ^ (((ob >> 9) & 1) << 5)); }
__host__ __device__ __forceinline__ void stage_rc(int b, int& R, int& C) { const int st = b / 1024, sb = b % 1024, swz = sb ^ (((sb >> 9) & 1) << 5); R = (st >> 1) * 16 + swz / 64; C = (st & 1) * 32 + (swz % 64) / 2; }
__host__ __device__ __forceinline__ int perm32(int rho) { const int n = rho >> 4, i = rho & 15; return 8 * (i >> 2) + 4 * n + (i & 3); }
struct Unit { int pm, pn; };
struct UnitPtrs { const GAS char* A; const GAS char* B; int two; };
struct StaticOrder {
    int nM, nN, nwg, G, c;
    __device__ void init(int M, int N, int G_, int c_) { nM = M / BM; nN = N / BM; nwg = nM * nN; G = G_; c = c_; }
    __device__ bool next(int i, Unit& u) const {
        const long L = (long)i * G + c; if (L >= nwg) return false;
        int wgid = (int)L; { const int q = nwg / NXCD, r = nwg % NXCD, xcd = wgid % NXCD, off = wgid / NXCD; wgid = (xcd < r ? xcd * (q + 1) : r * (q + 1) + (xcd - r) * q) + off; }
        const int nig = WGM * nN, gid = wgid / nig, fm = gid * WGM, gsz = (nM - fm) < WGM ? (nM - fm) : WGM;
        u.pm = fm + ((wgid % nig) % gsz); u.pn = (wgid % nig) / gsz; return true;
    }
};
__device__ __forceinline__ unsigned cvt_pk_bf16(float lo, float hi) { unsigned r; asm volatile("v_cvt_pk_bf16_f32 %0, %1, %2" : "=v"(r) : "v"(lo), "v"(hi)); return r; }

template <int LDA, int LDB, int NT> struct ProbPlain {
    const GAS bf16_t* A; const GAS bf16_t* Bt;
    static constexpr long lda = LDA, ldb = LDB; static constexpr bool TWO_SRC = false; static constexpr int NTC = NT;
    __device__ __forceinline__ void ptrs(const Unit& u, UnitPtrs& p) const {
        p.A = (const GAS char*)(A + (size_t)u.pm * BM * lda); p.B = (const GAS char*)(Bt + (size_t)u.pn * BM * ldb);
    }
};
struct ProbRkv {
    const GAS bf16_t* X; size_t xstride; const GAS bf16_t* Wt; const GAS bf16_t* Upad; const GAS bf16_t* LB1; long lb2d;
    static constexpr long lda = 1024, ldb = 1024; static constexpr bool TWO_SRC = true; static constexpr int NTC = 16;
    __device__ __forceinline__ void ptrs(const Unit& u, UnitPtrs& p) const {
        if (u.pn < 12) { p.A = (const GAS char*)(X + (size_t)(u.pn >> 2) * xstride + (size_t)u.pm * BM * 1024); p.B = (const GAS char*)(Wt + (size_t)u.pn * BM * 1024); p.two = 0; }
        else { const size_t arow = (size_t)u.pm * BM + (size_t)(u.pm >> 4) + 1; p.A = (const GAS char*)(Upad + arow * 1024); p.B = (const GAS char*)LB1; p.two = 1; }
    }
};
struct RkvOrder2 {
    int c;
    __device__ bool next(int i, Unit& u) const {
        int idx;
        if (c < 128) { if (i == 0) { u.pm = c; u.pn = 12; return true; } if (i > 5) return false; idx = i * 256 + c; }
        else { if (i > 6) return false; idx = (i < 2) ? i * 128 + (c - 128) : (i - 1) * 256 + c; }
        const int w = (idx & 7) * 192 + (idx >> 3), gid = w / 96, rem = w % 96; u.pm = gid * 8 + (rem & 7); u.pn = rem >> 3; return true;
    }
};
struct RkvOrder {
    int c;
    __device__ bool next(int i, Unit& u) const { const int half = c & 1; if (i >= (half ? 6 : 7)) return false; u.pm = c >> 1; u.pn = half ? 7 + i : i; return true; }
};
struct EpiStore {
    GAS bf16_t* O; int ldc; int act; int rkv; size_t gstride; GAS bf16_t* Ol; int skip = 0;
    const GAS float* rsc = nullptr;
    static constexpr bool PERM = true;
    __device__ __forceinline__ void operator()(const f32x4 (&acc)[2][2][4][2], const Unit& u, int wr, int wc, int fr, int fq, LAS unsigned char* stgA, LAS unsigned char* stgB, int lane) const {
        if (skip == 2) return;
        GAS bf16_t* base = O; int ld = ldc, colt = u.pn * BM;
        if (rkv) { if (u.pn < 12) { base = O + (size_t)(u.pn >> 2) * gstride; colt = (u.pn & 3) * BM; } else { base = Ol; ld = 256; colt = 0; } }
        const int rowg = u.pm * BM + wr * 64, colw = colt + wc * 64;
        const int lact = (rkv && u.pn == 12) ? (wc == 0 ? 1 : wc == 1 ? 0 : 2) : 0;
        const int lrow = lane >> 3, lpc = lane & 7;
        const unsigned wA = (unsigned)((fr >> 3) * 1024 + (fr & 7) * 128), wB = (unsigned)((fr >> 3) * 8192 + (fr & 7) * 128);
        const unsigned sw0 = (unsigned)((fq ^ (fr & 7)) << 4), sw1 = (unsigned)(((4 + fq) ^ (fr & 7)) << 4);
        const unsigned rd = (unsigned)(lrow * 128 + ((lpc ^ lrow) << 4));
        GAS bf16_t* srow = base + (size_t)(rowg + lrow) * ld + colw + 8 * lpc;
#define EPI_WRITE(r_) do { constexpr int ai_ = (r_) >> 2, m_ = (r_) & 3; LAS unsigned char* wb_ = ((r_) & 1) ? stgA + wA : stgB + wB; \
            const float rs_ = rsv[(r_)]; \
            _Pragma("unroll") for (int bj = 0; bj < 2; ++bj) { f32x4 v0 = acc[ai_][bj][m_][0] * rs_, v1 = acc[ai_][bj][m_][1] * rs_; \
                if (act == 1) { _Pragma("unroll") for (int q = 0; q < 4; ++q) { const float a = fmaxf(v0[q], 0.f), b = fmaxf(v1[q], 0.f); v0[q] = a * a; v1[q] = b * b; } } \
                if (lact == 1) { _Pragma("unroll") for (int q = 0; q < 4; ++q) { v0[q] = tanhf_(v0[q]); v1[q] = tanhf_(v1[q]); } } \
                if (lact == 2) { _Pragma("unroll") for (int q = 0; q < 4; ++q) { v0[q] = sigmoidf_(v0[q]); v1[q] = sigmoidf_(v1[q]); } } \
                u32x4 w; w.x = cvt_pk_bf16(v0[0], v0[1]); w.y = cvt_pk_bf16(v0[2], v0[3]); w.z = cvt_pk_bf16(v1[0], v1[1]); w.w = cvt_pk_bf16(v1[2], v1[3]); \
                *(LAS u32x4*)(wb_ + (bj ? sw1 : sw0)) = w; } } while (0)
#define EPI_READ(r_, o0_, o1_) do { LAS unsigned char* rb_ = ((r_) & 1) ? stgA : stgB; constexpr int hs_ = ((r_) & 1) ? 1024 : 8192; \
            o0_ = *(const LAS u32x4*)(rb_ + rd); o1_ = *(const LAS u32x4*)(rb_ + hs_ + rd); } while (0)
#define EPI_STORE(r_, o0_, o1_) do { constexpr int ai_ = (r_) >> 2, m_ = (r_) & 3; if (!skip) { \
            *(GAS u32x4*)(srow + (size_t)(ai_ * HALF + m_ * 16) * ld) = o0_; *(GAS u32x4*)(srow + (size_t)(ai_ * HALF + m_ * 16 + 8) * ld) = o1_; } } while (0)
#define EPI_STEP(r_) do { u32x4 o0_, o1_; EPI_READ((r_) - 1, o0_, o1_); asm volatile("" ::: "memory"); EPI_WRITE(r_); asm volatile("" ::: "memory"); EPI_STORE((r_) - 1, o0_, o1_); asm volatile("" ::: "memory"); } while (0)
        float rsv[8];
#pragma unroll
        for (int r8 = 0; r8 < 8; ++r8) rsv[r8] = rsc ? rsc[rowg + (r8 >> 2) * HALF + (r8 & 3) * 16 + fr] : 1.0f;
        EPI_WRITE(0); asm volatile("" ::: "memory");
        EPI_STEP(1); EPI_STEP(2); EPI_STEP(3); EPI_STEP(4); EPI_STEP(5); EPI_STEP(6); EPI_STEP(7);
        { u32x4 o0_, o1_; EPI_READ(7, o0_, o1_); EPI_STORE(7, o0_, o1_); asm volatile("" ::: "memory"); }
#undef EPI_WRITE
#undef EPI_READ
#undef EPI_STORE
#undef EPI_STEP
    }
};

template <class Prob, class Epi, class Sched>
__device__ __forceinline__ void gemm_phase(LAS unsigned char* lds, int wave_in, const Prob& P, const Sched& S, const Epi& E) {
    const int wid = __builtin_amdgcn_readfirstlane(wave_in); const int lane = lane_id(); const int tid = wid * 64 + lane;
    const int wr = wid >> 2, wc = wid & 3, fr = lane & 15, fq = lane >> 4;
    constexpr long lda = Prob::lda, ldb = Prob::ldb; long lb2d = 0; if constexpr (Prob::TWO_SRC) lb2d = P.lb2d;
    unsigned voffA[2], voffB[2];
#pragma unroll
    for (int i = 0; i < 2; ++i) { int R, C; stage_rc(tid * 16 + i * 8192, R, C); const int Rb = 64 * (R >> 5) + perm32(R & 31);
        voffA[i] = (unsigned)(R * lda + C) * 2u; voffB[i] = (unsigned)(Rb * ldb + C) * 2u; }
    const long kstep = (long)(BK * 2);
    const long hstepA = (long)HALF * lda * 2, hstepB = (long)32 * ldb * 2;
    const unsigned ldsw = (unsigned)wid * 1024u;
    const int aoff = lds_byte(wr * 64 + fr, fq * 8), boff = lds_byte(wc * 32 + fr, fq * 8);
#define PG8_SA(b, h) (((b) * 2 + (h)) * HTB)
#define PG8_SB(b, h) ((4 + (b) * 2 + (h)) * HTB)
#define PG8_STAGE(bufoff, gbase, voff) do { _Pragma("unroll") for (int _i = 0; _i < 2; ++_i) \
        __builtin_amdgcn_global_load_lds((const GAS unsigned*)((const GAS char*)(gbase) + (voff)[_i]), (LAS unsigned*)(lds + (bufoff) + ldsw + _i * 8192), 16, 0, 0); } while (0)
#define PG8_LDA(dst, b, h) do { _Pragma("unroll") for (int m = 0; m < 4; ++m) _Pragma("unroll") for (int k = 0; k < 2; ++k) dst[m][k] = *(const LAS bf16x8*)(lds + PG8_SA(b, h) + aoff + m * 2048 + k * 1024); } while (0)
#define PG8_LDB(dst, b, h) do { _Pragma("unroll") for (int n = 0; n < 2; ++n) _Pragma("unroll") for (int k = 0; k < 2; ++k) dst[n][k] = *(const LAS bf16x8*)(lds + PG8_SB(b, h) + boff + n * 2048 + k * 1024); } while (0)
#define PG8_MMA(ai, bj, At, Bt) do { __builtin_amdgcn_s_setprio(1); _Pragma("unroll") for (int m = 0; m < 4; ++m) _Pragma("unroll") for (int n = 0; n < 2; ++n) _Pragma("unroll") for (int k = 0; k < 2; ++k) \
        acc[ai][bj][m][n] = __builtin_amdgcn_mfma_f32_16x16x32_bf16(Bt[n][k], At[m][k], acc[ai][bj][m][n], 0, 0, 0); __builtin_amdgcn_s_setprio(0); } while (0)
#define PG8_WAIT_V(n) asm volatile("s_waitcnt vmcnt(" #n ")" ::: "memory")
#define PG8_WAIT_L(n) asm volatile("s_waitcnt lgkmcnt(" #n ")" ::: "memory")
#define PG8_BAR __builtin_amdgcn_s_barrier()
#define PG8_SCHED __builtin_amdgcn_sched_barrier(0)
#define PG8_KTA(p, tau) ((p).A + ((!Prob::TWO_SRC || (tau) < 16) ? (long)(tau) * kstep : (long)((tau) - 16) * kstep - 2048))
#define PG8_KTB(p, tau) ((p).B + ((!Prob::TWO_SRC || (tau) < 16) ? (long)(tau) * kstep : (long)((tau) - 16) * kstep + lb2d))
    Unit cur, nxt; int ui = 0;
    if (!S.next(0, cur)) return;
    UnitPtrs cp, np; P.ptrs(cur, cp);
    f32x4 acc[2][2][4][2];
#pragma unroll
    for (int a = 0; a < 2; ++a)
#pragma unroll
        for (int b = 0; b < 2; ++b)
#pragma unroll
            for (int m = 0; m < 4; ++m)
#pragma unroll
                for (int n = 0; n < 2; ++n) acc[a][b][m][n] = (f32x4){0.f, 0.f, 0.f, 0.f};
    bf16x8 At[4][2], B0[2][2], B1[2][2];
    {
        const GAS char* cA = cp.A; const GAS char* cB = cp.B;
        PG8_STAGE(PG8_SB(0, 0), cB, voffB); PG8_STAGE(PG8_SB(0, 1), cB + hstepB, voffB); PG8_STAGE(PG8_SA(0, 0), cA, voffA); PG8_STAGE(PG8_SA(0, 1), cA + hstepA, voffA);
        if (wr == 1) PG8_BAR;
        PG8_WAIT_V(2); PG8_BAR;
        PG8_STAGE(PG8_SB(1, 0), cB + kstep, voffB); PG8_STAGE(PG8_SA(1, 0), cA + kstep, voffA); PG8_STAGE(PG8_SB(1, 1), cB + hstepB + kstep, voffB);
        PG8_WAIT_V(6); PG8_BAR;
    }
    for (;;) {
        const bool has_next = S.next(ui + 1, nxt);
        if (has_next) P.ptrs(nxt, np); else np = cp;
        int nt = Prob::NTC; if constexpr (Prob::TWO_SRC) { if (cp.two) nt = 32; }
        for (int t = 0; t < nt; t += 2) {
            const bool last = (t == nt - 2);
            const GAS char* a1 = PG8_KTA(cp, t + 1);
            const GAS char* a2 = last ? np.A : PG8_KTA(cp, t + 2); const GAS char* b2 = last ? np.B : PG8_KTB(cp, t + 2);
            const GAS char* a3 = a2 + kstep; const GAS char* b3 = b2 + kstep;
            PG8_LDB(B0, 0, 0); PG8_LDB(B1, 0, 1); PG8_SCHED; PG8_LDA(At, 0, 0); PG8_STAGE(PG8_SA(1, 1), a1 + hstepA, voffA);
            PG8_WAIT_V(8); PG8_WAIT_L(0); PG8_BAR; PG8_MMA(0, 0, At, B0); PG8_MMA(0, 1, At, B1); PG8_BAR; PG8_SCHED;
            PG8_LDA(At, 0, 1); PG8_STAGE(PG8_SB(0, 0), b2, voffB); PG8_STAGE(PG8_SB(0, 1), b2 + hstepB, voffB); PG8_STAGE(PG8_SA(0, 0), a2, voffA);
            PG8_WAIT_V(8); PG8_WAIT_L(0); PG8_BAR; PG8_MMA(1, 0, At, B0); PG8_MMA(1, 1, At, B1); PG8_BAR; PG8_SCHED;
            PG8_LDB(B0, 1, 0); PG8_LDB(B1, 1, 1); PG8_SCHED; PG8_LDA(At, 1, 0); PG8_STAGE(PG8_SA(0, 1), a2 + hstepA, voffA);
            PG8_WAIT_V(8); PG8_WAIT_L(0); PG8_BAR; PG8_MMA(0, 0, At, B0); PG8_MMA(0, 1, At, B1); PG8_BAR; PG8_SCHED;
            PG8_LDA(At, 1, 1); PG8_STAGE(PG8_SB(1, 0), b3, voffB); PG8_STAGE(PG8_SB(1, 1), b3 + hstepB, voffB); PG8_STAGE(PG8_SA(1, 0), a3, voffA);
            PG8_WAIT_V(8); PG8_WAIT_L(0); PG8_BAR; PG8_MMA(1, 0, At, B0); PG8_MMA(1, 1, At, B1); PG8_BAR; PG8_SCHED;
        }
        if (wr == 0) PG8_BAR;
        E(acc, cur, wr, wc, fr, fq, lds + EPI_STG_OFF + wid * 2048, lds + PG8_SA(1, 1) + wid * 1024, lane);
        if (!has_next) break;
#pragma unroll
        for (int a = 0; a < 2; ++a)
#pragma unroll
            for (int b = 0; b < 2; ++b)
#pragma unroll
                for (int m = 0; m < 4; ++m)
#pragma unroll
                    for (int n = 0; n < 2; ++n) acc[a][b][m][n] = (f32x4){0.f, 0.f, 0.f, 0.f};
        cur = nxt; cp = np; ++ui;
        if (wr == 1) PG8_BAR;
    }
    PG8_WAIT_V(0);
    PG8_BAR;
#undef PG8_SA
#undef PG8_SB
#undef PG8_STAGE
#undef PG8_LDA
#undef PG8_LDB
#undef PG8_MMA
#undef PG8_WAIT_V
#undef PG8_WAIT_L
#undef PG8_BAR
#undef PG8_SCHED
#undef PG8_KTA
#undef PG8_KTB
}
}

struct Frame {
    LAS unsigned char* lds;
    int tid, lane, wave, vcu, G, gw, NGW;
};
#define DPP_ADD(v, ctrl) v += __builtin_bit_cast(float, __builtin_amdgcn_update_dpp(0, __builtin_bit_cast(int, v), ctrl, 0xF, 0xF, true))
__device__ __forceinline__ float wave_sum(float v, int lane) {
    DPP_ADD(v, 0xB1); DPP_ADD(v, 0x4E); DPP_ADD(v, 0x141); DPP_ADD(v, 0x140);
    v += SHX(v, 16, lane); v += SHX(v, 32, lane);
    return v;
}
__device__ __forceinline__ void cvt_item(const GAS float* W, int ldw, GAS bf16_t* WT, int ldt, int k0, int n0, const GAS float* sc, int mode, LAS float* scr, int lane) {
#pragma unroll 8
    for (int i = 0; i < 32; ++i) { const int kk = 2 * i + (lane >> 5); float v = W[(size_t)(k0 + kk) * ldw + n0 + (lane & 31)];
        if (mode) { const float s = sc[k0 + kk]; v *= (mode == 1) ? s : (1.0f - s); }
        scr[kk * 33 + (lane & 31)] = v; }
    LDS_WAIT(); asm volatile("" ::: "memory");
    const int c = lane & 7;
#pragma unroll
    for (int j = 0; j < 4; ++j) { const int n = (lane >> 3) + 8 * j; const LAS float* s = scr + (8 * c) * 33 + n;
        u32x4 o; o.x = pk2(s[0 * 33], s[1 * 33]); o.y = pk2(s[2 * 33], s[3 * 33]); o.z = pk2(s[4 * 33], s[5 * 33]); o.w = pk2(s[6 * 33], s[7 * 33]);
        *(GAS u32x4*)(WT + (size_t)(n0 + n) * ldt + k0 + 8 * c) = o; }
    LDS_WAIT(); asm volatile("" ::: "memory");
}
__device__ __forceinline__ void cvt_matrix(const Frame& F, const GAS float* W, int ldw, int K, int N, GAS bf16_t* WT, int ldt, const GAS float* sc, int mode, int& cursor) {
    LAS float* scr = (LAS float*)(F.lds + F.wave * 16384);
    const int nnb = N / 32, nitems = (K / 64) * nnb;
    int first = (F.gw - cursor) % F.NGW; if (first < 0) first += F.NGW;
    for (int it = first; it < nitems; it += F.NGW) cvt_item(W, ldw, WT, ldt, 64 * (it / nnb), 32 * (it % nnb), sc, mode, scr, F.lane);
    cursor += nitems;
}
struct Inputs { const float* p[25]; };
#define INP(i) ((const GAS float*)in.p[i])
__device__ __forceinline__ void convert_layer(const Frame& F, const Inputs& in, GAS bf16_t* Wb, int L, int part) {
    int cur = 0;
    if (part == 0) {
        if ((L & 1) == 0) {
            const int e = L >> 1;
            cvt_matrix(F, INP(2) + (size_t)e * 1024 * PITCH_WIN, PITCH_WIN, 1024, NPROJ, Wb + W_IN, 1024, nullptr, 0, cur);
        } else {
            const int o = L >> 1; const GAS float* mu = INP(7) + (size_t)o * 6 * 1024;
            for (int j = 0; j < 3; ++j) cvt_matrix(F, INP(8) + ((size_t)o * 3 + j) * 1024 * 1024, 1024, 1024, 1024, Wb + W_RKV + (size_t)j * 1024 * 1024, 1024, nullptr, 0, cur);
            for (int s = 0; s < 2; ++s) { GAS bf16_t* LB = Wb + (s ? W_LB2 : W_LB1); const int mode = s ? 1 : 2;
                cvt_matrix(F, INP(10) + (size_t)o * 1024 * 64, 64, 1024, 64, LB, 1024, mu + 1 * 1024, mode, cur);
                cvt_matrix(F, INP(13) + (size_t)o * 1024 * 64, 64, 1024, 64, LB + 64 * 1024, 1024, mu + 4 * 1024, mode, cur);
                cvt_matrix(F, INP(15) + (size_t)o * 1024 * 128, 128, 1024, 128, LB + 128 * 1024, 1024, mu + 5 * 1024, mode, cur); }
            cvt_matrix(F, INP(11) + (size_t)o * 64 * 1024, 1024, 64, 1024, Wb + W_W2T, 64, nullptr, 0, cur);
            cvt_matrix(F, INP(14) + (size_t)o * 64 * 1024, 1024, 64, 1024, Wb + W_A2T, 64, nullptr, 0, cur);
            cvt_matrix(F, INP(16) + (size_t)o * 128 * 1024, 1024, 128, 1024, Wb + W_G2T, 128, nullptr, 0, cur);
        }
        return;
    }
    if ((L & 1) == 0) cvt_matrix(F, INP(6) + (size_t)(L >> 1) * 1024 * 1024, 1024, 1024, 1024, Wb + W_OUTE, 1024, nullptr, 0, cur);
    else cvt_matrix(F, INP(22) + (size_t)(L >> 1) * 1024 * 1024, 1024, 1024, 1024, Wb + W_OUTO, 1024, nullptr, 0, cur);
    cvt_matrix(F, INP(23) + (size_t)L * 1024 * FF, FF, 1024, FF, Wb + W_UP, 1024, INP(1) + (size_t)L * 4 * 1024 + 2 * 1024, 1, cur);
    cvt_matrix(F, INP(24) + (size_t)L * FF * 1024, 1024, FF, 1024, Wb + W_DN, FF, nullptr, 0, cur);
}

struct RowPassArgs {
    const GAS void* hsrc; const GAS bf16_t* y; const GAS float* gpost; GAS void* hdst;
    GAS bf16_t* udst; const GAS float* gpre; int upad;
    const GAS float* gate_w; const GAS float* gate_b; GAS float* gates;
    int hsp = CD, hdp = CD;
    int yp = YP;
    GAS float* rsdst = nullptr;
};
template <int R, int HS, int HD>
__device__ __forceinline__ void row_pass_range(const Frame& F, const RowPassArgs& A, int row0, int rend, int rstep) {
    LAS float* GWT = (LAS float*)(F.lds + 65536);
    if (A.gates) {
        for (int idx = F.tid; idx < 8192; idx += NWAVES * 64) { const int k = idx >> 3, j = idx & 7; GWT[j * 1024 + k] = A.gate_w[(size_t)k * PITCH_WIN + NPROJ + j]; }
        __syncthreads();
    }
    f32x4 gp[4], gq[4];
#pragma unroll
    for (int j = 0; j < 4; ++j) { gp[j] = A.gpost ? *(const GAS f32x4*)(A.gpost + 4 * F.lane + 256 * j) : (f32x4){0.f, 0.f, 0.f, 0.f}; gq[j] = A.gpre ? *(const GAS f32x4*)(A.gpre + 4 * F.lane + 256 * j) : (f32x4){0.f, 0.f, 0.f, 0.f}; }
    for (int base = row0; base < rend; base += rstep) {
        f32x4 hv[R][4]; u32x2 yw[R][4];
#pragma unroll
        for (int r = 0; r < R; ++r)
#pragma unroll
            for (int j = 0; j < 4; ++j) {
                if (HS) { const u32x2 w = ld8((const GAS bf16_t*)A.hsrc + (size_t)(base + r) * A.hsp + 4 * F.lane + 256 * j);
                    hv[r][j] = (f32x4){bf2f((unsigned short)(w.x & 0xffffu)), bf2f((unsigned short)(w.x >> 16)), bf2f((unsigned short)(w.y & 0xffffu)), bf2f((unsigned short)(w.y >> 16))}; }
                else hv[r][j] = *(const GAS f32x4*)((const GAS float*)A.hsrc + (size_t)(base + r) * CD + 4 * F.lane + 256 * j);
                if (A.y) yw[r][j] = ld8(A.y + (size_t)(base + r) * A.yp + 4 * F.lane + 256 * j); }
        if (A.y) {
            f32x4 yf[R][4]; float ss[R];
#pragma unroll
            for (int r = 0; r < R; ++r) { ss[r] = 0.f;
#pragma unroll
                for (int j = 0; j < 4; ++j) { const u32x2 w = yw[r][j];
                    yf[r][j] = (f32x4){bf2f((unsigned short)(w.x & 0xffffu)), bf2f((unsigned short)(w.x >> 16)), bf2f((unsigned short)(w.y & 0xffffu)), bf2f((unsigned short)(w.y >> 16))};
                    ss[r] += (yf[r][j][0] * yf[r][j][0] + yf[r][j][1] * yf[r][j][1]) + (yf[r][j][2] * yf[r][j][2] + yf[r][j][3] * yf[r][j][3]); } }
#pragma unroll
            for (int r = 0; r < R; ++r) ss[r] = wave_sum(ss[r], F.lane);
#pragma unroll
            for (int r = 0; r < R; ++r) { const float rs = __builtin_amdgcn_rsqf(ss[r] * (1.0f / CD) + NORM_EPS);
#pragma unroll
                for (int j = 0; j < 4; ++j) { hv[r][j] += yf[r][j] * rs * gp[j];
                    if (!A.hdst) continue;
                    if (HD) *(GAS u32x2*)((GAS bf16_t*)A.hdst + (size_t)(base + r) * A.hdp + 4 * F.lane + 256 * j) = pack4(hv[r][j]);
                    else *(GAS f32x4*)((GAS float*)A.hdst + (size_t)(base + r) * CD + 4 * F.lane + 256 * j) = hv[r][j]; } }
        }
        if (A.udst || A.rsdst) {
            float ss[R];
#pragma unroll
            for (int r = 0; r < R; ++r) { ss[r] = 0.f;
#pragma unroll
                for (int j = 0; j < 4; ++j) ss[r] += (hv[r][j][0] * hv[r][j][0] + hv[r][j][1] * hv[r][j][1]) + (hv[r][j][2] * hv[r][j][2] + hv[r][j][3] * hv[r][j][3]); }
#pragma unroll
            for (int r = 0; r < R; ++r) ss[r] = wave_sum(ss[r], F.lane);
#pragma unroll
            for (int r = 0; r < R; ++r) {
                const int row = base + r;
                const float rs = __builtin_amdgcn_rsqf(ss[r] * (1.0f / CD) + NORM_EPS);
                if (A.rsdst) { if (F.lane == 0) A.rsdst[row] = rs; continue; }
                const size_t urow = A.upad ? (size_t)row + (size_t)(row / CS) + 1 : (size_t)row;
                f32x4 uf[4];
#pragma unroll
                for (int j = 0; j < 4; ++j) { uf[j] = hv[r][j] * rs * gq[j]; *(GAS u32x2*)(A.udst + urow * CD + 4 * F.lane + 256 * j) = pack4(uf[j]); }
                if (A.upad && (row % CS) == 0) {
#pragma unroll
                    for (int j = 0; j < 4; ++j) *(GAS u32x2*)(A.udst + (urow - 1) * CD + 4 * F.lane + 256 * j) = (u32x2){0u, 0u};
                }
                if (A.gates) {
                    float v[8];
                    int goff = 4 * F.lane; asm volatile("" : "+v"(goff));
#pragma unroll
                    for (int g = 0; g < 8; ++g) { float s = 0.f;
#pragma unroll
                        for (int j = 0; j < 4; ++j) { const f32x4 w = *(const LAS f32x4*)(GWT + g * 1024 + goff + 256 * j); s += (uf[j][0] * w[0] + uf[j][1] * w[1]) + (uf[j][2] * w[2] + uf[j][3] * w[3]); }
                        v[g] = s; }
                    const bool b5 = (F.lane & 32) != 0, b4 = (F.lane & 16) != 0, b3 = (F.lane & 8) != 0;
                    float r4[4], r2[2];
#pragma unroll
                    for (int i = 0; i < 4; ++i) { const float snd = b5 ? v[i] : v[i + 4], kp = b5 ? v[i + 4] : v[i]; r4[i] = kp + SHX(snd, 32, F.lane); }
#pragma unroll
                    for (int i = 0; i < 2; ++i) { const float snd = b4 ? r4[i] : r4[i + 2], kp = b4 ? r4[i + 2] : r4[i]; r2[i] = kp + SHX(snd, 16, F.lane); }
                    float r1; { const float snd = b3 ? r2[0] : r2[1], kp = b3 ? r2[1] : r2[0]; r1 = kp + __builtin_bit_cast(float, __builtin_amdgcn_update_dpp(0, __builtin_bit_cast(int, snd), 0x128  , 0xF, 0xF, true)); }
                    DPP_ADD(r1, 0xB1); DPP_ADD(r1, 0x4E); DPP_ADD(r1, 0x141);
                    if ((F.lane & 7) == 0) { const int o = F.lane >> 3; float g = r1 + A.gate_b[o]; if (o >= 4) g = -softplusf(-g); A.gates[(size_t)row * 8 + o] = g; }
                }
            }
        }
    }
}
template <int R, int HS, int HD>
__device__ __forceinline__ void row_pass(const Frame& F, const RowPassArgs& A) { row_pass_range<R, HS, HD>(F, A, F.gw * R, CM, F.NGW * R); }
__device__ __forceinline__ void mix_block(const Frame& F, const GAS bf16_t* Upad, const GAS bf16_t* halo, const GAS float* mu, GAS bf16_t* XR, GAS bf16_t* XK, GAS bf16_t* XV, int blk0) {
    f32x4 m0[4], m2[4], m3[4];
#pragma unroll
    for (int j = 0; j < 4; ++j) { m0[j] = *(const GAS f32x4*)(mu + 0 * 1024 + 4 * F.lane + 256 * j); m2[j] = *(const GAS f32x4*)(mu + 2 * 1024 + 4 * F.lane + 256 * j); m3[j] = *(const GAS f32x4*)(mu + 3 * 1024 + 4 * F.lane + 256 * j); }
    constexpr int R = 4;
    for (int base = blk0 + 16 * F.wave; base < blk0 + 16 * F.wave + 16; base += R) {
        u32x2 a[R][4], b[R][4];
#pragma unroll
        for (int r = 0; r < R; ++r) { const int row = base + r; const size_t urow = (size_t)row + (size_t)(row / CS) + 1;
            const GAS bf16_t* prev = (row == blk0 && (row % CS) != 0) ? halo : Upad + (urow - 1) * CD;
#pragma unroll
            for (int j = 0; j < 4; ++j) { const size_t c = 4 * F.lane + 256 * j; a[r][j] = ld8(Upad + urow * CD + c); b[r][j] = ld8(prev + c); } }
#pragma unroll
        for (int r = 0; r < R; ++r)
#pragma unroll
            for (int j = 0; j < 4; ++j) {
                const size_t c = 4 * F.lane + 256 * j;
                const f32x4 u = {bf2f((unsigned short)(a[r][j].x & 0xffffu)), bf2f((unsigned short)(a[r][j].x >> 16)), bf2f((unsigned short)(a[r][j].y & 0xffffu)), bf2f((unsigned short)(a[r][j].y >> 16))};
                const f32x4 p = {bf2f((unsigned short)(b[r][j].x & 0xffffu)), bf2f((unsigned short)(b[r][j].x >> 16)), bf2f((unsigned short)(b[r][j].y & 0xffffu)), bf2f((unsigned short)(b[r][j].y >> 16))};
                const f32x4 xx = p - u;
                *(GAS u32x2*)(XR + (size_t)(base + r) * CD + c) = pack4(u + xx * m0[j]);
                *(GAS u32x2*)(XK + (size_t)(base + r) * CD + c) = pack4(u + xx * m2[j]);
                *(GAS u32x2*)(XV + (size_t)(base + r) * CD + c) = pack4(u + xx * m3[j]);
            }
    }
}
__device__ __forceinline__ void mix_pass(const Frame& F, const GAS bf16_t* Upad, const GAS float* mu, GAS bf16_t* XR, GAS bf16_t* XK, GAS bf16_t* XV) {
    f32x4 m0[4], m2[4], m3[4];
#pragma unroll
    for (int j = 0; j < 4; ++j) { m0[j] = *(const GAS f32x4*)(mu + 0 * 1024 + 4 * F.lane + 256 * j); m2[j] = *(const GAS f32x4*)(mu + 2 * 1024 + 4 * F.lane + 256 * j); m3[j] = *(const GAS f32x4*)(mu + 3 * 1024 + 4 * F.lane + 256 * j); }
    constexpr int R = 4;
    for (int base = F.gw * R; base < CM; base += F.NGW * R) {
        u32x2 a[R][4], b[R][4];
#pragma unroll
        for (int r = 0; r < R; ++r) { const size_t urow = (size_t)(base + r) + (size_t)((base + r) / CS) + 1;
#pragma unroll
            for (int j = 0; j < 4; ++j) { const size_t c = 4 * F.lane + 256 * j; a[r][j] = ld8(Upad + urow * CD + c); b[r][j] = ld8(Upad + (urow - 1) * CD + c); } }
#pragma unroll
        for (int r = 0; r < R; ++r)
#pragma unroll
            for (int j = 0; j < 4; ++j) {
                const size_t c = 4 * F.lane + 256 * j;
                const f32x4 u = {bf2f((unsigned short)(a[r][j].x & 0xffffu)), bf2f((unsigned short)(a[r][j].x >> 16)), bf2f((unsigned short)(a[r][j].y & 0xffffu)), bf2f((unsigned short)(a[r][j].y >> 16))};
                const f32x4 p = {bf2f((unsigned short)(b[r][j].x & 0xffffu)), bf2f((unsigned short)(b[r][j].x >> 16)), bf2f((unsigned short)(b[r][j].y & 0xffffu)), bf2f((unsigned short)(b[r][j].y >> 16))};
                const f32x4 xx = p - u;
                *(GAS u32x2*)(XR + (size_t)(base + r) * CD + c) = pack4(u + xx * m0[j]);
                *(GAS u32x2*)(XK + (size_t)(base + r) * CD + c) = pack4(u + xx * m2[j]);
                *(GAS u32x2*)(XV + (size_t)(base + r) * CD + c) = pack4(u + xx * m3[j]);
            }
    }
}
template <int PARTS = 7>
__device__ __forceinline__ void conv_vt_pass(const Frame& F, const GAS bf16_t* PROJ, const GAS float* convw, GAS bf16_t* QKC, GAS bf16_t* VT, const GAS float* GATES, GAS float* SCA, GAS float* SCM, GAS float* SCE) {
    if ((PARTS & 1) && blockIdx.x < 32) { const int st = blockIdx.x, b = st >> 2, mh = st & 3; mlstm_gate_scan_wg(F.wave, GATES + (size_t)b * CS * 8, mh, 4 + mh, CS, SCA + (size_t)st * CS, SCM + (size_t)st * CS, SCE + (size_t)st * CS, (LAS float*)(F.lds + 80000)); }
    if (PARTS & 2) {
        const int cg = F.tid & 127, rs = F.tid >> 7, c0 = 8 * cg;
        float w[4][8];
#pragma unroll
        for (int j = 0; j < 4; ++j) { const f32x4 a = *(const GAS f32x4*)(convw + j * 1024 + c0), b = *(const GAS f32x4*)(convw + j * 1024 + c0 + 4);
#pragma unroll
            for (int q = 0; q < 4; ++q) { w[j][q] = a[q]; w[j][4 + q] = b[q]; } }
        const float osc = (c0 >= 512) ? 0.08838834764831845f : 1.0f;
        const u32x4 zz = {0u, 0u, 0u, 0u};
        u32x4 xa[19], xb[19];
#define CV_LOAD(x_, ub_) do { const int r0_ = (ub_) * 64 + rs * 16, tin_ = r0_ % CS; \
            _Pragma("unroll") for (int j = 0; j < 3; ++j) x_[j] = (tin_ >= 3 - j) ? ld16(PROJ + (size_t)(r0_ - 3 + j) * NPROJ + 1536 + c0) : zz;       \
            _Pragma("unroll") for (int i = 0; i < 16; ++i) x_[3 + i] = ld16(PROJ + (size_t)(r0_ + i) * NPROJ + 1536 + c0); } while (0)
        int ub = blockIdx.x;
        if (ub < CM / 64) CV_LOAD(xa, ub);
        for (; ub < CM / 64; ub += F.G) {
            const int r0 = ub * 64 + rs * 16;
            const bool more = ub + F.G < CM / 64;
            if (more) CV_LOAD(xb, ub + F.G);
#pragma unroll
            for (int i = 0; i < 16; ++i) {
                const u32x4 x0 = xa[i], x1 = xa[i + 1], x2 = xa[i + 2], x3 = xa[i + 3];
                u32x4 o;
#pragma unroll
                for (int q = 0; q < 4; ++q) {
                    float acc0 = w[0][2 * q] * bf2f((unsigned short)(x0[q] & 0xffffu)) + w[1][2 * q] * bf2f((unsigned short)(x1[q] & 0xffffu)) + w[2][2 * q] * bf2f((unsigned short)(x2[q] & 0xffffu)) + w[3][2 * q] * bf2f((unsigned short)(x3[q] & 0xffffu));
                    float acc1 = w[0][2 * q + 1] * bf2f((unsigned short)(x0[q] >> 16)) + w[1][2 * q + 1] * bf2f((unsigned short)(x1[q] >> 16)) + w[2][2 * q + 1] * bf2f((unsigned short)(x2[q] >> 16)) + w[3][2 * q + 1] * bf2f((unsigned short)(x3[q] >> 16));
                    acc0 = acc0 * sigmoidf_(acc0) * osc; acc1 = acc1 * sigmoidf_(acc1) * osc;
                    o[q] = pk2(acc0, acc1);
                }
                *(GAS u32x4*)(QKC + (size_t)(r0 + i) * CD + c0) = o;
            }
            if (more) {
#pragma unroll
                for (int i = 0; i < 19; ++i) xa[i] = xb[i]; }
        }
#undef CV_LOAD
    }
    if (PARTS & 4) {
        LAS unsigned char* tile = F.lds + F.wave * 9216;
        constexpr int NIT = CB * 8 * (CS / 64);
        u32x4 xin[8];
#define VT_LOAD(it_) do { const int bh_ = (it_) / (CS / 64), tb_ = (it_) % (CS / 64); const size_t tk_ = (size_t)(bh_ >> 3) * CS + (size_t)tb_ * 64; \
            _Pragma("unroll") for (int i = 0; i < 8; ++i) xin[i] = ld16(PROJ + (tk_ + 8 * i + (F.lane >> 3)) * NPROJ + 1024 + 64 * (bh_ & 7) + 8 * (F.lane & 7)); } while (0)
        if (F.gw < NIT) VT_LOAD(F.gw);
        for (int it = F.gw; it < NIT; it += F.NGW) {
            const int bh = it / (CS / 64), tb = it % (CS / 64);
#pragma unroll
            for (int i = 0; i < 8; ++i) *(LAS u32x4*)(tile + (8 * i + (F.lane >> 3)) * 144 + (F.lane & 7) * 16) = xin[i];
            if (it + F.NGW < NIT) VT_LOAD(it + F.NGW);
            asm volatile("" ::: "memory");
            u32x4 o[8];
#pragma unroll
            for (int tg = 0; tg < 8; ++tg) { unsigned short e8[8];
#pragma unroll
                for (int q = 0; q < 8; ++q) e8[q] = *(const LAS unsigned short*)(tile + (8 * tg + q) * 144 + F.lane * 2);
                o[tg] = (u32x4){(unsigned)e8[0] | ((unsigned)e8[1] << 16), (unsigned)e8[2] | ((unsigned)e8[3] << 16), (unsigned)e8[4] | ((unsigned)e8[5] << 16), (unsigned)e8[6] | ((unsigned)e8[7] << 16)}; }
            asm volatile("" ::: "memory");
#pragma unroll
            for (int tg = 0; tg < 8; ++tg) *(LAS u32x4*)(tile + F.lane * 144 + tg * 16) = o[tg];
            asm volatile("" ::: "memory");
#pragma unroll
            for (int i = 0; i < 8; ++i) { const int pidx = i * 64 + F.lane, d = pidx >> 3, pc = pidx & 7;
                const u32x4 v = *(const LAS u32x4*)(tile + d * 144 + pc * 16);
                *(GAS u32x4*)(VT + ((size_t)bh * 64 + d) * CS + (size_t)tb * 64 + 8 * pc) = v; }
            asm volatile("" ::: "memory");
        }
#undef VT_LOAD
    }
}
#ifndef MLNJ
#define MLNJ 1
#endif
#ifndef MLFORM
#define MLFORM 1
#endif
#if MLFORM == 4
#define MLWG 32
#else
#define MLWG 64
#endif
template <int ONLY_SB = 0>
__device__ __forceinline__ void mixers_even_phase(const Frame& F, const GAS bf16_t* PROJ, const GAS bf16_t* QKC, const GAS bf16_t* VT, const GAS float* SCA, const GAS float* SCM, GAS bf16_t* MIXCAT, GAS bf16_t* NUM, GAS float* DEN) {
    const int wg = blockIdx.x;
#ifndef NO_ML
    if (wg < MLWG) {
        if (ONLY_SB) return;
        LAS unsigned* flags = (LAS unsigned*)(F.lds + LDSCTL_OFF);
        if (F.tid < 64) flags[F.tid] = 0u;
        __syncthreads();
#if MLFORM == 4
        const int st = wg, b = st >> 2, mh = st & 3; const size_t r0 = (size_t)b * CS;
        mlstm_coop32<4, 2>(F.wave, 0, true, QKC + r0 * CD + 128 * mh, QKC + r0 * CD + 512 + 128 * mh, CD, PROJ + r0 * NPROJ + 2560 + 128 * mh, NPROJ, SCA + (size_t)st * CS, SCM + (size_t)st * CS, CS,
                           NUM + r0 * 512 + 128 * mh, 512, DEN + r0 * 4 + mh, 4, F.lds, flags);
#else
        const int st = wg >> 1, half = wg & 1, b = st >> 2, mh = st & 3; const size_t r0 = (size_t)b * CS;
#ifdef ABL_PROBE
        { const unsigned long long t0 = __builtin_amdgcn_s_memrealtime();
          mlstm_coop32<1, 4, ABL_PROBE>(F.wave, 64 * half, half == 0, QKC + r0 * CD + 128 * mh, QKC + r0 * CD + 512 + 128 * mh, CD, PROJ + r0 * NPROJ + 2560 + 128 * mh, NPROJ, SCA + (size_t)st * CS, SCM + (size_t)st * CS, CS,
                           NUM + (size_t)17 * 1048576 + r0 * 512 + 128 * mh, 512, DEN + (size_t)115 * 1048576 + r0 * 4 + mh, 4, F.lds, flags);
          __syncthreads();
          if (blockIdx.x == 0 && F.tid == 0) ((volatile LAS unsigned long long*)(F.lds + MISC_OFF + 64))[1] += __builtin_amdgcn_s_memrealtime() - t0;
          if (F.tid < 64) flags[F.tid] = 0u;
          __syncthreads(); }
#endif
        mlstm_coop32<MLNJ, 4 / MLNJ>(F.wave, 64 * half, half == 0, QKC + r0 * CD + 128 * mh, QKC + r0 * CD + 512 + 128 * mh, CD, PROJ + r0 * NPROJ + 2560 + 128 * mh, NPROJ, SCA + (size_t)st * CS, SCM + (size_t)st * CS, CS,
                           NUM + r0 * 512 + 128 * mh, 512, DEN + r0 * 4 + mh, 4, F.lds, flags);
#endif
        return;
    }
#endif
#ifndef NO_SB
    const int worker = (wg - MLWG) * NWAVES + F.wave;
    constexpr int NWORK = (256 - MLWG) * NWAVES, NUNIT = CB * 8 * (CS / 32);
    for (int u = worker; u < NUNIT; u += NWORK) {
        const int bh = u / (CS / 32), qb = (u + 37 * bh) % (CS / 32), b = bh >> 3, h = bh & 7;
        const size_t r0 = (size_t)b * CS;
        sb_attn_unit(PROJ + r0 * NPROJ + 64 * h, PROJ + r0 * NPROJ + 512 + 64 * h, NPROJ, PROJ + r0 * NPROJ + 1024 + 64 * h, NPROJ, F.lds + F.wave * 16384 + 8448  , MIXCAT + r0 * CD + 64 * h, CD, 32 * qb);
    }
#endif
}
__device__ __forceinline__ void mlstm_post_pass(const Frame& F, const GAS bf16_t* NUM, const GAS float* DEN, const GAS float* SCE, const GAS bf16_t* PROJ, const GAS float* head_g, GAS bf16_t* MIXCAT) {
    const int hd = F.lane >> 4;
    f32x4 g0 = *(const GAS f32x4*)(head_g + 8 * F.lane), g1 = *(const GAS f32x4*)(head_g + 8 * F.lane + 4);
    constexpr int R = 4;
    for (int base = F.gw * R; base < CM; base += F.NGW * R) {
        u32x4 nv[R], ov[R]; float den[R], emt[R];
#pragma unroll
        for (int r = 0; r < R; ++r) { const int row = base + r; nv[r] = ld16(NUM + (size_t)row * 512 + 8 * F.lane); ov[r] = ld16(PROJ + (size_t)row * NPROJ + 3072 + 8 * F.lane);
            den[r] = DEN[(size_t)row * 4 + hd]; emt[r] = SCE[(size_t)((row / CS) * 4 + hd) * CS + (row % CS)]; }
#pragma unroll
        for (int r = 0; r < R; ++r) {
            const int row = base + r;
            const float inv = __builtin_amdgcn_rcpf(fmaxf(fabsf(den[r]), emt[r]));
            float hvv[8]; float ss = 0.f;
#pragma unroll
            for (int q = 0; q < 4; ++q) { hvv[2 * q] = bf2f((unsigned short)(nv[r][q] & 0xffffu)) * inv; hvv[2 * q + 1] = bf2f((unsigned short)(nv[r][q] >> 16)) * inv; ss += hvv[2 * q] * hvv[2 * q] + hvv[2 * q + 1] * hvv[2 * q + 1]; }
            DPP_ADD(ss, 0xB1); DPP_ADD(ss, 0x4E); DPP_ADD(ss, 0x141); DPP_ADD(ss, 0x140);
            const float rs = __builtin_amdgcn_rsqf(ss * (1.0f / 128.0f) + NORM_EPS);
            u32x4 o;
#pragma unroll
            for (int q = 0; q < 4; ++q) {
                const float ga = (q < 2) ? g0[2 * q] : g1[2 * q - 4], gb = (q < 2) ? g0[2 * q + 1] : g1[2 * q - 3];
                const float a = hvv[2 * q] * rs * ga * sigmoidf_(bf2f((unsigned short)(ov[r][q] & 0xffffu)));
                const float b = hvv[2 * q + 1] * rs * gb * sigmoidf_(bf2f((unsigned short)(ov[r][q] >> 16)));
                o[q] = pk2(a, b);
            }
            *(GAS u32x4*)(MIXCAT + (size_t)row * CD + 512 + 8 * F.lane) = o;
        }
    }
}
#ifndef PH_MASK
#define PH_MASK 0xFFFFFFFFu
#endif
#define PH(k) ((PH_MASK >> (k)) & 1u)
#ifndef PROBE_MASK
#define PROBE_MASK 0u
#endif
#define REPS(k) (((PROBE_MASK >> (k)) & 1u) ? 2 : 1)
#ifndef PROBE_T
#define PROBE_T 0u
#endif
#define TWORDS ((volatile LAS unsigned long long*)((LAS unsigned char*)lds_raw + MISC_OFF + 64))
#ifndef PROBE_BLK
#define PROBE_BLK 0
#endif
#ifdef CLK_PHASE
#define CLKS(k) do { if ((k) == CLK_PHASE && blockIdx.x == PROBE_BLK && T0_()) TWORDS[2] = __builtin_amdgcn_s_memtime(); } while (0)
#define CLKE(k) do { if ((k) == CLK_PHASE && blockIdx.x == PROBE_BLK && T0_()) TWORDS[1] += (__builtin_amdgcn_s_memtime() - TWORDS[2]) / 100ull; } while (0)
#else
#define CLKS(k) do {} while (0)
#define CLKE(k) do {} while (0)
#endif
#define TSTART(k) do { if (((PROBE_T >> (k)) & 1u) && blockIdx.x == PROBE_BLK && T0_()) TWORDS[0] = __builtin_amdgcn_s_memrealtime(); } while (0)
#define TEND(k) do { if (((PROBE_T >> (k)) & 1u) && blockIdx.x == PROBE_BLK && T0_()) TWORDS[1] += __builtin_amdgcn_s_memrealtime() - TWORDS[0]; } while (0)
struct Args { Inputs in; float* out; unsigned char* ws; };
__device__ __forceinline__ Frame make_frame(LAS unsigned char* lds, int wave_s) {
    Frame F; int bx = blockIdx.x; asm volatile("" : "+s"(bx)); int wv = wave_s; asm volatile("" : "+s"(wv));
    F.lds = lds; F.lane = lane_id(); F.wave = wv; F.tid = wv * 64 + F.lane;
    F.G = gridDim.x; F.vcu = (bx % 8) * (F.G / 8) + bx / 8;
    F.gw = F.vcu * NWAVES + F.wave; F.NGW = F.G * NWAVES; return F;
}
#define PHASE_BEGIN Frame F = make_frame((LAS unsigned char*)lds_raw, wave_s_); unsigned char* wsg_ = args.ws; asm volatile("" : "+s"(wsg_)); GAS unsigned char* ws = (GAS unsigned char*)wsg_; (void)F; \
    GAS bf16_t* Wb = (GAS bf16_t*)(ws + WS_W); GAS bf16_t* U = (GAS bf16_t*)(ws + WS_U); (void)Wb; (void)U; GAS float* HOUT = (GAS float*)args.out; (void)HOUT;
#define T0_() (wave_s_ == 0 && lane_id() == 0)
#define GRID_BAR() do { unsigned char* wsb = args.ws; asm volatile("" : "+s"(wsb)); XcdBarrier bar; bar.bar = (unsigned*)(wsb + WS_CTL) + CW_BAR; bar.x = xb_xcc_id(); \
    bar.st = (volatile LAS unsigned*)((LAS unsigned char*)lds_raw + MISC_OFF) + 8; xcd_barrier(bar, T0_()); } while (0)
__global__ void __launch_bounds__(NWAVES * 64, 2) hybrid_fwd(Args args) {
    extern __shared__ __attribute__((aligned(16))) unsigned char lds_raw[];
    const int wave_s_ = __builtin_amdgcn_readfirstlane((int)(threadIdx.x >> 6));
    {
        LAS unsigned char* l3 = (LAS unsigned char*)lds_raw;
        for (int u = threadIdx.x; u < (LDS_BYTES - LDSCTL_OFF) / 4; u += NWAVES * 64) ((LAS unsigned*)(l3 + LDSCTL_OFF))[u] = 0u;
        __syncthreads();
        (void)xcd_barrier_post((unsigned*)(args.ws + WS_CTL) + CW_BAR, (volatile LAS unsigned*)(l3 + MISC_OFF) + 8, T0_());
    }
    const Inputs& in = args.in;
    {
        PHASE_BEGIN
        if (PH(0)) { convert_layer(F, in, Wb, 0, 0); }
        __syncthreads();
        if (PH(1)) { RowPassArgs A{INP(0), nullptr, nullptr, nullptr, U, INP(1) + 0, 0, INP(2), INP(3), (GAS float*)(ws + WS_GATES)}; row_pass<2, 0, 0>(F, A); }
    }
    GRID_BAR();

    for (int L = 0; L < 4; ++L) {
        if ((L & 1) == 0) {
            const int e = L >> 1;
            TSTART(2); CLKS(2);
            if (PH(2)) {
                PHASE_BEGIN
                pg8::ProbPlain<1024, 1024, 16> P{U, Wb + W_IN}; pg8::StaticOrder S; S.init(CM, NPROJ, F.G, (int)blockIdx.x);
                pg8::EpiStore E{(GAS bf16_t*)(ws + WS_PROJ), NPROJ, 0, 0, 0, nullptr};
                pg8::gemm_phase(F.lds, F.wave, P, S, E);
            }
            GRID_BAR();
            CLKE(2); TEND(2);
#ifdef E2_PROBE
            TSTART(16);
            { PHASE_BEGIN conv_vt_pass<E2_PROBE>(F, (const GAS bf16_t*)(ws + WS_PROJ), INP(4) + (size_t)e * 4 * 1024, (GAS bf16_t*)(ws + WS_QKC), (GAS bf16_t*)(ws + WS_VT), (const GAS float*)(ws + WS_GATES), (GAS float*)(ws + WS_SCA), (GAS float*)(ws + WS_SCM), (GAS float*)(ws + WS_EMT)); }
            GRID_BAR();
            TEND(16);
#endif
            TSTART(3); CLKS(3);
            if (PH(3)) { PHASE_BEGIN conv_vt_pass<3>(F, (const GAS bf16_t*)(ws + WS_PROJ), INP(4) + (size_t)e * 4 * 1024, (GAS bf16_t*)(ws + WS_QKC), (GAS bf16_t*)(ws + WS_VT), (const GAS float*)(ws + WS_GATES), (GAS float*)(ws + WS_SCA), (GAS float*)(ws + WS_SCM), (GAS float*)(ws + WS_EMT)); }
            GRID_BAR();
            CLKE(3); TEND(3);
#ifdef SB_PROBE
            TSTART(16);
            { PHASE_BEGIN mixers_even_phase<1>(F, (const GAS bf16_t*)(ws + WS_PROJ), (const GAS bf16_t*)(ws + WS_QKC), (const GAS bf16_t*)(ws + WS_VT), (const GAS float*)(ws + WS_SCA), (const GAS float*)(ws + WS_SCM), U, (GAS bf16_t*)(ws + WS_NUM), (GAS float*)(ws + WS_DEN)); }
            GRID_BAR();
            TEND(16);
#endif
            TSTART(4); CLKS(4);
            if (PH(4)) { PHASE_BEGIN mixers_even_phase(F, (const GAS bf16_t*)(ws + WS_PROJ), (const GAS bf16_t*)(ws + WS_QKC), (const GAS bf16_t*)(ws + WS_VT), (const GAS float*)(ws + WS_SCA), (const GAS float*)(ws + WS_SCM), U  , (GAS bf16_t*)(ws + WS_NUM), (GAS float*)(ws + WS_DEN));
                if ((int)blockIdx.x >= MLWG) { Frame F2 = F; F2.gw = ((int)blockIdx.x - MLWG) * NWAVES + F.wave; F2.NGW = (F.G - MLWG) * NWAVES; convert_layer(F2, in, Wb, L, 1); convert_layer(F2, in, Wb, L + 1, 0); } }
#ifdef ML_PROBE
            { PHASE_BEGIN __syncthreads(); if (blockIdx.x == 0 && T0_()) TWORDS[1] += ((LAS unsigned*)(F.lds + LDSCTL_OFF))[32 + ML_PROBE]; }
#endif
#ifdef E3_PRE
            __syncthreads(); CLKE(4); TEND(4);
#endif
            GRID_BAR();
#ifndef E3_PRE
            CLKE(4); TEND(4);
#endif
            TSTART(5); CLKS(5);
            if (PH(5)) { PHASE_BEGIN mlstm_post_pass(F, (const GAS bf16_t*)(ws + WS_NUM), (const GAS float*)(ws + WS_DEN), (const GAS float*)(ws + WS_EMT), (const GAS bf16_t*)(ws + WS_PROJ), INP(5) + (size_t)e * 512, U); }
            GRID_BAR();
            CLKE(5); TEND(5);
        } else {
            const int o = L >> 1;
            TSTART(7); CLKS(7);
            if (PH(7)) {
                PHASE_BEGIN
                pg8::ProbRkv P{(const GAS bf16_t*)(ws + WS_XR), (size_t)(WS_XK - WS_XR) / 2, Wb + W_RKV, U, Wb + W_LB1, (long)(W_LB2 - W_LB1) * 2};
                pg8::RkvOrder2 S{(int)blockIdx.x};
                pg8::EpiStore E{(GAS bf16_t*)(ws + WS_RO), 1024, 0, 1, (size_t)(WS_KO - WS_RO) / 2, (GAS bf16_t*)(ws + WS_LORA)};
                pg8::gemm_phase(F.lds, F.wave, P, S, E);
            }
            GRID_BAR();
            CLKE(7); TEND(7);
            constexpr int NCS1 = 192, NCS2 = 256 - NCS1, NPO1 = 128, NPO2 = 256 - NPO1;
            RwkvPrepArgs P{(const GAS bf16_t*)(args.ws + WS_RO), (const GAS bf16_t*)(args.ws + WS_KO), CD, (const GAS bf16_t*)(args.ws + WS_LORA), 256, (const GAS bf16_t*)(args.ws + WS_W) + W_W2T, (const GAS bf16_t*)(args.ws + WS_W) + W_A2T,
                           INP(9) + (size_t)o * 1024, INP(12) + (size_t)o * 1024, INP(17) + (size_t)o * 1024, INP(18) + (size_t)o * 1024,
                           INP(19) + (size_t)o * 1024, (GAS bf16_t*)(args.ws + WS_KT), (GAS bf16_t*)(args.ws + WS_BT), (GAS bf16_t*)(args.ws + WS_KK), (GAS bf16_t*)(args.ws + WS_RT), (GAS float*)(args.ws + WS_GL), (GAS float*)(args.ws + WS_BONUS)};
            TSTART(8); CLKS(8);
            if (PH(8)) {
                PHASE_BEGIN
                rwkv_prep_loop(P, F.gw, F.NGW, CB * NCS1 * 16, F.lds + F.wave * 10752, 0, NCS1);
            }
            GRID_BAR();
            CLKE(8); TEND(8);
            TSTART(9); CLKS(9);
            if (PH(9)) {
              for (int seg = 0; seg < 2; ++seg) {
                {
                PHASE_BEGIN
                const int gw2 = ((int)blockIdx.x - 128) * NWAVES + F.wave, ngw2 = (F.G - 128) * NWAVES;
                if (blockIdx.x >= 128) {
                    if (seg == 0) {
                        Frame F2 = F; F2.gw = gw2; F2.NGW = ngw2; convert_layer(F2, in, Wb, L, 1); if (L < 3) convert_layer(F2, in, Wb, L + 1, 0);
                        __syncthreads();
                        rwkv_prep_loop(P, gw2, ngw2, CB * NCS2 * 16, F.lds + F.wave * 10752, NCS1, NCS2);
                    } else {
                        rwkv_post_loop((const GAS bf16_t*)(ws + WS_YRAW), (const GAS bf16_t*)(ws + WS_VO), (const GAS bf16_t*)(ws + WS_LORA), Wb + W_G2T, (const GAS float*)(ws + WS_BONUS), INP(20) + (size_t)o * 1024, INP(21) + (size_t)o * 1024,
                                       (GAS bf16_t*)(ws + WS_YG), CD, gw2, ngw2, CB * NPO1 * 16, F.lds + F.wave * 10752, 0, NPO1);
                    }
                } else {
                    if (F.tid < 64) ((LAS unsigned*)(F.lds + RWS_FLAGS))[F.tid] = 0u;
                    __syncthreads();
                    const int bh = blockIdx.x, b = bh >> 4, h = bh & 15;
                    const int c0 = seg ? NCS1 : 0, ncs = seg ? NCS2 : NCS1;
                    const size_t r0 = (size_t)b * CS + (size_t)c0 * 16, co = 64 * h;
                    GAS float* hst = (GAS float*)(ws + WS_GATES) + (size_t)bh * 4096;
                    rwkv_scan_coop(F.wave, (const GAS bf16_t*)(ws + WS_KT) + r0 * CD + co, (const GAS bf16_t*)(ws + WS_BT) + r0 * CD + co, (const GAS bf16_t*)(ws + WS_KK) + r0 * CD + co, (const GAS bf16_t*)(ws + WS_RT) + r0 * CD + co,
                                   (const GAS bf16_t*)(ws + WS_VO) + r0 * CD + co, CD, (const GAS float*)(ws + WS_GL) + (r0 / 16) * 1024 + co, ncs * 16, (GAS bf16_t*)(ws + WS_YRAW) + r0 * CD + co, CD, F.lds,
                                   seg ? (const GAS float*)hst : nullptr, seg ? nullptr : hst);
#ifdef COOP_PROBE
                    __syncthreads(); if (blockIdx.x == 0 && T0_()) TWORDS[1] += ((LAS unsigned*)(F.lds + RWS_FLAGS))[32 + COOP_PROBE];
#endif
                }
                }
                GRID_BAR();
              }
            } else { GRID_BAR(); GRID_BAR(); }
            CLKE(9); TEND(9);
            TSTART(10); CLKS(10);
            if (PH(10)) {
                PHASE_BEGIN
                rwkv_post_loop((const GAS bf16_t*)(ws + WS_YRAW), (const GAS bf16_t*)(ws + WS_VO), (const GAS bf16_t*)(ws + WS_LORA), Wb + W_G2T, (const GAS float*)(ws + WS_BONUS), INP(20) + (size_t)o * 1024, INP(21) + (size_t)o * 1024, (GAS bf16_t*)(ws + WS_YG), CD, F.gw, F.NGW, CB * NPO2 * 16, F.lds + F.wave * 10752, NPO1, NPO2);
            }
            GRID_BAR();
            CLKE(10); TEND(10);
        }
        TSTART(11); CLKS(11);
        if (PH(11)) {
            PHASE_BEGIN
            const bool odd = (L & 1) != 0;
            pg8::ProbPlain<1024, 1024, 16> P{odd ? (const GAS bf16_t*)(ws + WS_YG) : (const GAS bf16_t*)U, Wb + (odd ? W_OUTO : W_OUTE)}; pg8::StaticOrder S; S.init(CM, CD, F.G, (int)blockIdx.x);
            pg8::EpiStore E{(GAS bf16_t*)(ws + WS_MIX), YP, 0, 0, 0, nullptr};
            pg8::gemm_phase(F.lds, F.wave, P, S, E);
        }
        GRID_BAR();
        CLKE(11); TEND(11);
        TSTART(12); CLKS(12);
        if (PH(12)) { PHASE_BEGIN const GAS float* ng = INP(1) + (size_t)L * 4 * 1024; GAS bf16_t* hb = (GAS bf16_t*)HOUT; GAS bf16_t* hd = (GAS bf16_t*)(ws + WS_HL);
            RowPassArgs A{L == 0 ? (const GAS void*)INP(0) : (const GAS void*)hb, (const GAS bf16_t*)(ws + WS_MIX), ng + 1 * 1024, hd, nullptr, nullptr, 0, nullptr, nullptr, nullptr, CD, HLP, YP, (GAS float*)(ws + WS_RS)};
            if (L == 0) row_pass<4, 0, 1>(F, A); else row_pass<4, 1, 1>(F, A); }
        GRID_BAR();
        CLKE(12); TEND(12);
#ifdef CLK_PROBE2
        if (blockIdx.x == 0 && T0_()) TWORDS[2] = __builtin_amdgcn_s_memtime();
#endif
        TSTART(13); CLKS(13);
        if (PH(13)) {
            PHASE_BEGIN
            const GAS bf16_t* hres = (const GAS bf16_t*)(ws + WS_HL);
            pg8::ProbPlain<HLP, 1024, 16> P{hres, Wb + W_UP}; pg8::StaticOrder S; S.init(CM, FF, F.G, (int)blockIdx.x);
            pg8::EpiStore E{(GAS bf16_t*)(ws + WS_HID), HIDP, 1, 0, 0, nullptr, 0, (const GAS float*)(ws + WS_RS)};
            pg8::gemm_phase(F.lds, F.wave, P, S, E);
        }
        GRID_BAR();
#ifdef CLK_PROBE2
        if (blockIdx.x == 0 && T0_()) TWORDS[1] += (__builtin_amdgcn_s_memtime() - TWORDS[2]) / 100ull;
#endif
        CLKE(13); TEND(13);
        TSTART(14); CLKS(14);
        if (PH(14)) {
            PHASE_BEGIN
            pg8::ProbPlain<HIDP, FF, 64> P{(const GAS bf16_t*)(ws + WS_HID), Wb + W_DN}; pg8::StaticOrder S; S.init(CM, CD, F.G, (int)blockIdx.x);
            pg8::EpiStore E{(GAS bf16_t*)(ws + WS_FFO), YP, 0, 0, 0, nullptr};
            pg8::gemm_phase(F.lds, F.wave, P, S, E);
        }
        GRID_BAR();
        CLKE(14); TEND(14);
        TSTART(15); CLKS(15);
        if (PH(15)) {
            PHASE_BEGIN
            const GAS float* ng = INP(1) + (size_t)L * 4 * 1024;
            const bool lastL = (L == 3); const bool next_even = ((L + 1) & 1) == 0;
            const GAS float* ngn = INP(1) + (size_t)(L + 1) * 4 * 1024;
            const bool gts = !lastL && next_even;
            GAS bf16_t* hs = (GAS bf16_t*)(ws + WS_HL);
            GAS void* hd = (GAS void*)HOUT;
            RowPassArgs A{hs, (const GAS bf16_t*)(ws + WS_FFO), ng + 3 * 1024, hd, lastL ? nullptr : U, lastL ? nullptr : ngn, next_even ? 0 : 1,
                          gts ? INP(2) + (size_t)((L + 1) >> 1) * 1024 * PITCH_WIN : nullptr, gts ? INP(3) + (size_t)((L + 1) >> 1) * 8 : nullptr, gts ? (GAS float*)(ws + WS_GATES) : nullptr};
            A.hsp = HLP;
            if (lastL) row_pass<2, 1, 0>(F, A);
            else if (next_even) row_pass<2, 1, 1>(F, A);
            else {
                const int blk0 = 128 * (int)blockIdx.x;
                GAS bf16_t* halo = (GAS bf16_t*)(ws + WS_DEN) + (size_t)blockIdx.x * 1024;
                if (F.wave == 0 && (blk0 % CS) != 0) { RowPassArgs H = A; H.hdst = nullptr; const int hrow = blk0 - 1;
                    H.udst = (GAS bf16_t*)((size_t)halo - ((size_t)hrow + (size_t)(hrow / CS) + 1) * CD * 2); row_pass_range<1, 1, 1>(F, H, hrow, blk0, 1); }
                row_pass_range<4, 1, 1>(F, A, blk0 + 16 * F.wave, blk0 + 16 * F.wave + 16, 4);
                asm volatile("s_waitcnt vmcnt(0)" ::: "memory"); __syncthreads();
                mix_block(F, U, halo, INP(7) + (size_t)((L + 1) >> 1) * 6 * 1024, (GAS bf16_t*)(ws + WS_XR), (GAS bf16_t*)(ws + WS_XK), (GAS bf16_t*)(ws + WS_XV), blk0);
            }
        }
        if (L < 3) GRID_BAR();
        CLKE(15); TEND(15);
    }
#ifdef ST_PROBE
    GRID_BAR();
    TSTART(16);
    {
        PHASE_BEGIN
        pg8::ProbPlain<1024, 1024, 16> P{U, Wb + W_UP}; pg8::StaticOrder S; S.init(CM, FF, F.G, (int)blockIdx.x);
        const int bid = (int)blockIdx.x;
        const int skip = ST_PROBE == 0 ? 0 : ST_PROBE == 1 ? (bid & 1) : ST_PROBE == 2 ? 1 : ST_PROBE == 3 ? ((bid & 7) != 0) : ST_PROBE == 4 ? ((bid >> 3) & 1) : ST_PROBE == 6 ? 2 : (bid != 0);
        int skip_l = skip; asm volatile("" : "+s"(skip_l));
        pg8::EpiStore E{(GAS bf16_t*)(ws + WS_HID), FF, 1, 0, 0, nullptr, skip_l};
        pg8::gemm_phase(F.lds, F.wave, P, S, E);
    }
    GRID_BAR();
    TEND(16);
#endif
#ifdef BAR_PROBE
    for (int i = 0; i < BAR_PROBE; ++i) GRID_BAR();
#endif
    if (PROBE_T != 0u && blockIdx.x == PROBE_BLK && T0_()) {
        const unsigned long long te = __builtin_amdgcn_s_memrealtime() + 4ull * TWORDS[1];
        while (__builtin_amdgcn_s_memrealtime() < te) __builtin_amdgcn_s_sleep(8);
    }
}

extern "C" void kernel_launch(void* const* d_in, const int* in_sizes, int n_in, void* d_out, int out_size, void* d_ws, size_t ws_size, hipStream_t stream) {
    static int grid = 0;
    if (grid == 0) {
        if (n_in != 25 || out_size != CM * CD || ws_size < WS_END) { fprintf(stderr, "kernel_launch: unexpected shapes (n_in %d, out %d, ws %zu)\n", n_in, out_size, ws_size); grid = -1; return; }
        int dev = 0, cus = 0, per_cu = 0;
        if (hipGetDevice(&dev) != hipSuccess || hipDeviceGetAttribute(&cus, hipDeviceAttributeMultiprocessorCount, dev) != hipSuccess) { grid = -1; return; }
        if (hipFuncSetAttribute((const void*)hybrid_fwd, hipFuncAttributeMaxDynamicSharedMemorySize, LDS_BYTES) != hipSuccess) { grid = -1; return; }
        if (hipOccupancyMaxActiveBlocksPerMultiprocessor(&per_cu, (const void*)hybrid_fwd, NWAVES * 64, LDS_BYTES) != hipSuccess || per_cu < 1) fprintf(stderr, "kernel_launch: occupancy query reports %d\n", per_cu);
        (void)hipGetLastError();
        grid = cus;
        if (grid != 256) fprintf(stderr, "kernel_launch: %d CUs (the phase deals assume 256)\n", grid);
    }
    if (grid < 0) return;
    if (hipMemsetAsync((char*)d_ws + WS_CTL, 0, CTL_ZERO_BYTES, stream) != hipSuccess) return;
    Args a{};
    for (int i = 0; i < 25; ++i) a.in.p[i] = (const float*)d_in[i];
    a.out = (float*)d_out; a.ws = (unsigned char*)d_ws;
    hipLaunchKernelGGL(hybrid_fwd, dim3(grid), dim3(NWAVES * 64), LDS_BYTES, stream, a);
}
```
